# Optimizing an MI355X kernel written in HIP

```python
import math
import jax, jax.numpy as jnp
from jax import lax
import numpy as np

D_MODEL = 2048
BATCH = 8
SEQ = 2048
DEPTH = 2

ATT_HEADS = 8
ATT_KV_HEADS = 2
ATT_HEAD_DIM = 128
ATT_GROUP = ATT_HEADS // ATT_KV_HEADS
ATT_W = ATT_HEADS * ATT_HEAD_DIM
KV_W = ATT_KV_HEADS * ATT_HEAD_DIM
IDX_HEADS = 16
IDX_HEAD_DIM = 64
IDX_Q_RANK = 512
TOPK_MAX = 256
Q_BLOCK = 128
HGRN_HEADS = 8
HGRN_KEY_DIM = 128
HGRN_VAL_DIM = 128
HGRN_KW = HGRN_HEADS * HGRN_KEY_DIM
HGRN_VW = HGRN_HEADS * HGRN_VAL_DIM
HGRN_CHUNK = 64
REL_BUCKETS = 32
REL_MAX_DIST = 128
D_FF_DENSE = 5632
N_EXPERTS = 8
TOP_K_EXPERTS = 2
D_FF_EXPERT = 7168
EPS = 1e-6

N_DENSE = (DEPTH + 1) // 2
N_MOE = DEPTH // 2

kernel_name = "hybrid_dsa_hgrn2_gated_moe_block"


def _split_points():
    sizes = [ATT_W, KV_W, KV_W, IDX_Q_RANK, IDX_HEAD_DIM, IDX_HEADS,
             HGRN_KW, HGRN_KW, HGRN_VW, HGRN_VW, D_MODEL, D_MODEL]
    return [int(s) for s in np.cumsum(sizes)[:-1]], int(sum(sizes))


def rmsnorm(x, g):
    xf = x.astype(jnp.float32)
    y = xf * lax.rsqrt(jnp.mean(xf * xf, axis=-1, keepdims=True) + EPS)
    return (y * g.astype(jnp.float32)).astype(x.dtype)


def layernorm(x, g, b):
    xf = x.astype(jnp.float32)
    mu = jnp.mean(xf, axis=-1, keepdims=True)
    var = jnp.mean(jnp.square(xf - mu), axis=-1, keepdims=True)
    y = (xf - mu) * lax.rsqrt(var + EPS)
    return (y * g.astype(jnp.float32) + b.astype(jnp.float32)).astype(x.dtype)


def rel_bucket(dist):
    max_exact = REL_BUCKETS // 2
    n = jnp.maximum(dist, 0)
    nf = jnp.maximum(n, 1).astype(jnp.float32)
    large = max_exact + (jnp.log(nf / max_exact) / math.log(REL_MAX_DIST / max_exact)
                         * (REL_BUCKETS - max_exact)).astype(jnp.int32)
    large = jnp.minimum(large, REL_BUCKETS - 1)
    return jnp.where(n < max_exact, n, large)


def dsa_attention(q, k, v, q_idx, k_idx, w_idx, rel_bias):
    B, T = q.shape[0], q.shape[1]
    n_sel = min(TOPK_MAX, T // 4)
    nb = T // Q_BLOCK
    pos = jnp.arange(T)
    att_scale = ATT_HEAD_DIM ** -0.5
    idx_scale = IDX_HEAD_DIM ** -0.5
    w_scale = IDX_HEADS ** -0.5
    k_idx_f = k_idx.astype(jnp.float32)

    def to_blocks(a):
        return a.reshape((B, nb, Q_BLOCK) + a.shape[2:]).swapaxes(0, 1)

    def block(args):
        qb, qib, wb, t0 = args
        tq = t0 + jnp.arange(Q_BLOCK)
        s = jnp.einsum('bqhd,bsd->bhqs', qib.astype(jnp.float32), k_idx_f) * idx_scale
        score = jnp.einsum('bhqs,bqh->bqs', jax.nn.relu(s), wb.astype(jnp.float32) * w_scale)
        causal = pos[None, :] <= tq[:, None]
        score = jnp.where(causal[None], score, -jnp.inf)
        _, idx = lax.top_k(score, n_sel)
        valid = idx <= tq[None, :, None]
        kg = jax.vmap(lambda kk, ii: kk[ii])(k, idx)
        vg = jax.vmap(lambda vv, ii: vv[ii])(v, idx)
        qg = qb.reshape(B, Q_BLOCK, ATT_KV_HEADS, ATT_GROUP, ATT_HEAD_DIM)
        logits = jnp.einsum('bqgrd,bqngd->bgrqn', qg, kg).astype(jnp.float32) * att_scale
        bias = rel_bias[rel_bucket(tq[None, :, None] - idx)]
        bias = bias.transpose(0, 3, 1, 2).reshape(B, ATT_KV_HEADS, ATT_GROUP, Q_BLOCK, n_sel)
        logits = jnp.where(valid[:, None, None], logits + bias.astype(jnp.float32), -jnp.inf)
        p = jax.nn.softmax(logits, axis=-1).astype(vg.dtype)
        o = jnp.einsum('bgrqn,bqngd->bqgrd', p, vg)
        return o.reshape(B, Q_BLOCK, ATT_W)

    out = lax.map(block, (to_blocks(q), to_blocks(q_idx), to_blocks(w_idx),
                          jnp.arange(nb) * Q_BLOCK))
    return out.swapaxes(0, 1).reshape(B, T, ATT_W)


def hgrn2_branch(hq, hf, hi, hg, lb, g_norm):
    B, T = hq.shape[0], hq.shape[1]
    dt = hq.dtype
    H, dk, dv, C = HGRN_HEADS, HGRN_KEY_DIM, HGRN_VAL_DIM, HGRN_CHUNK
    nc = T // C
    q = jax.nn.silu(hq.astype(jnp.float32)).reshape(B, T, H, dk) * (dk ** -0.5)
    f = hf.astype(jnp.float32).reshape(B, T, H, dk)
    lbf = lb.astype(jnp.float32)
    log_f = jnp.logaddexp(jnp.log(lbf), jnp.log1p(-lbf) + jax.nn.log_sigmoid(f))
    kk = (1.0 - lbf) * jax.nn.sigmoid(-f)
    v = hi.astype(jnp.float32).reshape(B, T, H, dv)

    def chunks(a):
        return a.reshape(B, nc, C, H, a.shape[-1]).transpose(1, 0, 3, 2, 4)

    tri = jnp.tril(jnp.ones((C, C), dtype=bool))

    def step(S, xs):
        qc, kc, vc, gc = xs
        b = jnp.cumsum(gc, axis=2)
        diff = b[:, :, :, None, :] - b[:, :, None, :, :]
        decay = jnp.exp(jnp.where(tri[None, None, :, :, None], diff, -jnp.inf))
        A = jnp.einsum('bhtd,bhsd,bhtsd->bhts', qc, kc, decay)
        o = jnp.einsum('bhts,bhsv->bhtv', A, vc) + jnp.einsum('bhtd,bhdv->bhtv', qc * jnp.exp(b), S)
        b_last = b[:, :, -1:, :]
        S = jnp.exp(b_last[:, :, 0, :])[..., None] * S + jnp.einsum(
            'bhsd,bhsv->bhdv', kc * jnp.exp(b_last - b), vc)
        return S, o

    S0 = jnp.zeros((B, H, dk, dv), jnp.float32)
    _, o = lax.scan(step, S0, (chunks(q), chunks(kk), chunks(v), chunks(log_f)))
    o = o.transpose(1, 0, 3, 2, 4).reshape(B, T, H, dv)
    o = rmsnorm(o, g_norm) * jax.nn.silu(hg.astype(jnp.float32).reshape(B, T, H, dv))
    return o.reshape(B, T, HGRN_VW).astype(dt)


def hybrid_mixer(xn, w_in, q_norm_g, k_norm_g, idx_q_norm_g, w_idx_q, idx_k_ln_g, idx_k_ln_b,
                 lb, hgrn_out_norm_g, w_up_att, w_up_hgrn, w_o, rel_bias):
    B, T = xn.shape[0], xn.shape[1]
    splits, _ = _split_points()
    proj = jnp.einsum('btd,dn->btn', xn, w_in)
    (q, k, v, cq, kid, wid, hq, hf, hi, hg, ga, gh) = jnp.split(proj, splits, axis=-1)
    q = rmsnorm(q.reshape(B, T, ATT_HEADS, ATT_HEAD_DIM), q_norm_g)
    k = rmsnorm(k.reshape(B, T, ATT_KV_HEADS, ATT_HEAD_DIM), k_norm_g)
    v = v.reshape(B, T, ATT_KV_HEADS, ATT_HEAD_DIM)
    q_idx = jnp.einsum('btr,rn->btn', rmsnorm(cq, idx_q_norm_g), w_idx_q)
    q_idx = q_idx.reshape(B, T, IDX_HEADS, IDX_HEAD_DIM)
    k_idx = layernorm(kid, idx_k_ln_g, idx_k_ln_b)
    att = dsa_attention(q, k, v, q_idx, k_idx, wid, rel_bias)
    rec = hgrn2_branch(hq, hf, hi, hg, lb, hgrn_out_norm_g)
    merged = (jax.nn.sigmoid(ga) * jnp.einsum('btc,cd->btd', att, w_up_att)
              + jax.nn.sigmoid(gh) * jnp.einsum('btc,cd->btd', rec, w_up_hgrn))
    return jnp.einsum('btd,de->bte', merged, w_o)


def swiglu(x, w1, w3, w2):
    return jnp.einsum('btf,fd->btd', jax.nn.silu(jnp.einsum('btd,df->btf', x, w1))
                      * jnp.einsum('btd,df->btf', x, w3), w2)


def moe_swiglu(x, w_router, w1, w3, w2):
    logits = jnp.einsum('btd,de->bte', x, w_router).astype(jnp.float32)
    top_v, top_i = lax.top_k(logits, TOP_K_EXPERTS)
    top_p = jax.nn.softmax(top_v, axis=-1)
    gates = jnp.sum(jax.nn.one_hot(top_i, N_EXPERTS, dtype=jnp.float32) * top_p[..., None], axis=-2)
    y = jnp.zeros(x.shape, jnp.float32)
    for e in range(N_EXPERTS):
        y = y + gates[..., e:e + 1] * swiglu(x, w1[e], w3[e], w2[e]).astype(jnp.float32)
    return y.astype(x.dtype)


def setup_inputs(seed: int = 0) -> dict:
    key = jax.random.key(seed)
    ks = jax.random.split(key, 24)
    _, n_in = _split_points()
    nrm = lambda k, shape, s: jax.random.normal(k, shape, jnp.float32) * s
    gain = lambda k, shape: 1.0 + 0.02 * jax.random.normal(k, shape, jnp.float32)
    return {
        "x": nrm(ks[0], (BATCH, SEQ, D_MODEL), 1.0),
        "rel_bias": nrm(ks[1], (REL_BUCKETS, ATT_HEADS), 0.5),
        "norm_mix_g": gain(ks[2], (DEPTH, D_MODEL)),
        "norm_ffn_g": gain(ks[3], (DEPTH, D_MODEL)),
        "w_in": nrm(ks[4], (DEPTH, D_MODEL, n_in), D_MODEL ** -0.5),
        "q_norm_g": gain(ks[5], (DEPTH, ATT_HEAD_DIM)),
        "k_norm_g": gain(ks[6], (DEPTH, ATT_HEAD_DIM)),
        "idx_q_norm_g": gain(ks[7], (DEPTH, IDX_Q_RANK)),
        "w_idx_q": nrm(ks[8], (DEPTH, IDX_Q_RANK, IDX_HEADS * IDX_HEAD_DIM), IDX_Q_RANK ** -0.5),
        "idx_k_ln_g": gain(ks[9], (DEPTH, IDX_HEAD_DIM)),
        "idx_k_ln_b": nrm(ks[10], (DEPTH, IDX_HEAD_DIM), 0.02),
        "hgrn_lb_logits": nrm(ks[11], (DEPTH, HGRN_KW), 1.0),
        "hgrn_out_norm_g": gain(ks[12], (DEPTH, HGRN_VAL_DIM)),
        "w_up_att": nrm(ks[13], (DEPTH, ATT_W, D_MODEL), ATT_W ** -0.5),
        "w_up_hgrn": nrm(ks[14], (DEPTH, HGRN_VW, D_MODEL), HGRN_VW ** -0.5),
        "w_o": nrm(ks[15], (DEPTH, D_MODEL, D_MODEL), D_MODEL ** -0.5),
        "w1_dense": nrm(ks[16], (N_DENSE, D_MODEL, D_FF_DENSE), D_MODEL ** -0.5),
        "w3_dense": nrm(ks[17], (N_DENSE, D_MODEL, D_FF_DENSE), D_MODEL ** -0.5),
        "w2_dense": nrm(ks[18], (N_DENSE, D_FF_DENSE, D_MODEL), D_FF_DENSE ** -0.5),
        "w_router": nrm(ks[19], (N_MOE, D_MODEL, N_EXPERTS), D_MODEL ** -0.5),
        "w1_moe": nrm(ks[20], (N_MOE, N_EXPERTS, D_MODEL, D_FF_EXPERT), D_MODEL ** -0.5),
        "w3_moe": nrm(ks[21], (N_MOE, N_EXPERTS, D_MODEL, D_FF_EXPERT), D_MODEL ** -0.5),
        "w2_moe": nrm(ks[22], (N_MOE, N_EXPERTS, D_FF_EXPERT, D_MODEL), D_FF_EXPERT ** -0.5),
    }


def reference(x, rel_bias, norm_mix_g, norm_ffn_g, w_in, q_norm_g, k_norm_g, idx_q_norm_g, w_idx_q,
              idx_k_ln_g, idx_k_ln_b, hgrn_lb_logits, hgrn_out_norm_g, w_up_att, w_up_hgrn, w_o,
              w1_dense, w3_dense, w2_dense, w_router, w1_moe, w3_moe, w2_moe):
    lb_all = jnp.cumsum(jax.nn.softmax(hgrn_lb_logits.astype(jnp.float32), axis=0), axis=0)
    lb_all = lb_all - lb_all[0:1]
    for l in range(DEPTH):
        xn = rmsnorm(x, norm_mix_g[l])
        h = x + hybrid_mixer(xn, w_in[l], q_norm_g[l], k_norm_g[l], idx_q_norm_g[l], w_idx_q[l],
                             idx_k_ln_g[l], idx_k_ln_b[l],
                             lb_all[l].reshape(HGRN_HEADS, HGRN_KEY_DIM), hgrn_out_norm_g[l],
                             w_up_att[l], w_up_hgrn[l], w_o[l], rel_bias)
        hn = rmsnorm(h, norm_ffn_g[l])
        if l % 2 == 0:
            j = l // 2
            ffn = swiglu(hn, w1_dense[j], w3_dense[j], w2_dense[j])
        else:
            j = l // 2
            ffn = moe_swiglu(hn, w_router[j], w1_moe[j], w3_moe[j], w2_moe[j])
        x = h + ffn
    return x
```

```cpp
#include <hip/hip_runtime.h>
#include <cstdio>
#include <cstdint>
namespace pg8 {
#define PG8_LAS __attribute__((address_space(3)))
typedef unsigned short bf16_t;
typedef short bf16x8 __attribute__((ext_vector_type(8)));
typedef float f32x4 __attribute__((ext_vector_type(4)));
typedef unsigned u32x4 __attribute__((ext_vector_type(4)));
constexpr int BM = 256, BK = 64, HALF = 128, HTB = HALF * BK * 2  , STAGE_BYTES = 8 * HTB, NXCD = 8, WGM = 8;

__host__ __device__ __forceinline__ int lds_byte(int r, int c) { const int st = (r >> 4) * 2 + (c >> 5), rr = r & 15, cc = c & 31, ob = rr * 64 + cc * 2; return st * 1024 + (ob ^ (((ob >> 9) & 1) << 5)); }
__host__ __device__ __forceinline__ void stage_rc(int b, int& R, int& C) { const int st = b / 1024, sb = b % 1024, swz = sb ^ (((sb >> 9) & 1) << 5); R = (st >> 1) * 16 + swz / 64; C = (st & 1) * 32 + (swz % 64) / 2; }
__host__ __device__ __forceinline__ int perm32(int rho) { const int n = rho >> 4, i = rho & 15; return 8 * (i >> 2) + 4 * n + (i & 3); }

struct Unit { int pm, pn; };
struct Gemm { const bf16_t* A; const bf16_t* Bt; int M, N, K, lda; };

struct StaticOrder {
    int nM, nN, nwg, G, c;
    __host__ __device__ void init(int M, int N, int G_, int c_) { nM = M / BM; nN = N / BM; nwg = nM * nN; G = G_; c = c_; }
    __host__ __device__ bool next(int i, Unit& u) const {
        const long L = (long)i * G + c; if (L >= nwg) return false;
        int wgid = (int)L; { const int q = nwg / NXCD, r = nwg % NXCD, xcd = wgid % NXCD, off = wgid / NXCD; wgid = (xcd < r ? xcd * (q + 1) : r * (q + 1) + (xcd - r) * q) + off; }
        const int nig = WGM * nN, gid = wgid / nig, fm = gid * WGM, gsz = (nM - fm) < WGM ? (nM - fm) : WGM;
        u.pm = fm + ((wgid % nig) % gsz); u.pn = (wgid % nig) / gsz; return true;
    }
    __device__ __forceinline__ void a_ready(const Unit&) const {}
    __device__ __forceinline__ void done(const Unit&) const {}
};

__device__ __forceinline__ unsigned cvt_pk_bf16(float lo, float hi) { unsigned r; asm volatile("v_cvt_pk_bf16_f32 %0, %1, %2" : "=v"(r) : "v"(lo), "v"(hi)); return r; }
__device__ __forceinline__ float bflo(unsigned w) { return __builtin_bit_cast(float, w << 16); }
__device__ __forceinline__ float bfhi(unsigned w) { return __builtin_bit_cast(float, w & 0xffff0000u); }
__device__ __forceinline__ float sigm(float x) { return 1.0f / (1.0f + __expf(-x)); }
__device__ __forceinline__ float silu(float x) { return x / (1.0f + __expf(-x)); }

struct EpiScaleBf16 {
    static constexpr bool PERM = true, AFTER_DRAIN = false;
    bf16_t* O; int ldc; const float* rs;
    __device__ __forceinline__ void operator()(const f32x4 (&acc)[2][2][4][2], const Unit& u, int wr, int wc, int fr, int fq) const {
        const int row0 = u.pm * BM + wr * 64 + fr, col0 = u.pn * BM + wc * 32 + 8 * fq;
#pragma unroll
        for (int ai = 0; ai < 2; ++ai)
#pragma unroll
            for (int m = 0; m < 4; ++m) { const int row = row0 + ai * HALF + m * 16; const float s = rs[row]; bf16_t* rowp = O + (size_t)row * ldc + col0;
#pragma unroll
                for (int bj = 0; bj < 2; ++bj) { const f32x4 v0 = acc[ai][bj][m][0] * s, v1 = acc[ai][bj][m][1] * s;
                    u32x4 w; w.x = cvt_pk_bf16(v0[0], v0[1]); w.y = cvt_pk_bf16(v0[2], v0[3]); w.z = cvt_pk_bf16(v1[0], v1[1]); w.w = cvt_pk_bf16(v1[2], v1[3]);
                    *(u32x4*)(rowp + bj * HALF) = w; } }
    }
};
template <int MODE> struct EpiGate {
    static constexpr bool PERM = true, AFTER_DRAIN = false;
    float* C; bf16_t* O; int ldc; const bf16_t* G; int ldg;
    __device__ __forceinline__ void operator()(const f32x4 (&acc)[2][2][4][2], const Unit& u, int wr, int wc, int fr, int fq) const {
        const int row0 = u.pm * BM + wr * 64 + fr, col0 = u.pn * BM + wc * 32 + 8 * fq;
#pragma unroll
        for (int ai = 0; ai < 2; ++ai)
#pragma unroll
            for (int m = 0; m < 4; ++m) { const int row = row0 + ai * HALF + m * 16;
#pragma unroll
                for (int bj = 0; bj < 2; ++bj) { const int col = col0 + bj * HALF;
                    const u32x4 gw = *(const u32x4*)(G + (size_t)row * ldg + col);
                    f32x4 g0, g1; g0[0] = sigm(bflo(gw.x)); g0[1] = sigm(bfhi(gw.x)); g0[2] = sigm(bflo(gw.y)); g0[3] = sigm(bfhi(gw.y));
                    g1[0] = sigm(bflo(gw.z)); g1[1] = sigm(bfhi(gw.z)); g1[2] = sigm(bflo(gw.w)); g1[3] = sigm(bfhi(gw.w));
                    float* cp = C + (size_t)row * ldc + col;
                    if (MODE == 0) { *(f32x4*)cp = acc[ai][bj][m][0] * g0; *(f32x4*)(cp + 4) = acc[ai][bj][m][1] * g1; }
                    else { const f32x4 v0 = *(const f32x4*)cp + acc[ai][bj][m][0] * g0, v1 = *(const f32x4*)(cp + 4) + acc[ai][bj][m][1] * g1;
                        u32x4 w; w.x = cvt_pk_bf16(v0[0], v0[1]); w.y = cvt_pk_bf16(v0[2], v0[3]); w.z = cvt_pk_bf16(v1[0], v1[1]); w.w = cvt_pk_bf16(v1[2], v1[3]);
                        *(u32x4*)(O + (size_t)row * ldc + col) = w; } } }
    }
};
struct EpiResF32 {
    static constexpr bool PERM = true, AFTER_DRAIN = false;
    const float* res; float* out; int ldc, npn;
    __device__ __forceinline__ void operator()(const f32x4 (&acc)[2][2][4][2], const Unit& u, int wr, int wc, int fr, int fq) const {
        const int row0 = u.pm * BM + wr * 64 + fr, col0 = (u.pn % npn) * BM + wc * 32 + 8 * fq;
#pragma unroll
        for (int ai = 0; ai < 2; ++ai)
#pragma unroll
            for (int m = 0; m < 4; ++m) { const size_t off = (size_t)(row0 + ai * HALF + m * 16) * ldc + col0;
#pragma unroll
                for (int bj = 0; bj < 2; ++bj) { f32x4 v0 = acc[ai][bj][m][0], v1 = acc[ai][bj][m][1];
                    if (res) { v0 += *(const f32x4*)(res + off + bj * HALF); v1 += *(const f32x4*)(res + off + bj * HALF + 4); }
                    *(f32x4*)(out + off + bj * HALF) = v0; *(f32x4*)(out + off + bj * HALF + 4) = v1; } }
    }
};
struct EpiSwiGLU {
    static constexpr bool PERM = true, AFTER_DRAIN = false;
    bf16_t* O; int ldc, npn; const float* rs;
    __device__ __forceinline__ void operator()(const f32x4 (&acc)[2][2][4][2], const Unit& u, int wr, int wc, int fr, int fq) const {
        const int row0 = u.pm * BM + wr * 64 + fr, col0 = (u.pn % npn) * HALF + wc * 32 + 8 * fq;
#pragma unroll
        for (int ai = 0; ai < 2; ++ai)
#pragma unroll
            for (int m = 0; m < 4; ++m) { const int row = row0 + ai * HALF + m * 16; const float r = rs[row];
                float o[8];
#pragma unroll
                for (int n = 0; n < 2; ++n)
#pragma unroll
                    for (int j = 0; j < 4; ++j) { const float a1 = acc[ai][0][m][n][j] * r, a3 = acc[ai][1][m][n][j] * r; o[4 * n + j] = silu(a1) * a3; }
                u32x4 w; w.x = cvt_pk_bf16(o[0], o[1]); w.y = cvt_pk_bf16(o[2], o[3]); w.z = cvt_pk_bf16(o[4], o[5]); w.w = cvt_pk_bf16(o[6], o[7]);
                *(u32x4*)(O + (size_t)row * ldc + col0) = w; }
    }
};
struct MoeOrder {
    int G, c, nN; int t0, t1, t2, t3, t4, t5, t6, t7, t8;
    __device__ __forceinline__ bool next(int i, Unit& u) const {
        const long L = (long)i * G + c; if (L >= (long)t8 * nN) return false;
        int ts = t0, te = t1;
        if (L >= (long)t1 * nN) { ts = t1; te = t2; } if (L >= (long)t2 * nN) { ts = t2; te = t3; } if (L >= (long)t3 * nN) { ts = t3; te = t4; } if (L >= (long)t4 * nN) { ts = t4; te = t5; }
        if (L >= (long)t5 * nN) { ts = t5; te = t6; } if (L >= (long)t6 * nN) { ts = t6; te = t7; } if (L >= (long)t7 * nN) { ts = t7; te = t8; }
        int e = 0; e += (L >= (long)t1 * nN); e += (L >= (long)t2 * nN); e += (L >= (long)t3 * nN); e += (L >= (long)t4 * nN); e += (L >= (long)t5 * nN); e += (L >= (long)t6 * nN); e += (L >= (long)t7 * nN);
        const int Ll = (int)(L - (long)ts * nN), Te = te - ts;
        u.pm = ts + Ll % Te; u.pn = e * nN + Ll / Te; return true;
    }
    __device__ __forceinline__ void a_ready(const Unit&) const {}
    __device__ __forceinline__ void done(const Unit&) const {}
};
template <class Epi, class Sched, bool ALIGN_EPI = false, bool SP2 = false>
__device__ __forceinline__ void gemm_phase(PG8_LAS unsigned char* lds, const Gemm g, const Sched& S, const Epi& E) {
    int tid_ = threadIdx.x; asm volatile("" : "+v"(tid_));
    const int tid = tid_, wid = __builtin_amdgcn_readfirstlane(tid >> 6), lane = tid & 63, wr = wid >> 2, wc = wid & 3, fr = lane & 15, fq = lane >> 4;
    const int K = g.K, nt = K / BK;
    unsigned voffA[2], voffB[2];
#pragma unroll
    for (int i = 0; i < 2; ++i) { int R, C; stage_rc(tid * 16 + i * 8192, R, C); const int Rb = Epi::PERM ? ((R & ~31) + perm32(R & 31)) : R;
        voffA[i] = (unsigned)(R * g.lda + C) * 2u; voffB[i] = (unsigned)(Rb * K + C) * 2u; }
    const size_t kstep = (size_t)(BK * 2);
    const size_t hstepB = (size_t)HALF * K * 2, hstepA = (size_t)HALF * g.lda * 2;
    const size_t tstepA = 2 * hstepA, tstepB = 2 * hstepB;
    const unsigned ldsw = (unsigned)wid * 1024u;
    const int aoff = lds_byte(wr * 64 + fr, fq * 8), boff = lds_byte(wc * 32 + fr, fq * 8);
#define PG8_SA(b, h) (((b) * 2 + (h)) * HTB)
#define PG8_SB(b, h) ((4 + (b) * 2 + (h)) * HTB)
#define PG8_STAGE(bufoff, gbase, voff) do { _Pragma("unroll") for (int _i = 0; _i < 2; ++_i) \
        __builtin_amdgcn_global_load_lds((const unsigned*)((const char*)(gbase) + (voff)[_i]), (PG8_LAS unsigned*)(lds + (bufoff) + ldsw + _i * 8192), 16, 0, 0); } while (0)
#define PG8_LDA(dst, b, h) do { _Pragma("unroll") for (int m = 0; m < 4; ++m) _Pragma("unroll") for (int k = 0; k < 2; ++k) dst[m][k] = *(const PG8_LAS bf16x8*)(lds + PG8_SA(b, h) + aoff + m * 2048 + k * 1024); } while (0)
#define PG8_LDB(dst, b, h) do { _Pragma("unroll") for (int n = 0; n < 2; ++n) _Pragma("unroll") for (int k = 0; k < 2; ++k) dst[n][k] = *(const PG8_LAS bf16x8*)(lds + PG8_SB(b, h) + boff + n * 2048 + k * 1024); } while (0)
#define PG8_MMA(ai, bj, At, Bt) do { __builtin_amdgcn_s_setprio(1); _Pragma("unroll") for (int m = 0; m < 4; ++m) _Pragma("unroll") for (int n = 0; n < 2; ++n) _Pragma("unroll") for (int k = 0; k < 2; ++k) \
        acc[ai][bj][m][n] = __builtin_amdgcn_mfma_f32_16x16x32_bf16(Bt[n][k], At[m][k], acc[ai][bj][m][n], 0, 0, 0); __builtin_amdgcn_s_setprio(0); } while (0)
#define PG8_WAIT_V(n) asm volatile("s_waitcnt vmcnt(" #n ")" ::: "memory")
#define PG8_WAIT_L(n) asm volatile("s_waitcnt lgkmcnt(" #n ")" ::: "memory")
#define PG8_BAR __builtin_amdgcn_s_barrier()
#define PG8_SCHED __builtin_amdgcn_sched_barrier(0)
    Unit cur, nxt; int ui = 0;
    if (!S.next(0, cur)) return;
    f32x4 acc[2][2][4][2];
#pragma unroll
    for (int a = 0; a < 2; ++a)
#pragma unroll
        for (int b = 0; b < 2; ++b)
#pragma unroll
            for (int m = 0; m < 4; ++m)
#pragma unroll
                for (int n = 0; n < 2; ++n) acc[a][b][m][n] = (f32x4){0.f, 0.f, 0.f, 0.f};
    bf16x8 At[4][2], B0[2][2], B1[2][2];
    const char* cA = (const char*)g.A + (size_t)cur.pm * tstepA; const char* cB = (const char*)g.Bt + (size_t)cur.pn * tstepB;
    S.a_ready(cur);
    if constexpr (SP2) {
        PG8_STAGE(PG8_SB(0, 0), cB, voffB); PG8_STAGE(PG8_SB(0, 1), cB + hstepB, voffB); PG8_STAGE(PG8_SA(0, 0), cA, voffA); PG8_STAGE(PG8_SA(0, 1), cA + hstepA, voffA);
        if (wr == 1) PG8_BAR;
        PG8_WAIT_V(2); PG8_BAR;
        PG8_STAGE(PG8_SB(1, 0), cB + kstep, voffB); PG8_STAGE(PG8_SA(1, 0), cA + kstep, voffA); PG8_STAGE(PG8_SB(1, 1), cB + hstepB + kstep, voffB);
        PG8_WAIT_V(6); PG8_BAR;
    } else {
        PG8_STAGE(PG8_SB(0, 0), cB, voffB); PG8_STAGE(PG8_SA(0, 0), cA, voffA); PG8_STAGE(PG8_SB(0, 1), cB + hstepB, voffB); PG8_STAGE(PG8_SA(0, 1), cA + hstepA, voffA);
        if (wr == 1) PG8_BAR;
        PG8_WAIT_V(4); PG8_BAR;
        PG8_STAGE(PG8_SB(1, 0), cB + kstep, voffB); PG8_STAGE(PG8_SA(1, 0), cA + kstep, voffA); PG8_STAGE(PG8_SB(1, 1), cB + hstepB + kstep, voffB);
        PG8_WAIT_V(6); PG8_BAR;
    }
    for (;;) {
        const bool has_next = S.next(ui + 1, nxt);
        const char* nA = has_next ? (const char*)g.A + (size_t)nxt.pm * tstepA : cA; const char* nB = has_next ? (const char*)g.Bt + (size_t)nxt.pn * tstepB : cB;
        for (int t = 0; t < nt; t += 2) {
            const bool last = (t == nt - 2);
            const char* a1 = cA + (size_t)(t + 1) * kstep;
            const char* a2 = last ? nA : cA + (size_t)(t + 2) * kstep; const char* b2 = last ? nB : cB + (size_t)(t + 2) * kstep;
            const char* a3 = a2 + kstep; const char* b3 = b2 + kstep;
            if (last && has_next) S.a_ready(nxt);
            if constexpr (SP2) {
            PG8_LDB(B0, 0, 0); PG8_LDB(B1, 0, 1); PG8_SCHED; PG8_LDA(At, 0, 0); PG8_STAGE(PG8_SA(1, 1), a1 + hstepA, voffA);
            PG8_WAIT_V(8); PG8_WAIT_L(0); PG8_BAR; PG8_MMA(0, 0, At, B0); PG8_MMA(0, 1, At, B1); PG8_BAR; PG8_SCHED;
            PG8_LDA(At, 0, 1); PG8_STAGE(PG8_SB(0, 0), b2, voffB); PG8_STAGE(PG8_SB(0, 1), b2 + hstepB, voffB); PG8_STAGE(PG8_SA(0, 0), a2, voffA);
            PG8_WAIT_V(8); PG8_WAIT_L(0); PG8_BAR; PG8_MMA(1, 0, At, B0); PG8_MMA(1, 1, At, B1); PG8_BAR; PG8_SCHED;
            PG8_LDB(B0, 1, 0); PG8_LDB(B1, 1, 1); PG8_SCHED; PG8_LDA(At, 1, 0); PG8_STAGE(PG8_SA(0, 1), a2 + hstepA, voffA);
            PG8_WAIT_V(8); PG8_WAIT_L(0); PG8_BAR; PG8_MMA(0, 0, At, B0); PG8_MMA(0, 1, At, B1); PG8_BAR; PG8_SCHED;
            PG8_LDA(At, 1, 1); PG8_STAGE(PG8_SB(1, 0), b3, voffB); PG8_STAGE(PG8_SB(1, 1), b3 + hstepB, voffB); PG8_STAGE(PG8_SA(1, 0), a3, voffA);
            PG8_WAIT_V(8); PG8_WAIT_L(0); PG8_BAR; PG8_MMA(1, 0, At, B0); PG8_MMA(1, 1, At, B1); PG8_BAR; PG8_SCHED;
            } else {
            PG8_LDB(B0, 0, 0); PG8_SCHED; PG8_LDA(At, 0, 0); PG8_STAGE(PG8_SA(1, 1), a1 + hstepA, voffA);
            PG8_WAIT_L(8); PG8_BAR; PG8_WAIT_L(0); PG8_MMA(0, 0, At, B0); PG8_BAR; PG8_SCHED;
            PG8_LDB(B1, 0, 1); PG8_STAGE(PG8_SB(0, 0), b2, voffB);
            PG8_BAR; PG8_WAIT_L(0); PG8_MMA(0, 1, At, B1); PG8_BAR;
            PG8_LDA(At, 0, 1); PG8_STAGE(PG8_SA(0, 0), a2, voffA);
            PG8_BAR; PG8_WAIT_L(0); PG8_MMA(1, 0, At, B0); PG8_BAR; PG8_SCHED;
            PG8_STAGE(PG8_SB(0, 1), b2 + hstepB, voffB);
            PG8_WAIT_V(6); PG8_BAR; PG8_MMA(1, 1, At, B1); PG8_BAR;
            PG8_LDB(B0, 1, 0); PG8_SCHED; PG8_LDA(At, 1, 0); PG8_STAGE(PG8_SA(0, 1), a2 + hstepA, voffA);
            PG8_WAIT_L(8); PG8_BAR; PG8_WAIT_L(0); PG8_MMA(0, 0, At, B0); PG8_BAR; PG8_SCHED;
            PG8_LDB(B1, 1, 1); PG8_STAGE(PG8_SB(1, 0), b3, voffB);
            PG8_BAR; PG8_WAIT_L(0); PG8_MMA(0, 1, At, B1); PG8_BAR;
            PG8_LDA(At, 1, 1); PG8_STAGE(PG8_SA(1, 0), a3, voffA);
            PG8_BAR; PG8_WAIT_L(0); PG8_MMA(1, 0, At, B0); PG8_BAR; PG8_SCHED;
            PG8_STAGE(PG8_SB(1, 1), b3 + hstepB, voffB);
            PG8_WAIT_V(6); PG8_BAR; PG8_MMA(1, 1, At, B1); PG8_BAR;
            }
        }
        if constexpr (ALIGN_EPI) { if (wr == 0) PG8_BAR; }
        if constexpr (!Epi::AFTER_DRAIN) { E(acc, cur, wr, wc, fr, fq); S.done(cur); }
        if (!has_next) break;
#pragma unroll
        for (int a = 0; a < 2; ++a)
#pragma unroll
            for (int b = 0; b < 2; ++b)
#pragma unroll
                for (int m = 0; m < 4; ++m)
#pragma unroll
                    for (int n = 0; n < 2; ++n) acc[a][b][m][n] = (f32x4){0.f, 0.f, 0.f, 0.f};
        cur = nxt; cA = nA; cB = nB; ++ui;
        if constexpr (ALIGN_EPI) { if (wr == 1) PG8_BAR; }
    }
    PG8_WAIT_V(0);
    if constexpr (!ALIGN_EPI) { if (wr == 0) PG8_BAR; }
    PG8_BAR;
    if constexpr (Epi::AFTER_DRAIN) { E.fused(acc, cur, wr, wc, fr, fq, lds, wid, lane); S.done(cur); }
#undef PG8_SA
#undef PG8_SB
#undef PG8_STAGE
#undef PG8_LDA
#undef PG8_LDB
#undef PG8_MMA
#undef PG8_WAIT_V
#undef PG8_WAIT_L
#undef PG8_BAR
#undef PG8_SCHED
}
}

#define GAS __attribute__((address_space(1)))
#define LAS __attribute__((address_space(3)))
typedef unsigned short bf16;
typedef unsigned v4u __attribute__((ext_vector_type(4)));
typedef float f32x4 __attribute__((ext_vector_type(4)));
typedef short bf16x8 __attribute__((ext_vector_type(8)));
typedef GAS unsigned gu32;
typedef GAS unsigned long long gu64;
#define RLX_AGENT __ATOMIC_RELAXED, __HIP_MEMORY_SCOPE_AGENT
#define LDS_WAIT() asm volatile("s_waitcnt lgkmcnt(0)" ::: "memory")
#define VM_WAIT() asm volatile("s_waitcnt vmcnt(0)" ::: "memory")
__device__ __forceinline__ unsigned long long rt() { return __builtin_amdgcn_s_memrealtime(); }
__device__ __forceinline__ unsigned f2bf(float f) { unsigned u = __builtin_bit_cast(unsigned, f); return (u + 0x7fffu + ((u >> 16) & 1u)) >> 16; }
__device__ __forceinline__ unsigned pk2(float lo, float hi) { return f2bf(lo) | (f2bf(hi) << 16); }

#define XB_TMO      128
#define XB_XCNT(j)  (256  + 64 * (j))
#define XB_XSUB(j)  (1280 + 64 * (j))
#define XB_XGEN(j)  (2304 + 64 * (j))
#define XB_TOP      3328
#define XB_TOPGEN   3392
#define XCD_BAR_WORDS 3456
#define XB_SPIN_CAP (1u << 18)

__device__ __forceinline__ unsigned xb_ld(unsigned* p)              { return __hip_atomic_load(p, __ATOMIC_RELAXED, __HIP_MEMORY_SCOPE_AGENT); }
__device__ __forceinline__ unsigned xb_add(unsigned* p, unsigned v) { return __hip_atomic_fetch_add(p, v, __ATOMIC_RELAXED, __HIP_MEMORY_SCOPE_AGENT); }
__device__ __forceinline__ unsigned xb_xcc_id() { return (unsigned)__builtin_amdgcn_s_getreg((3 << 11) | 20) & 0xFu; }
#define XB_SPIN(cond, bar) do { unsigned _sp = 0; while (cond) { __builtin_amdgcn_s_sleep(1); \
    if ((++_sp & 255u) == 0u) { if (xb_ld(&(bar)[XB_TMO])) break; if (_sp > XB_SPIN_CAP) { atomicAdd(&(bar)[XB_TMO], 1u); break; } } } } while (0)

struct XcdBarrier {
    unsigned* bar; unsigned x;
    volatile LAS unsigned* st;
};

__device__ __forceinline__ XcdBarrier xcd_barrier_post(unsigned* bar, volatile LAS unsigned* st) {
    XcdBarrier b; b.bar = bar; b.x = xb_xcc_id(); b.st = st;
    if (threadIdx.x == 0) (void)xb_add(&bar[XB_XCNT(b.x)], 1u);
    return b;
}
__device__ __forceinline__ void xcd_barrier_complete(unsigned* bar, unsigned x, unsigned& nloc, unsigned& nx) {
    const unsigned G = gridDim.x * gridDim.y * gridDim.z;
    unsigned sum, cnt, mine, sp = 0u;
    for (;;) {
        sum = 0u; cnt = 0u; mine = 0u;
#pragma unroll
        for (unsigned j = 0; j < 16; ++j) { const unsigned c = xb_ld(&bar[XB_XCNT(j)]); sum += c; cnt += (c > 0u) ? 1u : 0u; mine = (j == x) ? c : mine; }
        if (sum == G) break;
        __builtin_amdgcn_s_sleep(1);
        if ((++sp & 255u) == 0u) { if (xb_ld(&bar[XB_TMO])) break; if (sp > XB_SPIN_CAP) { atomicAdd(&bar[XB_TMO], 1u); break; } }
    }
    nloc = mine > 0u ? mine : 1u; nx = cnt > 0u ? cnt : 1u;
}

__device__ __forceinline__ void xcd_barrier(const XcdBarrier& b) {
    asm volatile("s_waitcnt vmcnt(0)" ::: "memory");
    __syncthreads();
    if (threadIdx.x == 0) {
        unsigned* bar = b.bar;
        __builtin_amdgcn_s_waitcnt(0);
        unsigned nloc = b.st[0], nx = b.st[1];
        if (nloc == 0u) { xcd_barrier_complete(bar, b.x, nloc, nx); b.st[0] = nloc; b.st[1] = nx; }
        const unsigned old = xb_add(&bar[XB_XSUB(b.x)], 1u);
        const unsigned gen = old / nloc;
        if (old + 1u == (gen + 1u) * nloc) {
            __builtin_amdgcn_fence(__ATOMIC_RELEASE, "agent");
            asm volatile("s_waitcnt vmcnt(0)" ::: "memory");
            const unsigned og = xb_add(&bar[XB_TOP], 1u);
            const unsigned tg = og / nx;
            if (og + 1u == (tg + 1u) * nx) xb_add(&bar[XB_TOPGEN], 1u);
            else XB_SPIN(xb_ld(&bar[XB_TOPGEN]) == tg, bar);
            __builtin_amdgcn_fence(__ATOMIC_ACQUIRE, "agent");
            xb_add(&bar[XB_XGEN(b.x)], 1u);
            asm volatile("s_waitcnt vmcnt(0)" ::: "memory");
        } else {
            XB_SPIN(xb_ld(&bar[XB_XGEN(b.x)]) == gen, bar);
            __builtin_amdgcn_fence(__ATOMIC_ACQUIRE, "agent");
            asm volatile("s_waitcnt vmcnt(0)" ::: "memory");
        }
    }
    __syncthreads();
}

constexpr int NWAVES = 8;
constexpr int BATCH = 8, T = 2048, D = 2048, M = BATCH * T;
constexpr int NPROJ = 10320, NPROJ_P = 10496;
constexpr int C_Q = 0, C_K = 1024, C_V = 1280, C_CQ = 1536, C_KID = 2048, C_WID = 2112, C_HQ = 2128, C_HF = 3152, C_HI = 4176, C_HG = 5200, C_GA = 6224, C_GH = 8272;
constexpr int FFD = 5632, FFE = 7168, NEXP = 8;
constexpr int MS = 34816;
constexpr float EPS = 1e-6f;
constexpr float ATT_SCALE = 0.08838834764831845f;
constexpr float IDX_WSCALE = 0.25f * 0.125f;
constexpr int NSEL = 256;

constexpr size_t MiB = 1u << 20;
constexpr size_t WS_CTL = 0, CTL_ZERO_BYTES = 1 * MiB;
constexpr size_t WS_WIN = 2 * MiB, WIN_SZ = 41 * MiB;
constexpr size_t WS_WIDX = 84 * MiB, WIDX_SZ = 1 * MiB;
constexpr size_t WS_WUA = 86 * MiB, WS_WUH = 94 * MiB, WU_SZ = 4 * MiB;
constexpr size_t WS_WO = 102 * MiB, WO_SZ = 8 * MiB;
constexpr size_t WS_W13D = 118 * MiB, WS_W2D = 162 * MiB;
constexpr size_t WS_W13M = 184 * MiB, WS_W2M = 632 * MiB;
constexpr size_t WS_XB = 856 * MiB;
constexpr size_t WS_PROJ = 920 * MiB;
constexpr size_t WS_QN = 1248 * MiB, WS_QIDX = 1280 * MiB, WS_KN = 1312 * MiB, WS_KIDX = 1320 * MiB, WS_WIDXV = 1322 * MiB, WS_MASK = 1323 * MiB;
constexpr size_t WS_RSTD1 = 1327 * MiB, WS_RSTDCQ = WS_RSTD1 + 65536;
constexpr size_t WS_MIX = 1328 * MiB;
constexpr size_t WS_TMP = 1392 * MiB;
constexpr size_t WS_MRG = 1520 * MiB;
constexpr size_t WS_H = 1584 * MiB;
constexpr size_t WS_ACTM = 920 * MiB;
constexpr size_t WS_Y = 1396 * MiB, WS_HS = 1396 * MiB;
constexpr size_t WS_TAB = 1712 * MiB;
constexpr size_t TAB_RSTD2 = 0, TAB_RSTDS = 1 * 65536, TAB_TOKE = 4 * 65536, TAB_TOKPOS = 6 * 65536, TAB_TOKP = 8 * 65536, TAB_TOKDEST = 10 * 65536;
constexpr size_t WS_END = 1714 * MiB;
static_assert(WS_WIN + 2 * WIN_SZ <= WS_WIDX && WS_W2M + 8ull * 2048 * 7168 * 2 <= WS_XB && WS_PROJ + (size_t)M * NPROJ_P * 2 <= WS_QN && WS_ACTM + (size_t)MS * FFE * 2 <= WS_Y && WS_Y + (size_t)MS * 2048 * 4 <= WS_TAB && WS_H + (size_t)M * D * 4 <= WS_TAB && WS_MRG + (size_t)M * D * 2 <= WS_H && WS_TMP + (size_t)M * D * 4 <= WS_MRG && WS_MIX + (size_t)M * D * 2 <= WS_TMP && WS_RSTDCQ + 65536 <= WS_MIX && WS_XB + (size_t)M * D * 2 <= WS_PROJ && WS_TAB + 12 * 65536 <= WS_END, "ws map");
constexpr int CW_BAR = 4096;
constexpr int CW_ECNT = 16384;

constexpr int RING_OFF = 0, RING_BYTES = 131072;
constexpr int LDSCTL_OFF = 135168, MISC_OFF = LDSCTL_OFF + 320;
constexpr int LDS_BYTES = 147456;

__device__ const unsigned char BUCKET[129] = {0, 1, 2, 3, 4, 5, 6, 7, 8, 9, 10, 11, 12, 13, 14, 15, 16, 16, 16, 17, 17, 18, 18, 18, 19, 19, 19, 20, 20, 20, 20, 21, 21, 21, 21, 22, 22, 22, 22, 22, 23, 23, 23, 23, 23, 23, 24, 24, 24, 24, 24, 24, 25, 25, 25, 25, 25, 25, 25, 26, 26, 26, 26, 26, 26, 26, 26, 27, 27, 27, 27, 27, 27, 27, 27, 27, 27, 28, 28, 28, 28, 28, 28, 28, 28, 28, 28, 29, 29, 29, 29, 29, 29, 29, 29, 29, 29, 29, 29, 30, 30, 30, 30, 30, 30, 30, 30, 30, 30, 30, 30, 30, 30, 31, 31, 31, 31, 31, 31, 31, 31, 31, 31, 31, 31, 31, 31, 31, 31};

typedef unsigned v2u __attribute__((ext_vector_type(2)));
struct Args { const float* in[23]; float* out; unsigned char* ws; int ph_lo, ph_hi; };
typedef const __attribute__((address_space(4))) Args* KA;
__device__ __forceinline__ KA ka_get() { KA p = (KA)__builtin_amdgcn_kernarg_segment_ptr(); asm volatile("" : "+s"(p)); return p; }

struct Frame {
    LAS unsigned char* lds;
    int tid, lane, wave, G, bid;
};
__device__ __forceinline__ Frame make_frame(LAS unsigned char* lds) {
    Frame F; int t = threadIdx.x; asm volatile("" : "+v"(t)); int b = blockIdx.x, g = gridDim.x; asm volatile("" : "+s"(b), "+s"(g));
    F.lds = lds; F.tid = t; F.lane = t & 63; F.wave = __builtin_amdgcn_readfirstlane(t >> 6); F.G = g; F.bid = b; return F;
}
__device__ __forceinline__ bool in_range(int k, int lo, int hi) { asm volatile("" : "+s"(k)); return lo <= k && k < hi; }
__device__ __forceinline__ float wave_sum(float v) {
#pragma unroll
    for (int o = 1; o < 64; o <<= 1) v += __shfl_xor(v, o);
    return v;
}
__device__ __forceinline__ float wave_max(float v) {
#pragma unroll
    for (int o = 1; o < 64; o <<= 1) v = fmaxf(v, __shfl_xor(v, o));
    return v;
}
__device__ __forceinline__ float bf2f(bf16 v) { return __builtin_bit_cast(float, (unsigned)v << 16); }
__device__ __forceinline__ float blo(unsigned w) { return __builtin_bit_cast(float, w << 16); }
__device__ __forceinline__ float bhi(unsigned w) { return __builtin_bit_cast(float, w & 0xffff0000u); }
__device__ __forceinline__ float sigmf(float x) { return 1.0f / (1.0f + __expf(-x)); }
__device__ __forceinline__ float siluf(float x) { return x / (1.0f + __expf(-x)); }

struct ConvD { const float* src; bf16* dst; const float* gain; int K, N, Npad, nb; size_t sstride, dstride; int grp, gstride, goff; };
__device__ __forceinline__ void get_conv(int id, KA a, ConvD& d) {
    const int l = id >> 3, k = id & 7;
    bf16* ws16 = (bf16*)a->ws;
    d.gain = nullptr; d.nb = 1; d.sstride = 0; d.dstride = 0; d.grp = 1 << 30; d.gstride = 0; d.goff = 0;
    if (k == 0) { d.src = a->in[4] + (size_t)l * 2048 * NPROJ; d.dst = (bf16*)(a->ws + WS_WIN + l * WIN_SZ); d.gain = a->in[2] + l * 2048; d.K = 2048; d.N = NPROJ; d.Npad = NPROJ_P; }
    else if (k == 1) { d.src = a->in[8] + (size_t)l * 512 * 1024; d.dst = (bf16*)(a->ws + WS_WIDX + l * WIDX_SZ); d.gain = a->in[7] + l * 512; d.K = 512; d.N = 1024; d.Npad = 1024; }
    else if (k == 2) { d.src = a->in[13] + (size_t)l * 1024 * 2048; d.dst = (bf16*)(a->ws + WS_WUA + l * WU_SZ); d.K = 1024; d.N = 2048; d.Npad = 2048; }
    else if (k == 3) { d.src = a->in[14] + (size_t)l * 1024 * 2048; d.dst = (bf16*)(a->ws + WS_WUH + l * WU_SZ); d.K = 1024; d.N = 2048; d.Npad = 2048; }
    else if (k == 4) { d.src = a->in[15] + (size_t)l * 2048 * 2048; d.dst = (bf16*)(a->ws + WS_WO + l * WO_SZ); d.K = 2048; d.N = 2048; d.Npad = 2048; }
    else if (l == 0) {
        if (k == 5) { d.src = a->in[16]; d.dst = (bf16*)(a->ws + WS_W13D); d.gain = a->in[3]; d.K = 2048; d.N = FFD; d.Npad = FFD; d.grp = 128; d.gstride = 256; d.goff = 0; }
        else if (k == 6) { d.src = a->in[17]; d.dst = (bf16*)(a->ws + WS_W13D); d.gain = a->in[3]; d.K = 2048; d.N = FFD; d.Npad = FFD; d.grp = 128; d.gstride = 256; d.goff = 128; }
        else { d.src = a->in[18]; d.dst = (bf16*)(a->ws + WS_W2D); d.K = FFD; d.N = 2048; d.Npad = 2048; }
    } else {
        if (k == 5) { d.src = a->in[20]; d.dst = (bf16*)(a->ws + WS_W13M); d.gain = a->in[3] + 2048; d.K = 2048; d.N = FFE; d.Npad = FFE; d.nb = NEXP; d.sstride = (size_t)2048 * FFE; d.dstride = (size_t)2 * FFE * 2048; d.grp = 128; d.gstride = 256; d.goff = 0; }
        else if (k == 6) { d.src = a->in[21]; d.dst = (bf16*)(a->ws + WS_W13M); d.gain = a->in[3] + 2048; d.K = 2048; d.N = FFE; d.Npad = FFE; d.nb = NEXP; d.sstride = (size_t)2048 * FFE; d.dstride = (size_t)2 * FFE * 2048; d.grp = 128; d.gstride = 256; d.goff = 128; }
        else { d.src = a->in[22]; d.dst = (bf16*)(a->ws + WS_W2M); d.K = FFE; d.N = 2048; d.Npad = 2048; d.nb = NEXP; d.sstride = (size_t)FFE * 2048; d.dstride = (size_t)2048 * FFE; }
    }
    (void)ws16;
}
__device__ __forceinline__ void conv_item(const ConvD& d, long item, LAS float* scr, int lane) {
    const int nblk = d.Npad / 64, kblk = d.K / 64; const long per = (long)kblk * nblk;
    const int e = (int)(item / per); const int r = (int)(item - (long)e * per); const int kb = r / nblk, nbi = r - kb * nblk, k0 = 64 * kb, n0 = 64 * nbi;
    const float* src = d.src + (size_t)e * d.sstride; bf16* dst = d.dst + (size_t)e * d.dstride;
    const int nn = (lane & 15) * 4, kq = lane >> 4;
    f32x4 v[16];
#pragma unroll
    for (int i = 0; i < 16; ++i) { const int kk = 4 * i + kq; v[i] = (n0 + nn < d.N) ? *(const GAS f32x4*)(src + (size_t)(k0 + kk) * d.N + n0 + nn) : (f32x4){0.f, 0.f, 0.f, 0.f}; }
#pragma unroll
    for (int i = 0; i < 16; ++i) { const int kk = 4 * i + kq; LAS float* p = scr + kk * 65 + nn; p[0] = v[i][0]; p[1] = v[i][1]; p[2] = v[i][2]; p[3] = v[i][3]; }
    LDS_WAIT(); asm volatile("" ::: "memory");
    const int c = lane & 7;
    float g[8];
#pragma unroll
    for (int i = 0; i < 8; ++i) g[i] = d.gain ? d.gain[k0 + 8 * c + i] : 1.0f;
#pragma unroll
    for (int j = 0; j < 8; ++j) { const int n = (lane >> 3) + 8 * j; const LAS float* s = scr + (8 * c) * 65 + n;
        v4u o; o.x = pk2(s[0 * 65] * g[0], s[1 * 65] * g[1]); o.y = pk2(s[2 * 65] * g[2], s[3 * 65] * g[3]); o.z = pk2(s[4 * 65] * g[4], s[5 * 65] * g[5]); o.w = pk2(s[6 * 65] * g[6], s[7 * 65] * g[7]);
        const int ng = n0 + n; const int row = (ng / d.grp) * d.gstride + d.goff + (ng % d.grp);
        *(GAS v4u*)(dst + (size_t)row * d.K + k0 + 8 * c) = o; }
    LDS_WAIT(); asm volatile("" ::: "memory");
}
__device__ __forceinline__ void phase_conv(Frame& F, KA a) {
    LAS float* scr = (LAS float*)(F.lds + F.wave * 16640);
    const long gw = (long)F.bid * NWAVES + F.wave, NGW = (long)F.G * NWAVES;
    long base = 0;
#pragma unroll 1
    for (int id = 0; id < 16; ++id) {
        ConvD d; get_conv(id, a, d);
        const long items = (long)d.nb * (d.K / 64) * (d.Npad / 64);
        long first = (gw - base % NGW + NGW) % NGW;
#pragma unroll 1
        for (long it = first; it < items; it += NGW) conv_item(d, it, scr, F.lane);
        base += items;
    }
}

__device__ __forceinline__ void phase_norm(Frame& F, const float* src, bf16* dst, float* rstd) {
    const int gw = F.bid * NWAVES + F.wave, NGW = F.G * NWAVES;
    for (int row = gw; row < M; row += NGW) {
        const GAS f32x4* xr = (const GAS f32x4*)(src + (size_t)row * D) + F.lane;
        f32x4 v[8]; float s = 0.f;
#pragma unroll
        for (int j = 0; j < 8; ++j) { v[j] = xr[64 * j]; s += (v[j].x * v[j].x + v[j].y * v[j].y) + (v[j].z * v[j].z + v[j].w * v[j].w); }
        s = wave_sum(s);
        GAS v2u* o8 = (GAS v2u*)(dst + (size_t)row * D) + F.lane;
#pragma unroll
        for (int j = 0; j < 8; ++j) { v2u w; w.x = pk2(v[j].x, v[j].y); w.y = pk2(v[j].z, v[j].w); o8[64 * j] = w; }
        if (F.lane == 0) rstd[row] = 1.0f / sqrtf(s * (1.0f / D) + EPS);
    }
}

__device__ __forceinline__ void phase_post(Frame& F, KA a, int l) {
    const int gw = F.bid * NWAVES + F.wave, NGW = F.G * NWAVES, lane = F.lane;
    const bf16* proj = (const bf16*)(a->ws + WS_PROJ);
    bf16* qn = (bf16*)(a->ws + WS_QN); bf16* kn = (bf16*)(a->ws + WS_KN); bf16* kidx = (bf16*)(a->ws + WS_KIDX); float* widx = (float*)(a->ws + WS_WIDXV); float* rstdcq = (float*)(a->ws + WS_RSTDCQ);
    const float* qg = a->in[5] + l * 128; const float* kg = a->in[6] + l * 128; const float* lng = a->in[9] + l * 64; const float* lnb = a->in[10] + l * 64;
    for (int row = gw; row < M; row += NGW) {
        const bf16* pr = proj + (size_t)row * NPROJ_P;
        {
            const v4u w0 = *(const GAS v4u*)(pr + C_Q + 16 * lane), w1 = *(const GAS v4u*)(pr + C_Q + 16 * lane + 8);
            float x[16] = {blo(w0.x), bhi(w0.x), blo(w0.y), bhi(w0.y), blo(w0.z), bhi(w0.z), blo(w0.w), bhi(w0.w), blo(w1.x), bhi(w1.x), blo(w1.y), bhi(w1.y), blo(w1.z), bhi(w1.z), blo(w1.w), bhi(w1.w)};
            float ss = 0.f;
#pragma unroll
            for (int i = 0; i < 16; ++i) ss += x[i] * x[i];
            ss += __shfl_xor(ss, 1); ss += __shfl_xor(ss, 2); ss += __shfl_xor(ss, 4);
            const float r = ATT_SCALE / sqrtf(ss * (1.0f / 128.0f) + EPS); const int d0 = (lane & 7) * 16;
            unsigned o[8];
#pragma unroll
            for (int i = 0; i < 8; ++i) o[i] = pk2(x[2 * i] * r * qg[d0 + 2 * i], x[2 * i + 1] * r * qg[d0 + 2 * i + 1]);
            *(GAS v4u*)(qn + (size_t)row * 1024 + 16 * lane) = (v4u){o[0], o[1], o[2], o[3]}; *(GAS v4u*)(qn + (size_t)row * 1024 + 16 * lane + 8) = (v4u){o[4], o[5], o[6], o[7]};
        }
        {
            const v2u w = *(const GAS v2u*)(pr + C_K + 4 * lane);
            const float x0 = blo(w.x), x1 = bhi(w.x), x2 = blo(w.y), x3 = bhi(w.y);
            float ss = x0 * x0 + x1 * x1 + x2 * x2 + x3 * x3;
            ss += __shfl_xor(ss, 1); ss += __shfl_xor(ss, 2); ss += __shfl_xor(ss, 4); ss += __shfl_xor(ss, 8); ss += __shfl_xor(ss, 16);
            const float r = 1.0f / sqrtf(ss * (1.0f / 128.0f) + EPS); const int d0 = (lane & 31) * 4;
            v2u o; o.x = pk2(x0 * r * kg[d0], x1 * r * kg[d0 + 1]); o.y = pk2(x2 * r * kg[d0 + 2], x3 * r * kg[d0 + 3]);
            *(GAS v2u*)(kn + (size_t)row * 256 + 4 * lane) = o;
        }
        {
            const v4u w = *(const GAS v4u*)(pr + C_CQ + 8 * lane);
            const float x[8] = {blo(w.x), bhi(w.x), blo(w.y), bhi(w.y), blo(w.z), bhi(w.z), blo(w.w), bhi(w.w)};
            float ss = 0.f;
#pragma unroll
            for (int i = 0; i < 8; ++i) ss += x[i] * x[i];
            ss = wave_sum(ss);
            if (lane == 0) rstdcq[row] = 1.0f / sqrtf(ss * (1.0f / 512.0f) + EPS);
        }
        {
            const float x = bf2f(pr[C_KID + lane]);
            const float mu = wave_sum(x) * (1.0f / 64.0f); const float dd = x - mu; const float var = wave_sum(dd * dd) * (1.0f / 64.0f);
            const float y = dd / sqrtf(var + EPS) * lng[lane] + lnb[lane];
            kidx[(size_t)row * 64 + lane] = (bf16)f2bf(y);
        }
        if (lane < 16) widx[(size_t)row * 16 + lane] = bf2f(pr[C_WID + lane]) * IDX_WSCALE;
    }
}

__device__ __forceinline__ unsigned ordkey(float v) { const unsigned u = __builtin_bit_cast(unsigned, v); return (u & 0x80000000u) ? ~u : (u | 0x80000000u); }
__device__ __forceinline__ void phase_index(Frame& F, KA a) {
    LAS float* qf = (LAS float*)(F.lds); LAS float* sc = (LAS float*)(F.lds + 32768); LAS float* wf = (LAS float*)(F.lds + 98304);
    const bf16* qidx = (const bf16*)(a->ws + WS_QIDX); const bf16* kidx = (const bf16*)(a->ws + WS_KIDX); const float* widx = (const float*)(a->ws + WS_WIDXV);
    unsigned long long* mask = (unsigned long long*)(a->ws + WS_MASK);
    const int tid = F.tid, lane = F.lane;
    for (int grp = F.bid; grp < M / 8; grp += F.G) {
        const int row0 = grp * 8, b = row0 / T, t0 = row0 % T;
        {
            const v4u w0 = *(const GAS v4u*)(qidx + (size_t)row0 * 1024 + 16 * tid), w1 = *(const GAS v4u*)(qidx + (size_t)row0 * 1024 + 16 * tid + 8);
            LAS f32x4* q4 = (LAS f32x4*)(qf + 16 * tid);
            q4[0] = (f32x4){blo(w0.x), bhi(w0.x), blo(w0.y), bhi(w0.y)}; q4[1] = (f32x4){blo(w0.z), bhi(w0.z), blo(w0.w), bhi(w0.w)};
            q4[2] = (f32x4){blo(w1.x), bhi(w1.x), blo(w1.y), bhi(w1.y)}; q4[3] = (f32x4){blo(w1.z), bhi(w1.z), blo(w1.w), bhi(w1.w)};
            if (tid < 128) wf[tid] = widx[(size_t)row0 * 16 + tid];
        }
        __syncthreads();
        for (int r = 0; r < 4; ++r) {
            const int s = tid + 512 * r;
            if (s <= t0 + 7) {
                float kf[64];
                const GAS v4u* kp = (const GAS v4u*)(kidx + (size_t)(b * T + s) * 64);
#pragma unroll
                for (int c = 0; c < 8; ++c) { const v4u w = kp[c]; kf[8 * c] = blo(w.x); kf[8 * c + 1] = bhi(w.x); kf[8 * c + 2] = blo(w.y); kf[8 * c + 3] = bhi(w.y); kf[8 * c + 4] = blo(w.z); kf[8 * c + 5] = bhi(w.z); kf[8 * c + 6] = blo(w.w); kf[8 * c + 7] = bhi(w.w); }
#pragma unroll 1
                for (int i = 0; i < 8; ++i) {
                    if (s <= t0 + i) {
                        float accs = 0.f;
#pragma unroll 1
                        for (int h = 0; h < 16; ++h) {
                            const LAS f32x4* q4 = (const LAS f32x4*)(qf + i * 1024 + h * 64);
                            float d0 = 0.f, d1 = 0.f;
#pragma unroll
                            for (int c = 0; c < 16; c += 2) { const f32x4 qa = q4[c], qb = q4[c + 1];
                                d0 += qa.x * kf[4 * c] + qa.y * kf[4 * c + 1] + qa.z * kf[4 * c + 2] + qa.w * kf[4 * c + 3];
                                d1 += qb.x * kf[4 * c + 4] + qb.y * kf[4 * c + 5] + qb.z * kf[4 * c + 6] + qb.w * kf[4 * c + 7]; }
                            accs += wf[i * 16 + h] * fmaxf(d0 + d1, 0.f);
                        }
                        sc[i * 2048 + s] = accs;
                    }
                }
            }
        }
        __syncthreads();
        {
            const int w = F.wave, t = t0 + w; const size_t row = (size_t)row0 + w;
            unsigned key[32];
#pragma unroll
            for (int j = 0; j < 32; ++j) { const int s = lane + 64 * j; key[j] = (s <= t) ? ordkey(sc[w * 2048 + s]) : 0u; }
            if (t + 1 <= NSEL) {
#pragma unroll
                for (int j = 0; j < 32; ++j) { const unsigned long long bs = __ballot(key[j] != 0u); if (lane == 0) mask[row * 32 + j] = bs; }
            } else {
                unsigned thr = 0u;
#pragma unroll 1
                for (int bit = 31; bit >= 0; --bit) {
                    const unsigned cand = thr | (1u << bit); int c = 0;
#pragma unroll
                    for (int j = 0; j < 32; ++j) c += __popcll(__ballot(key[j] >= cand));
                    if (c >= NSEL) thr = cand;
                }
                int cgt = 0;
#pragma unroll
                for (int j = 0; j < 32; ++j) cgt += __popcll(__ballot(key[j] > thr));
                const int need = NSEL - cgt; int running = 0;
                const unsigned long long lt = (lane == 0) ? 0ull : (~0ull >> (64 - lane));
#pragma unroll
                for (int j = 0; j < 32; ++j) {
                    const bool eq = key[j] == thr; const unsigned long long be = __ballot(eq);
                    const int rank = running + __popcll(be & lt);
                    const bool sel = (key[j] > thr) || (eq && rank < need);
                    running += __popcll(be);
                    const unsigned long long bs = __ballot(sel); if (lane == 0) mask[row * 32 + j] = bs;
                }
            }
        }
        __syncthreads();
    }
}

__device__ __forceinline__ void phase_attn(Frame& F, KA a) {
    const int lane = F.lane; const int gw = F.bid * NWAVES + F.wave, NGW = F.G * NWAVES;
    LAS unsigned short* list = (LAS unsigned short*)(F.lds + F.wave * 12800);
    LAS float* qf = (LAS float*)(F.lds + F.wave * 12800 + 512);
    LAS float* lg = (LAS float*)(F.lds + F.wave * 12800 + 4608);
    const unsigned* mask = (const unsigned*)(a->ws + WS_MASK);
    const bf16* qn = (const bf16*)(a->ws + WS_QN); const bf16* kn = (const bf16*)(a->ws + WS_KN); const bf16* proj = (const bf16*)(a->ws + WS_PROJ);
    bf16* mix = (bf16*)(a->ws + WS_MIX); const float* relb = a->in[1];
    for (int row = gw; row < M; row += NGW) {
        const int b = row / T, t = row % T;
        const unsigned w = mask[(size_t)row * 64 + lane];
        const int c = __popc(w); int pre = c;
#pragma unroll
        for (int o = 1; o < 64; o <<= 1) { const int v = __shfl_up(pre, o); if (lane >= o) pre += v; }
        const int n = __shfl(pre, 63);
        { int pos = pre - c; unsigned ww = w; while (ww) { const int bit = __ffs(ww) - 1; list[pos++] = (unsigned short)(32 * lane + bit); ww &= ww - 1; } }
        {   const v4u w0 = *(const GAS v4u*)(qn + (size_t)row * 1024 + 16 * lane), w1 = *(const GAS v4u*)(qn + (size_t)row * 1024 + 16 * lane + 8);
            LAS f32x4* q4 = (LAS f32x4*)(qf + 16 * lane);
            q4[0] = (f32x4){blo(w0.x), bhi(w0.x), blo(w0.y), bhi(w0.y)}; q4[1] = (f32x4){blo(w0.z), bhi(w0.z), blo(w0.w), bhi(w0.w)};
            q4[2] = (f32x4){blo(w1.x), bhi(w1.x), blo(w1.y), bhi(w1.y)}; q4[3] = (f32x4){blo(w1.z), bhi(w1.z), blo(w1.w), bhi(w1.w)}; }
        LDS_WAIT(); asm volatile("" ::: "memory");
#pragma unroll 1
        for (int i = 0; i < 4; ++i) {
            const int idx = lane + 64 * i;
            float lgt[8];
#pragma unroll
            for (int h = 0; h < 8; ++h) lgt[h] = -INFINITY;
            if (idx < n) {
                const int s = list[idx]; const int dist = t - s; const int bk = BUCKET[dist < 128 ? dist : 128];
                const bf16* krow = kn + (size_t)(b * T + s) * 256;
#pragma unroll
                for (int g = 0; g < 2; ++g) {
                    float d[4] = {0.f, 0.f, 0.f, 0.f};
#pragma unroll 1
                    for (int c4 = 0; c4 < 4; ++c4) {
                        float kf[32];
#pragma unroll
                        for (int cc = 0; cc < 4; ++cc) { const v4u kw = *(const GAS v4u*)(krow + g * 128 + c4 * 32 + cc * 8);
                            kf[8 * cc] = blo(kw.x); kf[8 * cc + 1] = bhi(kw.x); kf[8 * cc + 2] = blo(kw.y); kf[8 * cc + 3] = bhi(kw.y); kf[8 * cc + 4] = blo(kw.z); kf[8 * cc + 5] = bhi(kw.z); kf[8 * cc + 6] = blo(kw.w); kf[8 * cc + 7] = bhi(kw.w); }
#pragma unroll
                        for (int r = 0; r < 4; ++r) { const LAS f32x4* q4 = (const LAS f32x4*)(qf + (g * 4 + r) * 128 + c4 * 32);
#pragma unroll
                            for (int cc = 0; cc < 8; ++cc) { const f32x4 q = q4[cc]; d[r] += q.x * kf[4 * cc] + q.y * kf[4 * cc + 1] + q.z * kf[4 * cc + 2] + q.w * kf[4 * cc + 3]; } }
                    }
#pragma unroll
                    for (int r = 0; r < 4; ++r) lgt[g * 4 + r] = d[r] + relb[bk * 8 + g * 4 + r];
                }
            }
#pragma unroll
            for (int h = 0; h < 8; ++h) lg[h * 256 + idx] = lgt[h];
        }
        LDS_WAIT(); asm volatile("" ::: "memory");
#pragma unroll 1
        for (int h = 0; h < 8; ++h) {
            float v[4]; float mx = -INFINITY;
#pragma unroll
            for (int i = 0; i < 4; ++i) { v[i] = lg[h * 256 + lane + 64 * i]; mx = fmaxf(mx, v[i]); }
            mx = wave_max(mx); float sm = 0.f;
#pragma unroll
            for (int i = 0; i < 4; ++i) { v[i] = __expf(v[i] - mx); sm += v[i]; }
            sm = wave_sum(sm); const float inv = 1.0f / sm;
#pragma unroll
            for (int i = 0; i < 4; ++i) lg[h * 256 + lane + 64 * i] = v[i] * inv;
        }
        LDS_WAIT(); asm volatile("" ::: "memory");
        float o[8][2];
#pragma unroll
        for (int h = 0; h < 8; ++h) { o[h][0] = 0.f; o[h][1] = 0.f; }
#pragma unroll 2
        for (int idx = 0; idx < n; ++idx) {
            const int s = list[idx];
            const bf16* vrow = proj + (size_t)(b * T + s) * NPROJ_P + C_V;
            const unsigned v0 = *(const GAS unsigned*)(vrow + 2 * lane), v1 = *(const GAS unsigned*)(vrow + 128 + 2 * lane);
            const float a0 = blo(v0), a1 = bhi(v0), b0 = blo(v1), b1 = bhi(v1);
#pragma unroll
            for (int r = 0; r < 4; ++r) { const float p = lg[r * 256 + idx]; o[r][0] += p * a0; o[r][1] += p * a1; }
#pragma unroll
            for (int r = 0; r < 4; ++r) { const float p = lg[(4 + r) * 256 + idx]; o[4 + r][0] += p * b0; o[4 + r][1] += p * b1; }
        }
#pragma unroll
        for (int h = 0; h < 8; ++h) *(GAS unsigned*)(mix + (size_t)row * 2048 + h * 128 + 2 * lane) = pk2(o[h][0], o[h][1]);
        LDS_WAIT(); asm volatile("" ::: "memory");
    }
}

__device__ __forceinline__ void phase_hgrn(Frame& F, KA a, int l) {
    LAS float* qs = (LAS float*)(F.lds); LAS float* fs = (LAS float*)(F.lds + 16384); LAS float* ks = (LAS float*)(F.lds + 32768); LAS float* vs = (LAS float*)(F.lds + 49152); LAS float* ob = (LAS float*)(F.lds + 65536);
    const bf16* proj = (const bf16*)(a->ws + WS_PROJ); bf16* mix = (bf16*)(a->ws + WS_MIX);
    const float* lbl = a->in[11]; const float* gn = a->in[12] + l * 128;
    const int tid = F.tid, j = tid >> 2, dsl = tid & 3, tt_s = tid >> 4, d8 = (tid & 15) * 8;
    for (int unit = F.bid; unit < BATCH * 8; unit += F.G) {
        const int b = unit >> 3, h = unit & 7;
        float lbv[8];
#pragma unroll
        for (int i = 0; i < 8; ++i) lbv[i] = (l == 0) ? 0.f : sigmf(lbl[1024 + h * 128 + d8 + i] - lbl[h * 128 + d8 + i]);
        float S[32];
#pragma unroll
        for (int i = 0; i < 32; ++i) S[i] = 0.f;
#pragma unroll 1
        for (int c = 0; c < T / 32; ++c) {
            {   const bf16* pr = proj + (size_t)(b * T + c * 32 + tt_s) * NPROJ_P + h * 128 + d8;
                const v4u wq = *(const GAS v4u*)(pr + C_HQ), wfv = *(const GAS v4u*)(pr + C_HF), wi = *(const GAS v4u*)(pr + C_HI);
                const float xq[8] = {blo(wq.x), bhi(wq.x), blo(wq.y), bhi(wq.y), blo(wq.z), bhi(wq.z), blo(wq.w), bhi(wq.w)};
                const float xf[8] = {blo(wfv.x), bhi(wfv.x), blo(wfv.y), bhi(wfv.y), blo(wfv.z), bhi(wfv.z), blo(wfv.w), bhi(wfv.w)};
                const float xi[8] = {blo(wi.x), bhi(wi.x), blo(wi.y), bhi(wi.y), blo(wi.z), bhi(wi.z), blo(wi.w), bhi(wi.w)};
                float q[8], f[8], k[8];
#pragma unroll
                for (int i = 0; i < 8; ++i) { q[i] = siluf(xq[i]) * ATT_SCALE; f[i] = lbv[i] + (1.0f - lbv[i]) * sigmf(xf[i]); k[i] = 1.0f - f[i]; }
                const int o = tt_s * 128 + d8;
                *(LAS f32x4*)(qs + o) = (f32x4){q[0], q[1], q[2], q[3]}; *(LAS f32x4*)(qs + o + 4) = (f32x4){q[4], q[5], q[6], q[7]};
                *(LAS f32x4*)(fs + o) = (f32x4){f[0], f[1], f[2], f[3]}; *(LAS f32x4*)(fs + o + 4) = (f32x4){f[4], f[5], f[6], f[7]};
                *(LAS f32x4*)(ks + o) = (f32x4){k[0], k[1], k[2], k[3]}; *(LAS f32x4*)(ks + o + 4) = (f32x4){k[4], k[5], k[6], k[7]};
                *(LAS f32x4*)(vs + o) = (f32x4){xi[0], xi[1], xi[2], xi[3]}; *(LAS f32x4*)(vs + o + 4) = (f32x4){xi[4], xi[5], xi[6], xi[7]};
            }
            __syncthreads();
#pragma unroll 1
            for (int tt = 0; tt < 32; ++tt) {
                const float v = vs[tt * 128 + j]; float o = 0.f;
                const LAS f32x4* f4 = (const LAS f32x4*)(fs + tt * 128 + dsl * 32); const LAS f32x4* k4 = (const LAS f32x4*)(ks + tt * 128 + dsl * 32); const LAS f32x4* q4 = (const LAS f32x4*)(qs + tt * 128 + dsl * 32);
#pragma unroll
                for (int i4 = 0; i4 < 8; ++i4) { const f32x4 ff = f4[i4], kk = k4[i4], qq = q4[i4];
                    S[4 * i4] = ff.x * S[4 * i4] + kk.x * v; o += qq.x * S[4 * i4];
                    S[4 * i4 + 1] = ff.y * S[4 * i4 + 1] + kk.y * v; o += qq.y * S[4 * i4 + 1];
                    S[4 * i4 + 2] = ff.z * S[4 * i4 + 2] + kk.z * v; o += qq.z * S[4 * i4 + 2];
                    S[4 * i4 + 3] = ff.w * S[4 * i4 + 3] + kk.w * v; o += qq.w * S[4 * i4 + 3]; }
                o += __shfl_xor(o, 1); o += __shfl_xor(o, 2);
                if (dsl == 0) ob[tt * 128 + j] = o;
            }
            __syncthreads();
            {   const size_t row = (size_t)(b * T + c * 32 + tt_s);
                const f32x4 o0 = *(const LAS f32x4*)(ob + tt_s * 128 + d8), o1 = *(const LAS f32x4*)(ob + tt_s * 128 + d8 + 4);
                float ss = (o0.x * o0.x + o0.y * o0.y) + (o0.z * o0.z + o0.w * o0.w) + (o1.x * o1.x + o1.y * o1.y) + (o1.z * o1.z + o1.w * o1.w);
                ss += __shfl_xor(ss, 1); ss += __shfl_xor(ss, 2); ss += __shfl_xor(ss, 4); ss += __shfl_xor(ss, 8);
                const float r = 1.0f / sqrtf(ss * (1.0f / 128.0f) + EPS);
                const v4u wg = *(const GAS v4u*)(proj + row * NPROJ_P + C_HG + h * 128 + d8);
                const float xg[8] = {blo(wg.x), bhi(wg.x), blo(wg.y), bhi(wg.y), blo(wg.z), bhi(wg.z), blo(wg.w), bhi(wg.w)};
                const float ov[8] = {o0.x, o0.y, o0.z, o0.w, o1.x, o1.y, o1.z, o1.w};
                unsigned pw[4];
#pragma unroll
                for (int i = 0; i < 4; ++i) pw[i] = pk2(ov[2 * i] * r * gn[d8 + 2 * i] * siluf(xg[2 * i]), ov[2 * i + 1] * r * gn[d8 + 2 * i + 1] * siluf(xg[2 * i + 1]));
                *(GAS v4u*)(mix + row * 2048 + 1024 + h * 128 + d8) = (v4u){pw[0], pw[1], pw[2], pw[3]};
            }
            __syncthreads();
        }
    }
}

__device__ __forceinline__ void phase_norm_router(Frame& F, KA a, const float* src, bf16* dst) {
    LAS int* lcnt = (LAS int*)(F.lds); LAS int* lbase = (LAS int*)(F.lds + 64); LAS int* stash = (LAS int*)(F.lds + 128);
    float* rstd2 = (float*)(a->ws + WS_TAB + TAB_RSTD2); int* toke = (int*)(a->ws + WS_TAB + TAB_TOKE); int* tokpos = (int*)(a->ws + WS_TAB + TAB_TOKPOS); float* tokp = (float*)(a->ws + WS_TAB + TAB_TOKP);
    unsigned* gcnt = (unsigned*)(a->ws + WS_CTL) + CW_ECNT;
    const float* gain = a->in[3] + 2048; const float* wr = a->in[19];
    const int lane = F.lane;
    for (int chunk = F.bid; chunk < M / 64; chunk += F.G) {
        if (F.tid < 8) lcnt[F.tid] = 0;
        __syncthreads();
#pragma unroll 1
        for (int rr = 0; rr < 8; ++rr) {
            const int lrow = F.wave * 8 + rr; const size_t row = (size_t)chunk * 64 + lrow;
            const GAS f32x4* xr = (const GAS f32x4*)(src + row * D) + lane;
            f32x4 v[8]; float s = 0.f;
#pragma unroll
            for (int jj = 0; jj < 8; ++jj) { v[jj] = xr[64 * jj]; s += (v[jj].x * v[jj].x + v[jj].y * v[jj].y) + (v[jj].z * v[jj].z + v[jj].w * v[jj].w); }
            s = wave_sum(s); const float r = 1.0f / sqrtf(s * (1.0f / D) + EPS);
            GAS v2u* o8 = (GAS v2u*)(dst + row * D) + lane;
            float lg[8] = {0.f, 0.f, 0.f, 0.f, 0.f, 0.f, 0.f, 0.f};
#pragma unroll
            for (int jj = 0; jj < 8; ++jj) { v2u w; w.x = pk2(v[jj].x, v[jj].y); w.y = pk2(v[jj].z, v[jj].w); o8[64 * jj] = w;
                const int d0 = 4 * lane + 256 * jj; const f32x4 g4 = *(const GAS f32x4*)(gain + d0);
                const float xg[4] = {v[jj].x * g4.x, v[jj].y * g4.y, v[jj].z * g4.z, v[jj].w * g4.w};
#pragma unroll
                for (int q = 0; q < 4; ++q) { const f32x4 wa = *(const GAS f32x4*)(wr + (size_t)(d0 + q) * 8), wb = *(const GAS f32x4*)(wr + (size_t)(d0 + q) * 8 + 4);
                    lg[0] += xg[q] * wa.x; lg[1] += xg[q] * wa.y; lg[2] += xg[q] * wa.z; lg[3] += xg[q] * wa.w; lg[4] += xg[q] * wb.x; lg[5] += xg[q] * wb.y; lg[6] += xg[q] * wb.z; lg[7] += xg[q] * wb.w; } }
#pragma unroll
            for (int e = 0; e < 8; ++e) lg[e] = wave_sum(lg[e]) * r;
            int e0 = 0; float v0 = lg[0];
#pragma unroll
            for (int e = 1; e < 8; ++e) if (lg[e] > v0) { v0 = lg[e]; e0 = e; }
            int e1 = -1; float v1 = -INFINITY;
#pragma unroll
            for (int e = 0; e < 8; ++e) if (e != e0 && lg[e] > v1) { v1 = lg[e]; e1 = e; }
            const float p0 = 1.0f / (1.0f + __expf(v1 - v0)), p1 = 1.0f - p0;
            if (lane == 0) { rstd2[row] = r; const int lp0 = atomicAdd((int*)lcnt + e0, 1), lp1 = atomicAdd((int*)lcnt + e1, 1);
                stash[lrow * 4] = e0; stash[lrow * 4 + 1] = e1; stash[lrow * 4 + 2] = lp0; stash[lrow * 4 + 3] = lp1; tokp[row * 2] = p0; tokp[row * 2 + 1] = p1; }
        }
        __syncthreads();
        if (F.tid < 8) lbase[F.tid] = (int)__hip_atomic_fetch_add(gcnt + F.tid, (unsigned)lcnt[F.tid], __ATOMIC_RELAXED, __HIP_MEMORY_SCOPE_AGENT);
        __syncthreads();
        if (F.tid < 64) { const size_t row = (size_t)chunk * 64 + F.tid; const int e0 = stash[F.tid * 4], e1 = stash[F.tid * 4 + 1];
            toke[row * 2] = e0; toke[row * 2 + 1] = e1; tokpos[row * 2] = lbase[e0] + stash[F.tid * 4 + 2]; tokpos[row * 2 + 1] = lbase[e1] + stash[F.tid * 4 + 3]; }
        __syncthreads();
    }
}
struct ExpTab { int t[9]; };
__device__ __forceinline__ void load_exptab(KA a, int (&off)[9]) {
    const unsigned* gcnt = (const unsigned*)(a->ws + WS_CTL) + CW_ECNT;
    off[0] = 0;
#pragma unroll
    for (int e = 0; e < 8; ++e) { const unsigned c = __hip_atomic_load(gcnt + e, __ATOMIC_RELAXED, __HIP_MEMORY_SCOPE_AGENT); off[e + 1] = off[e] + (int)((c + 255u) >> 8); }
}
__device__ __forceinline__ void phase_gather(Frame& F, KA a) {
    int off[9]; load_exptab(a, off);
    const bf16* hb = (const bf16*)(a->ws + WS_XB); bf16* hs = (bf16*)(a->ws + WS_HS);
    const float* rstd2 = (const float*)(a->ws + WS_TAB + TAB_RSTD2); float* rstds = (float*)(a->ws + WS_TAB + TAB_RSTDS);
    const int* toke = (const int*)(a->ws + WS_TAB + TAB_TOKE); const int* tokpos = (const int*)(a->ws + WS_TAB + TAB_TOKPOS); int* tokdest = (int*)(a->ws + WS_TAB + TAB_TOKDEST);
    const int gw = F.bid * NWAVES + F.wave, NGW = F.G * NWAVES;
    for (int pair = gw; pair < 2 * M; pair += NGW) {
        const int tok = pair >> 1; const int e = toke[pair], pos = tokpos[pair];
        int o = off[0];
#pragma unroll
        for (int q = 1; q < 8; ++q) o = (e == q) ? off[q] : o;
        const int dest = o * 256 + pos;
        const GAS v4u* s = (const GAS v4u*)(hb + (size_t)tok * D) + F.lane; GAS v4u* dd = (GAS v4u*)(hs + (size_t)dest * D) + F.lane;
#pragma unroll
        for (int jj = 0; jj < 4; ++jj) dd[64 * jj] = s[64 * jj];
        if (F.lane == 0) { rstds[dest] = rstd2[tok]; tokdest[pair] = dest; }
    }
}
__device__ __forceinline__ void phase_combine(Frame& F, KA a) {
    const float* y = (const float*)(a->ws + WS_Y); const int* tokdest = (const int*)(a->ws + WS_TAB + TAB_TOKDEST); const float* tokp = (const float*)(a->ws + WS_TAB + TAB_TOKP);
    const int gw = F.bid * NWAVES + F.wave, NGW = F.G * NWAVES;
    for (int row = gw; row < M; row += NGW) {
        const int d0 = tokdest[2 * row], d1 = tokdest[2 * row + 1]; const float p0 = tokp[2 * row], p1 = tokp[2 * row + 1];
        GAS f32x4* o = (GAS f32x4*)(a->out + (size_t)row * D) + F.lane; const GAS f32x4* y0 = (const GAS f32x4*)(y + (size_t)d0 * D) + F.lane; const GAS f32x4* y1 = (const GAS f32x4*)(y + (size_t)d1 * D) + F.lane;
#pragma unroll
        for (int jj = 0; jj < 8; ++jj) o[64 * jj] = o[64 * jj] + y0[64 * jj] * p0 + y1[64 * jj] * p1;
    }
}

#ifndef MK_ONE_LAUNCH
#define MK_ONE_LAUNCH 0
#endif
constexpr int PH_PER_LAYER = 15, NPHASE = 2 * PH_PER_LAYER;
__global__ void __launch_bounds__(NWAVES * 64, 2) mk_fwd(Args args) {
    extern __shared__ __attribute__((aligned(16))) unsigned char lds[];
    LAS unsigned char* const ldsb = (LAS unsigned char*)lds;
    for (int u = threadIdx.x; u < (LDS_BYTES - LDSCTL_OFF) / 4; u += NWAVES * 64) ((LAS unsigned*)(ldsb + LDSCTL_OFF))[u] = 0u;
    __syncthreads();
    XcdBarrier bar; bar.bar = nullptr; bar.x = 0; bar.st = nullptr;
    if (MK_ONE_LAUNCH) { KA a = ka_get(); bar = xcd_barrier_post((unsigned*)(a->ws + WS_CTL) + CW_BAR, (volatile LAS unsigned*)(ldsb + MISC_OFF) + 8); }
    const int lo = args.ph_lo, hi = args.ph_hi;
#define IN(k) in_range((k), lo, hi)
#define SEAM(k) do { if (MK_ONE_LAUNCH && IN(k) && IN((k) + 1)) xcd_barrier(bar); } while (0)
#pragma unroll 1
    for (int l = 0; l < 2; ++l) {
        const int pb = l * PH_PER_LAYER;
        if (IN(pb + 0)) { KA a = ka_get(); Frame F = make_frame(ldsb); unsigned char* ws = a->ws; if (l == 0) phase_conv(F, a);
            phase_norm(F, (l == 0) ? a->in[0] : (const float*)(ws + WS_H), (bf16*)(ws + WS_XB), (float*)(ws + WS_RSTD1)); }
        SEAM(pb + 0);
        if (IN(pb + 1)) { KA a = ka_get(); Frame F = make_frame(ldsb); unsigned char* ws = a->ws;
            pg8::Gemm g{(const bf16*)(ws + WS_XB), (const bf16*)(ws + WS_WIN + l * WIN_SZ), M, NPROJ_P, D, D}; pg8::StaticOrder S; S.init(M, NPROJ_P, F.G, F.bid);
            pg8::EpiScaleBf16 E{(bf16*)(ws + WS_PROJ), NPROJ_P, (const float*)(ws + WS_RSTD1)};
            pg8::gemm_phase<pg8::EpiScaleBf16, pg8::StaticOrder, true, true>(F.lds + RING_OFF, g, S, E);
        }
        SEAM(pb + 1);
        if (IN(pb + 2)) { KA a = ka_get(); Frame F = make_frame(ldsb); phase_post(F, a, l); }
        SEAM(pb + 2);
        if (IN(pb + 3)) { KA a = ka_get(); Frame F = make_frame(ldsb); unsigned char* ws = a->ws;
            pg8::Gemm g{(const bf16*)(ws + WS_PROJ) + C_CQ, (const bf16*)(ws + WS_WIDX + l * WIDX_SZ), M, 1024, 512, NPROJ_P}; pg8::StaticOrder S; S.init(M, 1024, F.G, F.bid);
            pg8::EpiScaleBf16 E{(bf16*)(ws + WS_QIDX), 1024, (const float*)(ws + WS_RSTDCQ)};
            pg8::gemm_phase<pg8::EpiScaleBf16, pg8::StaticOrder, true, true>(F.lds + RING_OFF, g, S, E);
        }
        SEAM(pb + 3);
        if (IN(pb + 4)) { KA a = ka_get(); Frame F = make_frame(ldsb); phase_index(F, a); }
        SEAM(pb + 4);
        if (IN(pb + 5)) { KA a = ka_get(); Frame F = make_frame(ldsb); phase_attn(F, a); }
        SEAM(pb + 5);
        if (IN(pb + 6)) { KA a = ka_get(); Frame F = make_frame(ldsb); phase_hgrn(F, a, l); }
        SEAM(pb + 6);
        if (IN(pb + 7)) { KA a = ka_get(); Frame F = make_frame(ldsb); unsigned char* ws = a->ws;
            pg8::Gemm g{(const bf16*)(ws + WS_MIX), (const bf16*)(ws + WS_WUA + l * WU_SZ), M, D, 1024, D}; pg8::StaticOrder S; S.init(M, D, F.G, F.bid);
            pg8::EpiGate<0> E{(float*)(ws + WS_TMP), nullptr, D, (const bf16*)(ws + WS_PROJ) + C_GA, NPROJ_P};
            pg8::gemm_phase<pg8::EpiGate<0>, pg8::StaticOrder, true, true>(F.lds + RING_OFF, g, S, E);
        }
        SEAM(pb + 7);
        if (IN(pb + 8)) { KA a = ka_get(); Frame F = make_frame(ldsb); unsigned char* ws = a->ws;
            pg8::Gemm g{(const bf16*)(ws + WS_MIX) + 1024, (const bf16*)(ws + WS_WUH + l * WU_SZ), M, D, 1024, D}; pg8::StaticOrder S; S.init(M, D, F.G, F.bid);
            pg8::EpiGate<1> E{(float*)(ws + WS_TMP), (bf16*)(ws + WS_MRG), D, (const bf16*)(ws + WS_PROJ) + C_GH, NPROJ_P};
            pg8::gemm_phase<pg8::EpiGate<1>, pg8::StaticOrder, true, true>(F.lds + RING_OFF, g, S, E);
        }
        SEAM(pb + 8);
        if (IN(pb + 9)) { KA a = ka_get(); Frame F = make_frame(ldsb); unsigned char* ws = a->ws;
            pg8::Gemm g{(const bf16*)(ws + WS_MRG), (const bf16*)(ws + WS_WO + l * WO_SZ), M, D, D, D}; pg8::StaticOrder S; S.init(M, D, F.G, F.bid);
            pg8::EpiResF32 E{(l == 0) ? a->in[0] : (const float*)(ws + WS_H), (l == 0) ? (float*)(ws + WS_H) : a->out, D, 1 << 20};
            pg8::gemm_phase<pg8::EpiResF32, pg8::StaticOrder, true, true>(F.lds + RING_OFF, g, S, E);
        }
        SEAM(pb + 9);
        if (IN(pb + 10)) { KA a = ka_get(); Frame F = make_frame(ldsb); unsigned char* ws = a->ws;
            if (l == 0) phase_norm(F, (const float*)(ws + WS_H), (bf16*)(ws + WS_XB), (float*)(ws + WS_TAB + TAB_RSTD2)); else phase_norm_router(F, a, a->out, (bf16*)(ws + WS_XB)); }
        SEAM(pb + 10);
        if (l == 0) {
            if (IN(pb + 11)) { KA a = ka_get(); Frame F = make_frame(ldsb); unsigned char* ws = a->ws;
                pg8::Gemm g{(const bf16*)(ws + WS_XB), (const bf16*)(ws + WS_W13D), M, 2 * FFD, D, D}; pg8::StaticOrder S; S.init(M, 2 * FFD, F.G, F.bid);
                pg8::EpiSwiGLU E{(bf16*)(ws + WS_PROJ), FFD, 1 << 20, (const float*)(ws + WS_TAB + TAB_RSTD2)};
                pg8::gemm_phase<pg8::EpiSwiGLU, pg8::StaticOrder, true, true>(F.lds + RING_OFF, g, S, E);
            }
            SEAM(pb + 11);
            if (IN(pb + 12)) { KA a = ka_get(); Frame F = make_frame(ldsb); unsigned char* ws = a->ws;
                pg8::Gemm g{(const bf16*)(ws + WS_PROJ), (const bf16*)(ws + WS_W2D), M, D, FFD, FFD}; pg8::StaticOrder S; S.init(M, D, F.G, F.bid);
                pg8::EpiResF32 E{(const float*)(ws + WS_H), (float*)(ws + WS_H), D, 1 << 20};
                pg8::gemm_phase<pg8::EpiResF32, pg8::StaticOrder, true, true>(F.lds + RING_OFF, g, S, E);
            }
            SEAM(pb + 12);
        } else {
            if (IN(pb + 11)) { KA a = ka_get(); Frame F = make_frame(ldsb); phase_gather(F, a); }
            SEAM(pb + 11);
            if (IN(pb + 12)) { KA a = ka_get(); Frame F = make_frame(ldsb); unsigned char* ws = a->ws;
                int off[9]; load_exptab(a, off);
                pg8::Gemm g{(const bf16*)(ws + WS_HS), (const bf16*)(ws + WS_W13M), MS, 2 * FFE, D, D};
                pg8::MoeOrder S{F.G, F.bid, 2 * FFE / 256, off[0], off[1], off[2], off[3], off[4], off[5], off[6], off[7], off[8]};
                pg8::EpiSwiGLU E{(bf16*)(ws + WS_ACTM), FFE, 2 * FFE / 256, (const float*)(ws + WS_TAB + TAB_RSTDS)};
                pg8::gemm_phase<pg8::EpiSwiGLU, pg8::MoeOrder, true, true>(F.lds + RING_OFF, g, S, E);
            }
            SEAM(pb + 12);
            if (IN(pb + 13)) { KA a = ka_get(); Frame F = make_frame(ldsb); unsigned char* ws = a->ws;
                int off[9]; load_exptab(a, off);
                pg8::Gemm g{(const bf16*)(ws + WS_ACTM), (const bf16*)(ws + WS_W2M), MS, D, FFE, FFE};
                pg8::MoeOrder S{F.G, F.bid, D / 256, off[0], off[1], off[2], off[3], off[4], off[5], off[6], off[7], off[8]};
                pg8::EpiResF32 E{nullptr, (float*)(ws + WS_Y), D, D / 256};
                pg8::gemm_phase<pg8::EpiResF32, pg8::MoeOrder, true, true>(F.lds + RING_OFF, g, S, E);
            }
            SEAM(pb + 13);
            if (IN(pb + 14)) { KA a = ka_get(); Frame F = make_frame(ldsb); phase_combine(F, a); }
        }
    }
#undef IN
#undef SEAM
}

extern "C" void kernel_launch(void* const* d_in, const int* in_sizes, int n_in, void* d_out, int out_size, void* d_ws, size_t ws_size, hipStream_t stream) {
    static int grid = 0;
    if (grid == 0) {
        if (n_in != 23 || out_size != M * D || ws_size < WS_END) { fprintf(stderr, "kernel_launch: unexpected shapes (n_in %d out %d ws %zu need %zu)\n", n_in, out_size, ws_size, (size_t)WS_END); grid = -1; return; }
        int dev = 0, cus = 0, per_cu = 0;
        if (hipGetDevice(&dev) != hipSuccess || hipDeviceGetAttribute(&cus, hipDeviceAttributeMultiprocessorCount, dev) != hipSuccess) { grid = -1; return; }
        if (hipFuncSetAttribute((const void*)mk_fwd, hipFuncAttributeMaxDynamicSharedMemorySize, LDS_BYTES) != hipSuccess) { fprintf(stderr, "kernel_launch: hipFuncSetAttribute failed\n"); grid = -1; return; }
        if (hipOccupancyMaxActiveBlocksPerMultiprocessor(&per_cu, (const void*)mk_fwd, NWAVES * 64, LDS_BYTES) != hipSuccess || per_cu < 1) fprintf(stderr, "kernel_launch: occupancy query says %d\n", per_cu);
        (void)hipGetLastError();
        grid = cus;
    }
    if (grid < 0) return;
    (void)hipMemsetAsync((char*)d_ws + WS_CTL, 0, CTL_ZERO_BYTES, stream);
    Args a{};
    for (int i = 0; i < 23; ++i) a.in[i] = (const float*)d_in[i];
    a.out = (float*)d_out; a.ws = (unsigned char*)d_ws;
#if MK_ONE_LAUNCH
    a.ph_lo = 0; a.ph_hi = NPHASE;
    hipLaunchKernelGGL(mk_fwd, dim3(grid), dim3(NWAVES * 64), LDS_BYTES, stream, a);
#else
    for (int p = 0; p < NPHASE; ++p) {
        if (p == 13 || p == 14) continue;
        a.ph_lo = p; a.ph_hi = p + 1;
        hipLaunchKernelGGL(mk_fwd, dim3(grid), dim3(NWAVES * 64), LDS_BYTES, stream, a);
    }
#endif
}
```

```cpp
#include <hip/hip_runtime.h>
#include <cstdio>
#include <cstdint>
namespace pg8 {
#define PG8_LAS __attribute__((address_space(3)))
typedef unsigned short bf16_t;
typedef short bf16x8 __attribute__((ext_vector_type(8)));
typedef float f32x4 __attribute__((ext_vector_type(4)));
typedef unsigned u32x4 __attribute__((ext_vector_type(4)));
typedef int i32x8 __attribute__((ext_vector_type(8)));
constexpr int BM = 256, BK = 64, HALF = 128, HTB = HALF * BK * 2  , STAGE_BYTES = 8 * HTB, NXCD = 8, WGM = 8;

__host__ __device__ __forceinline__ int lds_byte(int r, int c) { const int st = (r >> 4) * 2 + (c >> 5), rr = r & 15, cc = c & 31, ob = rr * 64 + cc * 2; return st * 1024 + (ob ^ (((ob >> 9) & 1) << 5)); }
__host__ __device__ __forceinline__ void stage_rc(int b, int& R, int& C) { const int st = b / 1024, sb = b % 1024, swz = sb ^ (((sb >> 9) & 1) << 5); R = (st >> 1) * 16 + swz / 64; C = (st & 1) * 32 + (swz % 64) / 2; }
__host__ __device__ __forceinline__ int perm32(int rho) { const int n = rho >> 4, i = rho & 15; return 8 * (i >> 2) + 4 * n + (i & 3); }

struct Unit { int pm, pn; };
struct Gemm { const bf16_t* A; const bf16_t* Bt; int M, N, K, lda, tid; int scaleA, scaleB; };

struct StaticOrder {
    int nM, nN, nwg, G, c;
    __host__ __device__ void init(int M, int N, int G_, int c_) { nM = M / BM; nN = N / BM; nwg = nM * nN; G = G_; c = c_; }
    __host__ __device__ bool next(int i, Unit& u) const {
        const long L = (long)i * G + c; if (L >= nwg) return false;
        int wgid = (int)L; { const int q = nwg / NXCD, r = nwg % NXCD, xcd = wgid % NXCD, off = wgid / NXCD; wgid = (xcd < r ? xcd * (q + 1) : r * (q + 1) + (xcd - r) * q) + off; }
        const int nig = WGM * nN, gid = wgid / nig, fm = gid * WGM, gsz = (nM - fm) < WGM ? (nM - fm) : WGM;
        u.pm = fm + ((wgid % nig) % gsz); u.pn = (wgid % nig) / gsz; return true;
    }
    __device__ __forceinline__ void a_ready(const Unit&) const {}
    __device__ __forceinline__ void done(const Unit&) const {}
};

__device__ __forceinline__ unsigned cvt_pk_bf16(float lo, float hi) { unsigned r; asm volatile("v_cvt_pk_bf16_f32 %0, %1, %2" : "=v"(r) : "v"(lo), "v"(hi)); return r; }
__device__ __forceinline__ float bflo(unsigned w) { return __builtin_bit_cast(float, w << 16); }
__device__ __forceinline__ float bfhi(unsigned w) { return __builtin_bit_cast(float, w & 0xffff0000u); }
__device__ __forceinline__ float sigm(float x) { return __builtin_amdgcn_rcpf(1.0f + __builtin_amdgcn_exp2f(-1.4426950408889634f * x)); }
__device__ __forceinline__ float silu(float x) { return x * __builtin_amdgcn_rcpf(1.0f + __builtin_amdgcn_exp2f(-1.4426950408889634f * x)); }

struct EpiScaleBf16 {
    static constexpr bool PERM = true, AFTER_DRAIN = false;
    bf16_t* O; int ldc; const float* rs;
    __device__ __forceinline__ void operator()(const f32x4 (&acc)[2][2][4][2], const Unit& u, int wr, int wc, int fr, int fq) const {
        const int row0 = u.pm * BM + wr * 64 + fr, col0 = u.pn * BM + wc * 32 + 8 * fq;
#pragma unroll
        for (int ai = 0; ai < 2; ++ai)
#pragma unroll
            for (int m = 0; m < 4; ++m) { const int row = row0 + ai * HALF + m * 16; const float s = rs[row]; bf16_t* rowp = O + (size_t)row * ldc + col0;
#pragma unroll
                for (int bj = 0; bj < 2; ++bj) { const f32x4 v0 = acc[ai][bj][m][0] * s, v1 = acc[ai][bj][m][1] * s;
                    u32x4 w; w.x = cvt_pk_bf16(v0[0], v0[1]); w.y = cvt_pk_bf16(v0[2], v0[3]); w.z = cvt_pk_bf16(v1[0], v1[1]); w.w = cvt_pk_bf16(v1[2], v1[3]);
                    *(u32x4*)(rowp + bj * HALF) = w; } }
    }
};
template <int MODE> struct EpiGate {
    static constexpr bool PERM = true, AFTER_DRAIN = false;
    float* C; bf16_t* O; int ldc; const bf16_t* G; int ldg;
    __device__ __forceinline__ void operator()(const f32x4 (&acc)[2][2][4][2], const Unit& u, int wr, int wc, int fr, int fq) const {
        const int row0 = u.pm * BM + wr * 64 + fr, col0 = u.pn * BM + wc * 32 + 8 * fq;
#pragma unroll
        for (int ai = 0; ai < 2; ++ai)
#pragma unroll
            for (int m = 0; m < 4; ++m) { const int row = row0 + ai * HALF + m * 16;
#pragma unroll
                for (int bj = 0; bj < 2; ++bj) { const int col = col0 + bj * HALF;
                    const u32x4 gw = *(const u32x4*)(G + (size_t)row * ldg + col);
                    f32x4 g0, g1; g0[0] = sigm(bflo(gw.x)); g0[1] = sigm(bfhi(gw.x)); g0[2] = sigm(bflo(gw.y)); g0[3] = sigm(bfhi(gw.y));
                    g1[0] = sigm(bflo(gw.z)); g1[1] = sigm(bfhi(gw.z)); g1[2] = sigm(bflo(gw.w)); g1[3] = sigm(bfhi(gw.w));
                    float* cp = C + (size_t)row * ldc + col;
                    if (MODE == 0) { *(f32x4*)cp = acc[ai][bj][m][0] * g0; *(f32x4*)(cp + 4) = acc[ai][bj][m][1] * g1; }
                    else { const f32x4 v0 = *(const f32x4*)cp + acc[ai][bj][m][0] * g0, v1 = *(const f32x4*)(cp + 4) + acc[ai][bj][m][1] * g1;
                        u32x4 w; w.x = cvt_pk_bf16(v0[0], v0[1]); w.y = cvt_pk_bf16(v0[2], v0[3]); w.z = cvt_pk_bf16(v1[0], v1[1]); w.w = cvt_pk_bf16(v1[2], v1[3]);
                        *(u32x4*)(O + (size_t)row * ldc + col) = w; } } }
    }
};
struct EpiResF32 {
    static constexpr bool PERM = true, AFTER_DRAIN = false;
    const float* res; float* out; int ldc, npn;
    __device__ __forceinline__ void operator()(const f32x4 (&acc)[2][2][4][2], const Unit& u, int wr, int wc, int fr, int fq) const {
        const int row0 = u.pm * BM + wr * 64 + fr, col0 = (u.pn % npn) * BM + wc * 32 + 8 * fq;
#pragma unroll
        for (int ai = 0; ai < 2; ++ai)
#pragma unroll
            for (int m = 0; m < 4; ++m) { const size_t off = (size_t)(row0 + ai * HALF + m * 16) * ldc + col0;
#pragma unroll
                for (int bj = 0; bj < 2; ++bj) { f32x4 v0 = acc[ai][bj][m][0], v1 = acc[ai][bj][m][1];
                    if (res) { v0 += *(const f32x4*)(res + off + bj * HALF); v1 += *(const f32x4*)(res + off + bj * HALF + 4); }
                    *(f32x4*)(out + off + bj * HALF) = v0; *(f32x4*)(out + off + bj * HALF + 4) = v1; } }
    }
};
template <bool F8OUT> struct EpiSwiGLUT {
    static constexpr bool PERM = true, AFTER_DRAIN = false;
    bf16_t* O; int ldc, npn; const float* rs;
    __device__ __forceinline__ void operator()(const f32x4 (&acc)[2][2][4][2], const Unit& u, int wr, int wc, int fr, int fq) const {
        const int row0 = u.pm * BM + wr * 64 + fr, col0 = (u.pn % npn) * HALF + wc * 32 + 8 * fq;
#pragma unroll
        for (int ai = 0; ai < 2; ++ai)
#pragma unroll
            for (int m = 0; m < 4; ++m) { const int row = row0 + ai * HALF + m * 16; const float r = rs[row];
                float o[8];
#pragma unroll
                for (int n = 0; n < 2; ++n)
#pragma unroll
                    for (int j = 0; j < 4; ++j) { const float a1 = acc[ai][0][m][n][j] * r, a3 = acc[ai][1][m][n][j] * r; o[4 * n + j] = silu(a1) * a3; }
                if constexpr (F8OUT) {
                    unsigned w0 = 0u, w1 = 0u;
#pragma unroll
                    for (int j = 0; j < 8; ++j) o[j] = __builtin_amdgcn_fmed3f(o[j] * 8.0f, -440.f, 440.f);
                    w0 = __builtin_amdgcn_cvt_pk_fp8_f32(o[0], o[1], w0, false); w0 = __builtin_amdgcn_cvt_pk_fp8_f32(o[2], o[3], w0, true);
                    w1 = __builtin_amdgcn_cvt_pk_fp8_f32(o[4], o[5], w1, false); w1 = __builtin_amdgcn_cvt_pk_fp8_f32(o[6], o[7], w1, true);
                    typedef unsigned u32x2_ __attribute__((ext_vector_type(2)));
                    *(u32x2_*)((unsigned char*)O + (size_t)row * ldc + col0) = (u32x2_){w0, w1};
                } else {
                u32x4 w; w.x = cvt_pk_bf16(o[0], o[1]); w.y = cvt_pk_bf16(o[2], o[3]); w.z = cvt_pk_bf16(o[4], o[5]); w.w = cvt_pk_bf16(o[6], o[7]);
                *(u32x4*)(O + (size_t)row * ldc + col0) = w; } }
    }
};
typedef EpiSwiGLUT<false> EpiSwiGLU;
struct OneUnit { int pm, pn; bool has;
    __device__ __forceinline__ bool next(int i, Unit& u) const { if (i > 0 || !has) return false; u.pm = pm; u.pn = pn; return true; }
    __device__ __forceinline__ void a_ready(const Unit&) const {}
    __device__ __forceinline__ void done(const Unit&) const {}
};
struct MoeOrder {
    int G, c, nN; int t0, t1, t2, t3, t4, t5, t6, t7, t8;
    __device__ __forceinline__ bool next(int i, Unit& u) const {
        const long L = (long)i * G + c; if (L >= (long)t8 * nN) return false;
        int ts = t0, te = t1;
        if (L >= (long)t1 * nN) { ts = t1; te = t2; } if (L >= (long)t2 * nN) { ts = t2; te = t3; } if (L >= (long)t3 * nN) { ts = t3; te = t4; } if (L >= (long)t4 * nN) { ts = t4; te = t5; }
        if (L >= (long)t5 * nN) { ts = t5; te = t6; } if (L >= (long)t6 * nN) { ts = t6; te = t7; } if (L >= (long)t7 * nN) { ts = t7; te = t8; }
        int e = 0; e += (L >= (long)t1 * nN); e += (L >= (long)t2 * nN); e += (L >= (long)t3 * nN); e += (L >= (long)t4 * nN); e += (L >= (long)t5 * nN); e += (L >= (long)t6 * nN); e += (L >= (long)t7 * nN);
        const int Ll = (int)(L - (long)ts * nN), Te = te - ts;
        u.pm = ts + Ll % Te; u.pn = e * nN + Ll / Te; return true;
    }
    __device__ __forceinline__ void a_ready(const Unit&) const {}
    __device__ __forceinline__ void done(const Unit&) const {}
};
template <bool FP8> struct FragT;
template <> struct FragT<false> { bf16x8 k[2]; };
template <> struct FragT<true>  { i32x8 v; };
__device__ __forceinline__ void ld_frag(FragT<false>& f, const PG8_LAS unsigned char* p, int o0, int o1) { f.k[0] = *(const PG8_LAS bf16x8*)(p + o0); f.k[1] = *(const PG8_LAS bf16x8*)(p + o1); }
__device__ __forceinline__ void ld_frag(FragT<true>& f, const PG8_LAS unsigned char* p, int o0, int o1) { const u32x4 a = *(const PG8_LAS u32x4*)(p + o0), b = *(const PG8_LAS u32x4*)(p + o1);
    f.v = (i32x8){(int)a.x, (int)a.y, (int)a.z, (int)a.w, (int)b.x, (int)b.y, (int)b.z, (int)b.w}; }
__device__ __forceinline__ f32x4 mma_frag(const FragT<false>& b, const FragT<false>& a, f32x4 c, int, int) { c = __builtin_amdgcn_mfma_f32_16x16x32_bf16(b.k[0], a.k[0], c, 0, 0, 0); return __builtin_amdgcn_mfma_f32_16x16x32_bf16(b.k[1], a.k[1], c, 0, 0, 0); }
__device__ __forceinline__ f32x4 mma_frag(const FragT<true>& b, const FragT<true>& a, f32x4 c, int sb, int sa) {
    asm volatile("v_mfma_scale_f32_16x16x128_f8f6f4 %0, %1, %2, %0, %3, %4 op_sel_hi:[0,0,0]" : "+v"(c) : "v"(b.v), "v"(a.v), "v"(sb), "v"(sa)); return c; }
template <class Epi, class Sched, bool ALIGN_EPI = false, bool SP2 = false, bool FP8 = false>
__device__ __forceinline__ void gemm_phase(PG8_LAS unsigned char* lds, const Gemm g, const Sched& S, const Epi& E) {
    const int tid = g.tid, wid = __builtin_amdgcn_readfirstlane(tid >> 6), lane = tid & 63, wr = wid >> 2, wc = wid & 3, fr = lane & 15, fq = lane >> 4;
    const int K = g.K, nt = K / BK;
    unsigned voffA[2], voffB[2];
#pragma unroll
    for (int i = 0; i < 2; ++i) { int R, C; stage_rc(tid * 16 + i * 8192, R, C); const int Rb = Epi::PERM ? ((R & ~31) + perm32(R & 31)) : R;
        voffA[i] = (unsigned)(R * g.lda + C) * 2u; voffB[i] = (unsigned)(Rb * K + C) * 2u; }
    const size_t kstep = (size_t)(BK * 2);
    const size_t hstepB = (size_t)HALF * K * 2, hstepA = (size_t)HALF * g.lda * 2;
    const size_t tstepA = 2 * hstepA, tstepB = 2 * hstepB;
    const unsigned ldsw = (unsigned)wid * 1024u;
    const int aoff = FP8 ? lds_byte(wr * 64 + fr, fq * 16) : lds_byte(wr * 64 + fr, fq * 8), boff = FP8 ? lds_byte(wc * 32 + fr, fq * 16) : lds_byte(wc * 32 + fr, fq * 8);
    const int aoff1 = FP8 ? aoff + 16 : aoff + 1024, boff1 = FP8 ? boff + 16 : boff + 1024;
    int scA = g.scaleA, scB = g.scaleB; asm volatile("" : "+v"(scA), "+v"(scB));
#define PG8_SA(b, h) (((b) * 2 + (h)) * HTB)
#define PG8_SB(b, h) ((4 + (b) * 2 + (h)) * HTB)
#define PG8_STAGE(bufoff, gbase, voff) do { _Pragma("unroll") for (int _i = 0; _i < 2; ++_i) \
        __builtin_amdgcn_global_load_lds((const unsigned*)((const char*)(gbase) + (voff)[_i]), (PG8_LAS unsigned*)(lds + (bufoff) + ldsw + _i * 8192), 16, 0, 0); } while (0)
#define PG8_LDA(dst, b, h) do { _Pragma("unroll") for (int m = 0; m < 4; ++m) ld_frag(dst[m], lds + PG8_SA(b, h) + m * 2048, aoff, aoff1); } while (0)
#define PG8_LDB(dst, b, h) do { _Pragma("unroll") for (int n = 0; n < 2; ++n) ld_frag(dst[n], lds + PG8_SB(b, h) + n * 2048, boff, boff1); } while (0)
#define PG8_MMA(ai, bj, At, Bt) do { __builtin_amdgcn_s_setprio(1); _Pragma("unroll") for (int m = 0; m < 4; ++m) _Pragma("unroll") for (int n = 0; n < 2; ++n) \
        acc[ai][bj][m][n] = mma_frag(Bt[n], At[m], acc[ai][bj][m][n], scB, scA); __builtin_amdgcn_s_setprio(0); } while (0)
#define PG8_WAIT_V(n) asm volatile("s_waitcnt vmcnt(" #n ")" ::: "memory")
#define PG8_WAIT_L(n) asm volatile("s_waitcnt lgkmcnt(" #n ")" ::: "memory")
#define PG8_BAR __builtin_amdgcn_s_barrier()
#define PG8_SCHED __builtin_amdgcn_sched_barrier(0)
    Unit cur, nxt; int ui = 0;
    if (!S.next(0, cur)) return;
    f32x4 acc[2][2][4][2];
#pragma unroll
    for (int a = 0; a < 2; ++a)
#pragma unroll
        for (int b = 0; b < 2; ++b)
#pragma unroll
            for (int m = 0; m < 4; ++m)
#pragma unroll
                for (int n = 0; n < 2; ++n) acc[a][b][m][n] = (f32x4){0.f, 0.f, 0.f, 0.f};
    FragT<FP8> At[4], B0[2], B1[2];
    const char* cA = (const char*)g.A + (size_t)cur.pm * tstepA; const char* cB = (const char*)g.Bt + (size_t)cur.pn * tstepB;
    S.a_ready(cur);
    if constexpr (SP2) {
        PG8_STAGE(PG8_SB(0, 0), cB, voffB); PG8_STAGE(PG8_SB(0, 1), cB + hstepB, voffB); PG8_STAGE(PG8_SA(0, 0), cA, voffA); PG8_STAGE(PG8_SA(0, 1), cA + hstepA, voffA);
        if (wr == 1) PG8_BAR;
        PG8_WAIT_V(2); PG8_BAR;
        PG8_STAGE(PG8_SB(1, 0), cB + kstep, voffB); PG8_STAGE(PG8_SA(1, 0), cA + kstep, voffA); PG8_STAGE(PG8_SB(1, 1), cB + hstepB + kstep, voffB);
        PG8_WAIT_V(6); PG8_BAR;
    } else {
        PG8_STAGE(PG8_SB(0, 0), cB, voffB); PG8_STAGE(PG8_SA(0, 0), cA, voffA); PG8_STAGE(PG8_SB(0, 1), cB + hstepB, voffB); PG8_STAGE(PG8_SA(0, 1), cA + hstepA, voffA);
        if (wr == 1) PG8_BAR;
        PG8_WAIT_V(4); PG8_BAR;
        PG8_STAGE(PG8_SB(1, 0), cB + kstep, voffB); PG8_STAGE(PG8_SA(1, 0), cA + kstep, voffA); PG8_STAGE(PG8_SB(1, 1), cB + hstepB + kstep, voffB);
        PG8_WAIT_V(6); PG8_BAR;
    }
    for (;;) {
        const bool has_next = S.next(ui + 1, nxt);
        const char* nA = has_next ? (const char*)g.A + (size_t)nxt.pm * tstepA : cA; const char* nB = has_next ? (const char*)g.Bt + (size_t)nxt.pn * tstepB : cB;
        for (int t = 0; t < nt; t += 2) {
            const bool last = (t == nt - 2);
            const char* a1 = cA + (size_t)(t + 1) * kstep;
            const char* a2 = last ? nA : cA + (size_t)(t + 2) * kstep; const char* b2 = last ? nB : cB + (size_t)(t + 2) * kstep;
            const char* a3 = a2 + kstep; const char* b3 = b2 + kstep;
            if (last && has_next) S.a_ready(nxt);
            if constexpr (SP2) {
            PG8_LDB(B0, 0, 0); PG8_LDB(B1, 0, 1); PG8_SCHED; PG8_LDA(At, 0, 0); PG8_STAGE(PG8_SA(1, 1), a1 + hstepA, voffA);
            PG8_WAIT_V(8); PG8_WAIT_L(0); PG8_BAR; PG8_MMA(0, 0, At, B0); PG8_MMA(0, 1, At, B1); PG8_BAR; PG8_SCHED;
            PG8_LDA(At, 0, 1); PG8_STAGE(PG8_SB(0, 0), b2, voffB); PG8_STAGE(PG8_SB(0, 1), b2 + hstepB, voffB); PG8_STAGE(PG8_SA(0, 0), a2, voffA);
            PG8_WAIT_V(8); PG8_WAIT_L(0); PG8_BAR; PG8_MMA(1, 0, At, B0); PG8_MMA(1, 1, At, B1); PG8_BAR; PG8_SCHED;
            PG8_LDB(B0, 1, 0); PG8_LDB(B1, 1, 1); PG8_SCHED; PG8_LDA(At, 1, 0); PG8_STAGE(PG8_SA(0, 1), a2 + hstepA, voffA);
            PG8_WAIT_V(8); PG8_WAIT_L(0); PG8_BAR; PG8_MMA(0, 0, At, B0); PG8_MMA(0, 1, At, B1); PG8_BAR; PG8_SCHED;
            PG8_LDA(At, 1, 1); PG8_STAGE(PG8_SB(1, 0), b3, voffB); PG8_STAGE(PG8_SB(1, 1), b3 + hstepB, voffB); PG8_STAGE(PG8_SA(1, 0), a3, voffA);
            PG8_WAIT_V(8); PG8_WAIT_L(0); PG8_BAR; PG8_MMA(1, 0, At, B0); PG8_MMA(1, 1, At, B1); PG8_BAR; PG8_SCHED;
            } else {
            PG8_LDB(B0, 0, 0); PG8_SCHED; PG8_LDA(At, 0, 0); PG8_STAGE(PG8_SA(1, 1), a1 + hstepA, voffA);
            PG8_WAIT_L(8); PG8_BAR; PG8_WAIT_L(0); PG8_MMA(0, 0, At, B0); PG8_BAR; PG8_SCHED;
            PG8_LDB(B1, 0, 1); PG8_STAGE(PG8_SB(0, 0), b2, voffB);
            PG8_BAR; PG8_WAIT_L(0); PG8_MMA(0, 1, At, B1); PG8_BAR;
            PG8_LDA(At, 0, 1); PG8_STAGE(PG8_SA(0, 0), a2, voffA);
            PG8_BAR; PG8_WAIT_L(0); PG8_MMA(1, 0, At, B0); PG8_BAR; PG8_SCHED;
            PG8_STAGE(PG8_SB(0, 1), b2 + hstepB, voffB);
            PG8_WAIT_V(6); PG8_BAR; PG8_MMA(1, 1, At, B1); PG8_BAR;
            PG8_LDB(B0, 1, 0); PG8_SCHED; PG8_LDA(At, 1, 0); PG8_STAGE(PG8_SA(0, 1), a2 + hstepA, voffA);
            PG8_WAIT_L(8); PG8_BAR; PG8_WAIT_L(0); PG8_MMA(0, 0, At, B0); PG8_BAR; PG8_SCHED;
            PG8_LDB(B1, 1, 1); PG8_STAGE(PG8_SB(1, 0), b3, voffB);
            PG8_BAR; PG8_WAIT_L(0); PG8_MMA(0, 1, At, B1); PG8_BAR;
            PG8_LDA(At, 1, 1); PG8_STAGE(PG8_SA(1, 0), a3, voffA);
            PG8_BAR; PG8_WAIT_L(0); PG8_MMA(1, 0, At, B0); PG8_BAR; PG8_SCHED;
            PG8_STAGE(PG8_SB(1, 1), b3 + hstepB, voffB);
            PG8_WAIT_V(6); PG8_BAR; PG8_MMA(1, 1, At, B1); PG8_BAR;
            }
        }
        if constexpr (FP8) asm volatile("s_nop 15\n\ts_nop 15" : "+v"(acc[1][1][0][0]), "+v"(acc[1][1][0][1]), "+v"(acc[1][1][1][0]), "+v"(acc[1][1][1][1]), "+v"(acc[1][1][2][0]), "+v"(acc[1][1][2][1]), "+v"(acc[1][1][3][0]), "+v"(acc[1][1][3][1]) :: "memory");
        if constexpr (ALIGN_EPI) { if (wr == 0) PG8_BAR; }
        if constexpr (!Epi::AFTER_DRAIN) { E(acc, cur, wr, wc, fr, fq); S.done(cur); }
        if (!has_next) break;
#pragma unroll
        for (int a = 0; a < 2; ++a)
#pragma unroll
            for (int b = 0; b < 2; ++b)
#pragma unroll
                for (int m = 0; m < 4; ++m)
#pragma unroll
                    for (int n = 0; n < 2; ++n) acc[a][b][m][n] = (f32x4){0.f, 0.f, 0.f, 0.f};
        cur = nxt; cA = nA; cB = nB; ++ui;
        if constexpr (ALIGN_EPI) { if (wr == 1) PG8_BAR; }
    }
    PG8_WAIT_V(0);
    if constexpr (!ALIGN_EPI) { if (wr == 0) PG8_BAR; }
    PG8_BAR;
    if constexpr (Epi::AFTER_DRAIN) { E.fused(acc, cur, wr, wc, fr, fq, lds, wid, lane); S.done(cur); }
#undef PG8_SA
#undef PG8_SB
#undef PG8_STAGE
#undef PG8_LDA
#undef PG8_LDB
#undef PG8_MMA
#undef PG8_WAIT_V
#undef PG8_WAIT_L
#undef PG8_BAR
#undef PG8_SCHED
}
}

#define GAS __attribute__((address_space(1)))
#define LAS __attribute__((address_space(3)))
typedef unsigned short bf16;
typedef unsigned v4u __attribute__((ext_vector_type(4)));
typedef float f32x4 __attribute__((ext_vector_type(4)));
typedef short bf16x8 __attribute__((ext_vector_type(8)));
typedef GAS unsigned gu32;
typedef GAS unsigned long long gu64;
#define RLX_AGENT __ATOMIC_RELAXED, __HIP_MEMORY_SCOPE_AGENT
#define LDS_WAIT() asm volatile("s_waitcnt lgkmcnt(0)" ::: "memory")
#define VM_WAIT() asm volatile("s_waitcnt vmcnt(0)" ::: "memory")
__device__ __forceinline__ unsigned long long rt() { return __builtin_amdgcn_s_memrealtime(); }
__device__ __forceinline__ unsigned f2bf(float f) { unsigned u = __builtin_bit_cast(unsigned, f); return (u + 0x7fffu + ((u >> 16) & 1u)) >> 16; }
__device__ __forceinline__ unsigned pk2(float lo, float hi) { unsigned r; asm volatile("v_cvt_pk_bf16_f32 %0, %1, %2" : "=v"(r) : "v"(lo), "v"(hi)); return r; }

#define XB_TMO      128
#define XB_XCNT(j)  (256  + 64 * (j))
#define XB_XSUB(j)  (1280 + 64 * (j))
#define XB_XGEN(j)  (2304 + 64 * (j))
#define XB_TOP      3328
#define XB_TOPGEN   3392
#define XCD_BAR_WORDS 3456
#define XB_SPIN_CAP (1u << 18)

__device__ __forceinline__ unsigned xb_ld(unsigned* p)              { return __hip_atomic_load(p, __ATOMIC_RELAXED, __HIP_MEMORY_SCOPE_AGENT); }
__device__ __forceinline__ unsigned xb_add(unsigned* p, unsigned v) { return __hip_atomic_fetch_add(p, v, __ATOMIC_RELAXED, __HIP_MEMORY_SCOPE_AGENT); }
__device__ __forceinline__ unsigned xb_xcc_id() { return (unsigned)__builtin_amdgcn_s_getreg((3 << 11) | 20) & 0xFu; }
#define XB_SPIN(cond, bar) do { unsigned _sp = 0; while (cond) { __builtin_amdgcn_s_sleep(1); \
    if ((++_sp & 255u) == 0u) { if (xb_ld(&(bar)[XB_TMO])) break; if (_sp > XB_SPIN_CAP) { atomicAdd(&(bar)[XB_TMO], 1u); break; } } } } while (0)

struct XcdBarrier {
    unsigned* bar; unsigned x;
    volatile LAS unsigned* st;
};

__device__ __forceinline__ XcdBarrier xcd_barrier_post(unsigned* bar, volatile LAS unsigned* st) {
    XcdBarrier b; b.bar = bar; b.x = xb_xcc_id(); b.st = st;
    if (threadIdx.x == 0) (void)xb_add(&bar[XB_XCNT(b.x)], 1u);
    return b;
}
__device__ __forceinline__ void xcd_barrier_complete(unsigned* bar, unsigned x, unsigned& nloc, unsigned& nx) {
    const unsigned G = gridDim.x * gridDim.y * gridDim.z;
    unsigned sum, cnt, mine, sp = 0u;
    for (;;) {
        sum = 0u; cnt = 0u; mine = 0u;
#pragma unroll
        for (unsigned j = 0; j < 16; ++j) { const unsigned c = xb_ld(&bar[XB_XCNT(j)]); sum += c; cnt += (c > 0u) ? 1u : 0u; mine = (j == x) ? c : mine; }
        if (sum == G) break;
        __builtin_amdgcn_s_sleep(1);
        if ((++sp & 255u) == 0u) { if (xb_ld(&bar[XB_TMO])) break; if (sp > XB_SPIN_CAP) { atomicAdd(&bar[XB_TMO], 1u); break; } }
    }
    nloc = mine > 0u ? mine : 1u; nx = cnt > 0u ? cnt : 1u;
}

__device__ __forceinline__ void xcd_barrier(const XcdBarrier& b) {
    asm volatile("s_waitcnt vmcnt(0)" ::: "memory");
    __syncthreads();
    if (threadIdx.x == 0) {
        unsigned* bar = b.bar;
        __builtin_amdgcn_s_waitcnt(0);
        unsigned nloc = b.st[0], nx = b.st[1];
        if (nloc == 0u) { xcd_barrier_complete(bar, b.x, nloc, nx); b.st[0] = nloc; b.st[1] = nx; }
        const unsigned old = xb_add(&bar[XB_XSUB(b.x)], 1u);
        const unsigned gen = old / nloc;
        if (old + 1u == (gen + 1u) * nloc) {
            __builtin_amdgcn_fence(__ATOMIC_RELEASE, "agent");
            asm volatile("s_waitcnt vmcnt(0)" ::: "memory");
            const unsigned og = xb_add(&bar[XB_TOP], 1u);
            const unsigned tg = og / nx;
            if (og + 1u == (tg + 1u) * nx) xb_add(&bar[XB_TOPGEN], 1u);
            else XB_SPIN(xb_ld(&bar[XB_TOPGEN]) == tg, bar);
            __builtin_amdgcn_fence(__ATOMIC_ACQUIRE, "agent");
            xb_add(&bar[XB_XGEN(b.x)], 1u);
            asm volatile("s_waitcnt vmcnt(0)" ::: "memory");
        } else {
            XB_SPIN(xb_ld(&bar[XB_XGEN(b.x)]) == gen, bar);
            __builtin_amdgcn_fence(__ATOMIC_ACQUIRE, "agent");
            asm volatile("s_waitcnt vmcnt(0)" ::: "memory");
        }
    }
    __syncthreads();
}

constexpr int NWAVES = 8;
constexpr int BATCH = 8, T = 2048, D = 2048, M = BATCH * T;
constexpr int NPROJ = 10320, NPROJ_P = 10496;
constexpr int C_Q = 0, C_K = 1024, C_V = 1280, C_CQ = 1536, C_KID = 2048, C_WID = 2112, C_HQ = 2128, C_HF = 3152, C_HI = 4176, C_HG = 5200, C_GA = 6224, C_GH = 8272;
constexpr int FFD = 5632, FFE = 7168, NEXP = 8;
constexpr int MS = 34816;
constexpr float EPS = 1e-6f;
constexpr float ATT_SCALE = 0.08838834764831845f;
constexpr float IDX_WSCALE = 0.25f * 0.125f;
constexpr int NSEL = 256;

constexpr size_t MiB = 1u << 20;
constexpr size_t WS_CTL = 0, CTL_ZERO_BYTES = 1 * MiB;
constexpr size_t WS_WIN = 2 * MiB, WIN_SZ = 41 * MiB;
constexpr size_t WS_WIDX = 84 * MiB, WIDX_SZ = 1 * MiB;
constexpr size_t WS_WUA = 86 * MiB, WS_WUH = 94 * MiB, WU_SZ = 4 * MiB;
constexpr size_t WS_WO = 102 * MiB, WO_SZ = 8 * MiB;
constexpr size_t WS_W13D = 118 * MiB, WS_W2D = 162 * MiB;
constexpr size_t WS_W13M = 184 * MiB, WS_W2M = 632 * MiB;
constexpr size_t WS_XB = 856 * MiB;
constexpr size_t WS_PROJ = 920 * MiB;
constexpr size_t WS_QN = 1248 * MiB, WS_QIDX = 1280 * MiB, WS_KN = 1312 * MiB, WS_KIDX = 1320 * MiB, WS_WIDXV = 1322 * MiB, WS_MASK = 1323 * MiB;
constexpr size_t WS_RSTD1 = 1327 * MiB, WS_RSTDCQ = WS_RSTD1 + 65536;
constexpr size_t WS_MIX = 1328 * MiB;
constexpr size_t WS_TMP = 1392 * MiB;
constexpr size_t WS_MRG = 1520 * MiB;
constexpr size_t WS_H = 1584 * MiB;
constexpr size_t WS_ACTM = 920 * MiB;
constexpr size_t WS_Y = 1396 * MiB, WS_HS = 1396 * MiB;
constexpr size_t WS_TAB = 1712 * MiB;
constexpr size_t TAB_RSTD2 = 0, TAB_RSTDS = 1 * 65536, TAB_TOKE = 4 * 65536, TAB_TOKPOS = 6 * 65536, TAB_TOKP = 8 * 65536, TAB_TOKDEST = 10 * 65536;
constexpr size_t WS_ISCR = 408 * MiB;
constexpr size_t WS_HOI = 472 * MiB;
constexpr size_t WS_HSX = 536 * MiB;
constexpr size_t WS_HDEC = 604 * MiB;
constexpr size_t WS_HQH = 744 * MiB, WS_HUT = 776 * MiB;
static_assert(WS_W13M + 8ull * 2 * FFE * 2048 <= WS_ISCR && WS_HDEC + 2 * MiB <= WS_W2M && WS_W2M + 8ull * 2048 * FFE <= WS_HQH && WS_HUT + 64 * MiB <= WS_XB, "dedicated regions sit in the unused halves of the expert-weight slots");
constexpr size_t WS_HB = 1714 * MiB;
constexpr size_t WS_END = 1778 * MiB;
static_assert(WS_WIN + 2 * WIN_SZ <= WS_WIDX && WS_W2M + 8ull * 2048 * 7168 * 2 <= WS_XB && WS_PROJ + (size_t)M * NPROJ_P * 2 <= WS_QN && WS_ACTM + (size_t)MS * FFE * 2 <= WS_Y && WS_Y + (size_t)MS * 2048 * 4 <= WS_TAB && WS_H + (size_t)M * D * 4 <= WS_TAB && WS_MRG + (size_t)M * D * 2 <= WS_H && WS_TMP + (size_t)M * D * 4 <= WS_MRG && WS_MIX + (size_t)M * D * 2 <= WS_TMP && WS_RSTDCQ + 65536 <= WS_MIX && WS_XB + (size_t)M * D * 2 <= WS_PROJ && WS_TAB + 12 * 65536 <= WS_END, "ws map");
constexpr int CW_BAR = 4096;
constexpr int CW_ECNT = 16384;

constexpr int RING_OFF = 0, RING_BYTES = 131072;
constexpr int LDSCTL_OFF = 135168, MISC_OFF = LDSCTL_OFF + 320;
constexpr int LDS_BYTES = 147456;

__device__ const unsigned char BUCKET[129] = {0, 1, 2, 3, 4, 5, 6, 7, 8, 9, 10, 11, 12, 13, 14, 15, 16, 16, 16, 17, 17, 18, 18, 18, 19, 19, 19, 20, 20, 20, 20, 21, 21, 21, 21, 22, 22, 22, 22, 22, 23, 23, 23, 23, 23, 23, 24, 24, 24, 24, 24, 24, 25, 25, 25, 25, 25, 25, 25, 26, 26, 26, 26, 26, 26, 26, 26, 27, 27, 27, 27, 27, 27, 27, 27, 27, 27, 28, 28, 28, 28, 28, 28, 28, 28, 28, 28, 29, 29, 29, 29, 29, 29, 29, 29, 29, 29, 29, 29, 30, 30, 30, 30, 30, 30, 30, 30, 30, 30, 30, 30, 30, 30, 31, 31, 31, 31, 31, 31, 31, 31, 31, 31, 31, 31, 31, 31, 31, 31};

typedef unsigned v2u __attribute__((ext_vector_type(2)));
struct Args { const float* in[23]; float* out; unsigned char* ws; int ph_lo, ph_hi; };
typedef const __attribute__((address_space(4))) Args* KA;
__device__ __forceinline__ KA ka_get() { KA p = (KA)__builtin_amdgcn_kernarg_segment_ptr(); asm volatile("" : "+s"(p)); return p; }

struct Frame {
    LAS unsigned char* lds;
    int tid, lane, wave, G, bid;
};
__device__ __forceinline__ Frame make_frame(LAS unsigned char* lds, int wave_s) {
    Frame F; int ln; asm volatile("v_mbcnt_lo_u32_b32 %0, -1, 0\n\tv_mbcnt_hi_u32_b32 %0, -1, %0" : "=v"(ln));
    int w = wave_s, b = blockIdx.x, g = gridDim.x; asm volatile("" : "+s"(w), "+s"(b), "+s"(g));
    F.lds = lds; F.lane = ln; F.wave = w; F.tid = w * 64 + ln; F.G = g; F.bid = b; return F;
}
__device__ __forceinline__ bool in_range(int k, int lo, int hi) { asm volatile("" : "+s"(k)); return lo <= k && k < hi; }
template <int O> __device__ __forceinline__ float swz(float v) { return __builtin_bit_cast(float, __builtin_amdgcn_ds_swizzle(__builtin_bit_cast(int, v), (O << 10) | 0x1f)); }
__device__ __forceinline__ void swap32(unsigned a, unsigned& r0, unsigned& r1) { unsigned b = a; asm volatile("" : "+v"(b)); auto rr = __builtin_amdgcn_permlane32_swap(a, b, false, false); r0 = rr[0]; r1 = rr[1]; }
__device__ __forceinline__ float x32_sum(float v) { unsigned r0, r1; swap32(__builtin_bit_cast(unsigned, v), r0, r1); return __builtin_bit_cast(float, r0) + __builtin_bit_cast(float, r1); }
__device__ __forceinline__ float x32_max(float v) { unsigned r0, r1; swap32(__builtin_bit_cast(unsigned, v), r0, r1); return fmaxf(__builtin_bit_cast(float, r0), __builtin_bit_cast(float, r1)); }
__device__ __forceinline__ float wave_sum(float v) { v += swz<1>(v); v += swz<2>(v); v += swz<4>(v); v += swz<8>(v); v += swz<16>(v); return x32_sum(v); }
__device__ __forceinline__ float wave_max(float v) { v = fmaxf(v, swz<1>(v)); v = fmaxf(v, swz<2>(v)); v = fmaxf(v, swz<4>(v)); v = fmaxf(v, swz<8>(v)); v = fmaxf(v, swz<16>(v)); return x32_max(v); }
__device__ __forceinline__ float bf2f(bf16 v) { return __builtin_bit_cast(float, (unsigned)v << 16); }
__device__ __forceinline__ float blo(unsigned w) { return __builtin_bit_cast(float, w << 16); }
__device__ __forceinline__ float bhi(unsigned w) { return __builtin_bit_cast(float, w & 0xffff0000u); }
__device__ __forceinline__ float sigmf(float x) { return __builtin_amdgcn_rcpf(1.0f + __builtin_amdgcn_exp2f(-1.4426950408889634f * x)); }
__device__ __forceinline__ float siluf(float x) { return x * __builtin_amdgcn_rcpf(1.0f + __builtin_amdgcn_exp2f(-1.4426950408889634f * x)); }

struct ConvD { const float* src; bf16* dst; const float* gain; int K, N, Npad, nb; size_t sstride, dstride; int grp, gstride, goff; int f8; };
__device__ __forceinline__ void get_conv(int id, KA a, ConvD& d) {
    const int l = id >> 3, k = id & 7;
    bf16* ws16 = (bf16*)a->ws;
    d.gain = nullptr; d.nb = 1; d.sstride = 0; d.dstride = 0; d.grp = 30; d.gstride = 0; d.goff = 0; d.f8 = 0;
    if (k == 0) { d.src = a->in[4] + (size_t)l * 2048 * NPROJ; d.dst = (bf16*)(a->ws + WS_WIN + l * WIN_SZ); d.gain = a->in[2] + l * 2048; d.K = 2048; d.N = NPROJ; d.Npad = NPROJ_P; }
    else if (k == 1) { d.src = a->in[8] + (size_t)l * 512 * 1024; d.dst = (bf16*)(a->ws + WS_WIDX + l * WIDX_SZ); d.gain = a->in[7] + l * 512; d.K = 512; d.N = 1024; d.Npad = 1024; }
    else if (k == 2) { d.src = a->in[13] + (size_t)l * 1024 * 2048; d.dst = (bf16*)(a->ws + WS_WUA + l * WU_SZ); d.K = 1024; d.N = 2048; d.Npad = 2048; }
    else if (k == 3) { d.src = a->in[14] + (size_t)l * 1024 * 2048; d.dst = (bf16*)(a->ws + WS_WUH + l * WU_SZ); d.K = 1024; d.N = 2048; d.Npad = 2048; }
    else if (k == 4) { d.src = a->in[15] + (size_t)l * 2048 * 2048; d.dst = (bf16*)(a->ws + WS_WO + l * WO_SZ); d.K = 2048; d.N = 2048; d.Npad = 2048; }
    else if (l == 0) {
        if (k == 5) { d.src = a->in[16]; d.dst = (bf16*)(a->ws + WS_W13D); d.gain = a->in[3]; d.K = 2048; d.N = FFD; d.Npad = FFD; d.grp = 7; d.gstride = 256; d.goff = 0; }
        else if (k == 6) { d.src = a->in[17]; d.dst = (bf16*)(a->ws + WS_W13D); d.gain = a->in[3]; d.K = 2048; d.N = FFD; d.Npad = FFD; d.grp = 7; d.gstride = 256; d.goff = 128; }
        else { d.src = a->in[18]; d.dst = (bf16*)(a->ws + WS_W2D); d.K = FFD; d.N = 2048; d.Npad = 2048; }
    } else {
        if (k == 5) { d.src = a->in[20]; d.dst = (bf16*)(a->ws + WS_W13M); d.gain = a->in[3] + 2048; d.K = 2048; d.N = FFE; d.Npad = FFE; d.nb = NEXP; d.sstride = (size_t)2048 * FFE; d.dstride = (size_t)2 * FFE * 2048; d.grp = 7; d.gstride = 256; d.goff = 0; d.f8 = 1; }
        else if (k == 6) { d.src = a->in[21]; d.dst = (bf16*)(a->ws + WS_W13M); d.gain = a->in[3] + 2048; d.K = 2048; d.N = FFE; d.Npad = FFE; d.nb = NEXP; d.sstride = (size_t)2048 * FFE; d.dstride = (size_t)2 * FFE * 2048; d.grp = 7; d.gstride = 256; d.goff = 128; d.f8 = 1; }
        else { d.src = a->in[22]; d.dst = (bf16*)(a->ws + WS_W2M); d.K = FFE; d.N = 2048; d.Npad = 2048; d.nb = NEXP; d.sstride = (size_t)FFE * 2048; d.dstride = (size_t)2048 * FFE; d.f8 = 1; }
    }
    (void)ws16;
}
__device__ __forceinline__ void conv_item(const ConvD& d, long item, LAS float* scr, int lane) {
    const int nblk = d.Npad / 64, kblk = d.K / 64; const int per = kblk * nblk, it32 = (int)item;
    const int e = it32 / per; const int r = it32 - e * per; const int kb = r / nblk, nbi = r - kb * nblk, k0 = 64 * kb, n0 = 64 * nbi;
    const float* src = d.src + (size_t)e * d.sstride; bf16* dst = d.dst + (size_t)e * d.dstride; unsigned char* dst8 = (unsigned char*)d.dst + (size_t)e * d.dstride;
    const int nn = (lane & 15) * 4, kq = lane >> 4;
    const int c = lane & 7;
    f32x4 g0 = {1.f, 1.f, 1.f, 1.f}, g1 = g0;
    if (d.gain) { g0 = *(const GAS f32x4*)(d.gain + k0 + 8 * c); g1 = *(const GAS f32x4*)(d.gain + k0 + 8 * c + 4); }
    f32x4 v[16];
    if (n0 + 64 <= d.N) {
#pragma unroll
        for (int i = 0; i < 16; ++i) { const int kk = 4 * i + kq; v[i] = *(const GAS f32x4*)(src + (size_t)(k0 + kk) * d.N + n0 + nn); }
    } else {
#pragma unroll
        for (int i = 0; i < 16; ++i) { const int kk = 4 * i + kq; v[i] = (n0 + nn < d.N) ? *(const GAS f32x4*)(src + (size_t)(k0 + kk) * d.N + n0 + nn) : (f32x4){0.f, 0.f, 0.f, 0.f}; }
    }
#pragma unroll
    for (int i = 0; i < 16; ++i) { const int kk = 4 * i + kq; LAS float* p = scr + kk * 65 + nn; p[0] = v[i][0]; p[1] = v[i][1]; p[2] = v[i][2]; p[3] = v[i][3]; }
    LDS_WAIT(); asm volatile("" ::: "memory");
    const float g[8] = {g0[0], g0[1], g0[2], g0[3], g1[0], g1[1], g1[2], g1[3]};
#pragma unroll
    for (int j = 0; j < 8; ++j) { const int n = (lane >> 3) + 8 * j; const LAS float* s = scr + (8 * c) * 65 + n;
        const int ng = n0 + n; const int row = (ng >> d.grp) * d.gstride + d.goff + (ng & ((1 << d.grp) - 1));
        if (d.f8) { unsigned w0 = 0u, w1 = 0u;
            w0 = __builtin_amdgcn_cvt_pk_fp8_f32(s[0 * 65] * g[0] * 64.f, s[1 * 65] * g[1] * 64.f, w0, false); w0 = __builtin_amdgcn_cvt_pk_fp8_f32(s[2 * 65] * g[2] * 64.f, s[3 * 65] * g[3] * 64.f, w0, true);
            w1 = __builtin_amdgcn_cvt_pk_fp8_f32(s[4 * 65] * g[4] * 64.f, s[5 * 65] * g[5] * 64.f, w1, false); w1 = __builtin_amdgcn_cvt_pk_fp8_f32(s[6 * 65] * g[6] * 64.f, s[7 * 65] * g[7] * 64.f, w1, true);
            *(GAS v2u*)(dst8 + (size_t)row * d.K + k0 + 8 * c) = (v2u){w0, w1}; }
        else { v4u o; o.x = pk2(s[0 * 65] * g[0], s[1 * 65] * g[1]); o.y = pk2(s[2 * 65] * g[2], s[3 * 65] * g[3]); o.z = pk2(s[4 * 65] * g[4], s[5 * 65] * g[5]); o.w = pk2(s[6 * 65] * g[6], s[7 * 65] * g[7]);
            *(GAS v4u*)(dst + (size_t)row * d.K + k0 + 8 * c) = o; } }
    LDS_WAIT(); asm volatile("" ::: "memory");
}
__device__ __forceinline__ void phase_conv(Frame& F, KA a, int id_lo, int id_hi, int vb, int vG) {
    LAS float* scr = (LAS float*)(F.lds + F.wave * 16640);
    const long gw = (long)vb * NWAVES + F.wave, NGW = (long)vG * NWAVES;
    long base = 0;
#pragma unroll 1
    for (int id = id_lo; id < id_hi; ++id) {
        ConvD d; get_conv(id, a, d);
        const long items = (long)d.nb * (d.K / 64) * (d.Npad / 64);
        long first = (gw - base % NGW + NGW) % NGW;
#pragma unroll 1
        for (long it = first; it < items; it += NGW) conv_item(d, it, scr, F.lane);
        base += items;
    }
}

__device__ __forceinline__ void phase_norm(Frame& F, const float* src, bf16* dst, float* rstd) {
    const int gw = F.bid * NWAVES + F.wave, NGW = F.G * NWAVES;
    for (int row = gw; row < M; row += NGW) {
        const GAS f32x4* xr = (const GAS f32x4*)(src + (size_t)row * D) + F.lane;
        f32x4 v[8]; float s = 0.f;
#pragma unroll
        for (int j = 0; j < 8; ++j) { v[j] = xr[64 * j]; s += (v[j].x * v[j].x + v[j].y * v[j].y) + (v[j].z * v[j].z + v[j].w * v[j].w); }
        s = wave_sum(s);
        GAS v2u* o8 = (GAS v2u*)(dst + (size_t)row * D) + F.lane;
#pragma unroll
        for (int j = 0; j < 8; ++j) { v2u w; w.x = pk2(v[j].x, v[j].y); w.y = pk2(v[j].z, v[j].w); o8[64 * j] = w; }
        if (F.lane == 0) rstd[row] = 1.0f / sqrtf(s * (1.0f / D) + EPS);
    }
}

__device__ __forceinline__ void phase_post(Frame& F, KA a, int l) {
    const int gw = F.bid * NWAVES + F.wave, NGW = F.G * NWAVES, lane = F.lane;
    const bf16* proj = (const bf16*)(a->ws + WS_PROJ);
    bf16* qn = (bf16*)(a->ws + WS_QN); bf16* kn = (bf16*)(a->ws + WS_KN); bf16* kidx = (bf16*)(a->ws + WS_KIDX); float* widx = (float*)(a->ws + WS_WIDXV); float* rstdcq = (float*)(a->ws + WS_RSTDCQ);
    const float* qg = a->in[5] + l * 128; const float* kg = a->in[6] + l * 128; const float* lng = a->in[9] + l * 64; const float* lnb = a->in[10] + l * 64;
    for (int row = gw; row < M; row += NGW) {
        const bf16* pr = proj + (size_t)row * NPROJ_P;
        {
            const v4u w0 = *(const GAS v4u*)(pr + C_Q + 16 * lane), w1 = *(const GAS v4u*)(pr + C_Q + 16 * lane + 8);
            float x[16] = {blo(w0.x), bhi(w0.x), blo(w0.y), bhi(w0.y), blo(w0.z), bhi(w0.z), blo(w0.w), bhi(w0.w), blo(w1.x), bhi(w1.x), blo(w1.y), bhi(w1.y), blo(w1.z), bhi(w1.z), blo(w1.w), bhi(w1.w)};
            float ss = 0.f;
#pragma unroll
            for (int i = 0; i < 16; ++i) ss += x[i] * x[i];
            ss += swz<1>(ss); ss += swz<2>(ss); ss += swz<4>(ss);
            const float r = ATT_SCALE / sqrtf(ss * (1.0f / 128.0f) + EPS); const int d0 = (lane & 7) * 16;
            unsigned o[8];
#pragma unroll
            for (int i = 0; i < 8; ++i) o[i] = pk2(x[2 * i] * r * qg[d0 + 2 * i], x[2 * i + 1] * r * qg[d0 + 2 * i + 1]);
            *(GAS v4u*)(qn + (size_t)row * 1024 + 16 * lane) = (v4u){o[0], o[1], o[2], o[3]}; *(GAS v4u*)(qn + (size_t)row * 1024 + 16 * lane + 8) = (v4u){o[4], o[5], o[6], o[7]};
        }
        {
            const v2u w = *(const GAS v2u*)(pr + C_K + 4 * lane);
            const float x0 = blo(w.x), x1 = bhi(w.x), x2 = blo(w.y), x3 = bhi(w.y);
            float ss = x0 * x0 + x1 * x1 + x2 * x2 + x3 * x3;
            ss += swz<1>(ss); ss += swz<2>(ss); ss += swz<4>(ss); ss += swz<8>(ss); ss += swz<16>(ss);
            const float r = 1.0f / sqrtf(ss * (1.0f / 128.0f) + EPS); const int d0 = (lane & 31) * 4;
            v2u o; o.x = pk2(x0 * r * kg[d0], x1 * r * kg[d0 + 1]); o.y = pk2(x2 * r * kg[d0 + 2], x3 * r * kg[d0 + 3]);
            *(GAS v2u*)(kn + (size_t)row * 256 + 4 * lane) = o;
        }
        {
            const v4u w = *(const GAS v4u*)(pr + C_CQ + 8 * lane);
            const float x[8] = {blo(w.x), bhi(w.x), blo(w.y), bhi(w.y), blo(w.z), bhi(w.z), blo(w.w), bhi(w.w)};
            float ss = 0.f;
#pragma unroll
            for (int i = 0; i < 8; ++i) ss += x[i] * x[i];
            ss = wave_sum(ss);
            if (lane == 0) rstdcq[row] = 1.0f / sqrtf(ss * (1.0f / 512.0f) + EPS);
        }
        {
            const float x = bf2f(pr[C_KID + lane]);
            const float mu = wave_sum(x) * (1.0f / 64.0f); const float dd = x - mu; const float var = wave_sum(dd * dd) * (1.0f / 64.0f);
            const float y = dd / sqrtf(var + EPS) * lng[lane] + lnb[lane];
            kidx[(size_t)row * 64 + lane] = (bf16)f2bf(y);
        }
        if (lane < 16) widx[(size_t)row * 16 + lane] = bf2f(pr[C_WID + lane]) * IDX_WSCALE;
    }
}

__device__ __forceinline__ unsigned ordkey(float v) { const unsigned u = __builtin_bit_cast(unsigned, v); return (u & 0x80000000u) ? ~u : (u | 0x80000000u); }
typedef float f32x16 __attribute__((ext_vector_type(16)));
typedef float f32x2 __attribute__((ext_vector_type(2)));
__device__ __forceinline__ int wave_total6(int cl) { int c = 0;
#pragma unroll
    for (int b = 0; b < 6; ++b) c += __popcll(__ballot((cl >> b) & 1)) << b;
    return c; }
__device__ __forceinline__ void select_row(unsigned (&key)[32], int t, unsigned long long* mrow, int lane) {
    if (t + 1 <= NSEL) {
#pragma unroll
        for (int j = 0; j < 32; ++j) { const unsigned long long bs = __ballot(key[j] != 0u); if (lane == 0) mrow[j] = bs; }
    } else {
#pragma unroll
        for (int st = 0; st < 5; ++st) { const int j = 16 >> st; const unsigned m = st == 0 ? 0x0000FFFFu : st == 1 ? 0x00FF00FFu : st == 2 ? 0x0F0F0F0Fu : st == 3 ? 0x33333333u : 0x55555555u;
#pragma unroll
            for (int k = 0; k < 32; ++k) if (!(k & j)) { const unsigned x = ((key[k] >> j) ^ key[k + j]) & m; key[k] ^= x << j; key[k + j] ^= x; } }
        unsigned G = 0u, E = 0xffffffffu;
#pragma unroll
        for (int bit = 31; bit >= 0; --bit) {
            const unsigned m = E & key[bit];
            const bool take = wave_total6(__popc(G) + __popc(m)) >= NSEL;
            E = take ? m : (E & ~m); G = take ? G : (G | m);
        }
        const int need = NSEL - wave_total6(__popc(G)); int running = 0;
        const unsigned long long lt = (lane == 0) ? 0ull : (~0ull >> (64 - lane));
#pragma unroll
        for (int j = 0; j < 32; ++j) {
            const bool eq = (E >> j) & 1u; const unsigned long long be = __ballot(eq);
            const int rank = running + __popcll(be & lt);
            const bool sel = ((G >> j) & 1u) || (eq && rank < need);
            running += __popcll(be);
            const unsigned long long bs = __ballot(sel); if (lane == 0) mrow[j] = bs;
        }
    }
}
__device__ __forceinline__ void phase_index2(Frame& F, KA a) {
    LAS unsigned char* Ws = F.lds + 66048;
    LAS unsigned char* Qs = F.lds;
    const bf16* qidx = (const bf16*)(a->ws + WS_QIDX); const bf16* kidx = (const bf16*)(a->ws + WS_KIDX); const float* widx = (const float*)(a->ws + WS_WIDXV);
    unsigned long long* mask = (unsigned long long*)(a->ws + WS_MASK);
    float* scr = (float*)(a->ws + WS_ISCR) + (size_t)F.bid * 65536;
    const int tid = F.tid, lane = F.lane, r = lane & 31, hi = lane >> 5, wave = F.wave;
    for (int u = F.bid; u < 256; u += F.G) {
        const int b = u >> 5, ii = u & 31;
#pragma unroll 1
        for (int half = 0; half < 2; ++half) {
            const int qb = half ? 63 - ii : ii; const int row0 = b * T + 32 * qb;
#pragma unroll
            for (int c = 0; c < 8; ++c) { const int row = tid >> 4, ch = (tid & 15) + 16 * c;
                *(LAS v4u*)(Qs + row * 2064 + ch * 16) = *(const GAS v4u*)(qidx + (size_t)(row0 + row) * 1024 + ch * 8); }
            if (tid < 128) *(LAS f32x4*)(Ws + 16 * tid) = *(const GAS f32x4*)(widx + (size_t)row0 * 16 + 4 * tid);
            __syncthreads();
#pragma unroll 1
            for (int kb = wave; kb <= qb; kb += 8) {
                bf16x8 kf[4]; const bf16* kp = kidx + (size_t)(b * T + 32 * kb + r) * 64 + 8 * hi;
#pragma unroll
                for (int ks = 0; ks < 4; ++ks) kf[ks] = *(const GAS bf16x8*)(kp + 16 * ks);
                f32x16 sc;
#pragma unroll
                for (int i = 0; i < 16; ++i) sc[i] = 0.f;
                const LAS unsigned char* qrow = Qs + r * 2064 + hi * 16; const LAS float* wrow = (const LAS float*)(Ws + r * 64);
                bf16x8 qa[4], qb[4];
#pragma unroll
                for (int ks = 0; ks < 4; ++ks) qa[ks] = *(const LAS bf16x8*)(qrow + ks * 32);
#pragma unroll 1
                for (int h = 0; h < 16; h += 2) {
#pragma unroll
                    for (int ks = 0; ks < 4; ++ks) qb[ks] = *(const LAS bf16x8*)(qrow + (h + 1) * 128 + ks * 32);
                    const float wA = wrow[h], wB = wrow[h + 1];
                    f32x16 accA, accB;
#pragma unroll
                    for (int i = 0; i < 16; ++i) { accA[i] = 0.f; accB[i] = 0.f; }
                    __builtin_amdgcn_sched_barrier(0);
#pragma unroll
                    for (int ks = 0; ks < 4; ++ks) accA = __builtin_amdgcn_mfma_f32_32x32x16_bf16(kf[ks], qa[ks], accA, 0, 0, 0);
                    __builtin_amdgcn_sched_barrier(0);
                    if (h + 2 < 16) {
#pragma unroll
                        for (int ks = 0; ks < 4; ++ks) qa[ks] = *(const LAS bf16x8*)(qrow + (h + 2) * 128 + ks * 32); }
#pragma unroll
                    for (int ks = 0; ks < 4; ++ks) accB = __builtin_amdgcn_mfma_f32_32x32x16_bf16(kf[ks], qb[ks], accB, 0, 0, 0);
                    __builtin_amdgcn_sched_barrier(0);
#pragma unroll
                    for (int i = 0; i < 16; ++i) sc[i] = fmaf(wA, __builtin_amdgcn_fmed3f(accA[i], 0.f, 3.0e38f), sc[i]);
#pragma unroll
                    for (int i = 0; i < 16; ++i) sc[i] = fmaf(wB, __builtin_amdgcn_fmed3f(accB[i], 0.f, 3.0e38f), sc[i]);
                }
                LAS float* Tw = (LAS float*)(F.lds + 68096 + wave * 4224);
#pragma unroll
                for (int i = 0; i < 16; ++i) Tw[r * 33 + (i & 3) + 8 * (i >> 2) + 4 * hi] = sc[i];
                asm volatile("s_waitcnt lgkmcnt(0)" ::: "memory");
#pragma unroll
                for (int j = 0; j < 16; ++j) { const int q = 2 * j + hi; scr[(size_t)q * 2048 + 32 * kb + r] = Tw[q * 33 + r]; }
                asm volatile("s_waitcnt lgkmcnt(0)" ::: "memory");
            }
            __syncthreads();
#pragma unroll 1
            for (int pass = 0; pass < 2; ++pass) {
                const int q0 = 4 * wave + 2 * pass, ta = 32 * qb + q0, tb = ta + 1; const size_t rowa = (size_t)row0 + q0;
                unsigned ka[32], kb2[32];
#pragma unroll
                for (int j = 0; j < 32; ++j) { const int s = lane + 64 * j; float vx = 0.f, vy = 0.f;
                    if (s <= 32 * qb + 31) { vx = *(const GAS float*)(scr + (size_t)q0 * 2048 + s); vy = *(const GAS float*)(scr + (size_t)(q0 + 1) * 2048 + s); }
                    ka[j] = (s <= ta) ? ordkey(vx) : 0u; kb2[j] = (s <= tb) ? ordkey(vy) : 0u; }
                select_row(ka, ta, mask + rowa * 32, lane);
                select_row(kb2, tb, mask + (rowa + 1) * 32, lane);
            }
            __syncthreads();
        }
    }
}

namespace att {
using s16x4  = __attribute__((ext_vector_type(4))) short;
constexpr int KVBLK = 64; constexpr size_t SHM_V = 16384, SHM_K = 16384; constexpr int OFF_WS = 65536, OFF_BIAS = 67584;
constexpr float THR = 8.f, LOG2E = 1.4426950408889634f;
#define KSWZ(row, colB) ((row) * 256 + ((colB) ^ (((row) & 7) << 4)))
#define SBAR() __builtin_amdgcn_sched_barrier(0)
__device__ __forceinline__ int crow(int r, int hi) { return (r & 3) + 8 * (r >> 2) + 4 * hi; }
__device__ __forceinline__ unsigned cvtpk(float lo, float hi) { unsigned r; asm volatile("v_cvt_pk_bf16_f32 %0, %1, %2" : "=v"(r) : "v"(lo), "v"(hi)); return r; }
template <bool NEAR> __device__ __forceinline__ void mask_bias(f32x16& p0, f32x16& p1, unsigned w0, unsigned w1, int hi, int dbase, const LAS float* bt) {
    const unsigned s0 = w0 >> (4 * hi), s1 = w1 >> (4 * hi);
#pragma unroll
    for (int r = 0; r < 16; ++r) { const int bp = (r & 3) + 8 * (r >> 2);
        float a = p0[r], b = p1[r];
        if (NEAR) { int i0 = dbase - bp, i1 = dbase - bp - 32; i0 = i0 < 0 ? 0 : (i0 > 128 ? 128 : i0); i1 = i1 < 0 ? 0 : (i1 > 128 ? 128 : i1); a += bt[i0]; b += bt[i1]; }
        p0[r] = ((s0 >> bp) & 1u) ? a : -INFINITY; p1[r] = ((s1 >> bp) & 1u) ? b : -INFINITY; }
}
__device__ __forceinline__ void partialSM(f32x16& p0, f32x16& p1, float badd, float& m_reg, float& mn, float& alpha) {
  float pmax = p0[0];
#pragma unroll
  for (int r = 1; r < 16; ++r) pmax = __builtin_amdgcn_fmed3f(pmax, p0[r], INFINITY);
#pragma unroll
  for (int r = 0; r < 16; ++r) pmax = __builtin_amdgcn_fmed3f(pmax, p1[r], INFINITY);
  pmax += badd;
  pmax = x32_max(pmax);
  if (__builtin_expect(__all(pmax - m_reg <= THR), 1)) { mn = m_reg; alpha = 1.f; }
  else { mn = fmaxf(m_reg, pmax); alpha = __builtin_amdgcn_exp2f((m_reg - mn) * LOG2E); m_reg = mn; }
  const float mnC = (badd - mn) * LOG2E;
#pragma unroll
  for (int r = 0; r < 16; ++r) p0[r] = fmaf(p0[r], LOG2E, mnC);
#pragma unroll
  for (int r = 0; r < 16; ++r) p1[r] = fmaf(p1[r], LOG2E, mnC);
#pragma unroll
  for (int r = 0; r < 16; ++r) p0[r] = __builtin_amdgcn_exp2f(p0[r]);
}
__device__ __forceinline__ void finishSM(f32x16& p0, f32x16& p1, float alpha, float& l_reg, bf16x8& pa0, bf16x8& pa1, bf16x8& pa2, bf16x8& pa3) {
#pragma unroll
  for (int r = 0; r < 16; ++r) p1[r] = __builtin_amdgcn_exp2f(p1[r]);
  float ps = 0;
#pragma unroll
  for (int r = 0; r < 16; ++r) ps += p0[r];
#pragma unroll
  for (int r = 0; r < 16; ++r) ps += p1[r];
  ps = x32_sum(ps);
  l_reg = l_reg * alpha + ps;
#define PK4(P, BASE, OUT) do { unsigned a0 = cvtpk(P[BASE + 0], P[BASE + 1]), a1 = cvtpk(P[BASE + 2], P[BASE + 3]);   \
    unsigned b0 = cvtpk(P[BASE + 4], P[BASE + 5]), b1 = cvtpk(P[BASE + 6], P[BASE + 7]);                              \
    auto r0 = __builtin_amdgcn_permlane32_swap(a0, b0, false, false); auto r1 = __builtin_amdgcn_permlane32_swap(a1, b1, false, false); \
    v4u w = {r0[0], r1[0], r0[1], r1[1]}; OUT = __builtin_bit_cast(bf16x8, w); } while (0)
  PK4(p0, 0, pa0); PK4(p0, 8, pa1); PK4(p1, 0, pa2); PK4(p1, 8, pa3);
#undef PK4
}
__device__ __forceinline__ void qkt(f32x16& p0, f32x16& p1, const LAS char* Ks, const bf16x8* qr, int r32, int hi) {
#pragma unroll
  for (int r = 0; r < 16; ++r) { p0[r] = 0.f; p1[r] = 0.f; }
#pragma unroll
  for (int d0 = 0; d0 < 8; ++d0) { const int cb = (d0 * 16 + hi * 8) * 2;
    const bf16x8 b0 = *(const LAS bf16x8*)(Ks + KSWZ(r32, cb));
    const bf16x8 b1 = *(const LAS bf16x8*)(Ks + KSWZ(32 + r32, cb));
    p0 = __builtin_amdgcn_mfma_f32_32x32x16_bf16(b0, qr[d0], p0, 0, 0, 0);
    p1 = __builtin_amdgcn_mfma_f32_32x32x16_bf16(b1, qr[d0], p1, 0, 0, 0); }
}
__device__ __forceinline__ int v_st(int k, int c) { const int kk = (k & ~0xC) | ((k & 4) << 1) | ((k & 8) >> 1); return ((kk >> 3) * 4 + (c >> 5)) * 512 + ((kk & 7) * 32 + (c & 31)) * 2; }
__device__ __forceinline__ int v_rd_base(int lane) { return ((lane & 3) << 3) | (((lane >> 2) & 3) << 6) | (((lane >> 4) & 1) << 5) | (((lane >> 5) & 1) << 8); }
constexpr int v_rd_off(int d0, int ks, int half) { return d0 * 512 + ks * 4096 + half * 2048; }
template <int OFF> __device__ __forceinline__ s16x4 tr_read(int vb) { s16x4 r; asm volatile("ds_read_b64_tr_b16 %0, %1 offset:%2" : "=&v"(r) : "v"(vb), "i"(OFF) : "memory"); return r; }
template <int D0> __device__ __forceinline__ void pv_one(f32x16& od, int vb, bf16x8 pa0, bf16x8 pa1, bf16x8 pa2, bf16x8 pa3) {
  const s16x4 l0 = tr_read<v_rd_off(D0, 0, 0)>(vb), h0 = tr_read<v_rd_off(D0, 0, 1)>(vb), l1 = tr_read<v_rd_off(D0, 1, 0)>(vb), h1 = tr_read<v_rd_off(D0, 1, 1)>(vb);
  const s16x4 l2 = tr_read<v_rd_off(D0, 2, 0)>(vb), h2 = tr_read<v_rd_off(D0, 2, 1)>(vb), l3 = tr_read<v_rd_off(D0, 3, 0)>(vb), h3 = tr_read<v_rd_off(D0, 3, 1)>(vb);
  asm volatile("s_waitcnt lgkmcnt(0)" ::: "memory"); SBAR();
#define PK(L, H) (bf16x8){L[0], L[1], L[2], L[3], H[0], H[1], H[2], H[3]}
  od = __builtin_amdgcn_mfma_f32_32x32x16_bf16(pa0, PK(l0, h0), od, 0, 0, 0);
  od = __builtin_amdgcn_mfma_f32_32x32x16_bf16(pa1, PK(l1, h1), od, 0, 0, 0);
  od = __builtin_amdgcn_mfma_f32_32x32x16_bf16(pa2, PK(l2, h2), od, 0, 0, 0);
  od = __builtin_amdgcn_mfma_f32_32x32x16_bf16(pa3, PK(l3, h3), od, 0, 0, 0);
#undef PK
}
__device__ __forceinline__ void pv_d0(f32x16* o, int vb, bf16x8 pa0, bf16x8 pa1, bf16x8 pa2, bf16x8 pa3) {
  pv_one<0>(o[0], vb, pa0, pa1, pa2, pa3); pv_one<1>(o[1], vb, pa0, pa1, pa2, pa3); pv_one<2>(o[2], vb, pa0, pa1, pa2, pa3); pv_one<3>(o[3], vb, pa0, pa1, pa2, pa3);
}
__device__ __forceinline__ void attn_unit(const bf16* __restrict__ Qt, const bf16* __restrict__ Kh, const bf16* __restrict__ Vh, const unsigned* __restrict__ mrow, bf16* __restrict__ Ob,
                                          int kvh, int qt, const float* relb, LAS char* lds, int tid) {
  constexpr int LDKK = 256, LDKV = NPROJ_P;
  const int wid = __builtin_amdgcn_readfirstlane(tid >> 6), lane = tid & 63, r32 = lane & 31, hi = lane >> 5;
  LAS char* V_lds = lds; LAS char* K_lds = lds + 2 * SHM_V;
  LAS float* wsf = (LAS float*)(lds + OFF_WS) + wid * 64; LAS float* li_l = wsf; LAS float* al_l = wsf + 32;
  const int hq = kvh * 4 + (wid >> 1), tq0 = 64 * qt + 32 * (wid & 1), tq = tq0 + r32;
  const LAS float* bt = (const LAS float*)(lds + OFF_BIAS) + hq * 132;
  const float bfar = relb[31 * 8 + hq];
  float m_reg = -1e30f, l_reg = 0; f32x16 o[4]; bf16x8 qr[8];
#pragma unroll
  for (int d = 0; d < 4; ++d)
#pragma unroll
    for (int r = 0; r < 16; ++r) o[d][r] = 0.f;
  const bf16* Qw = Qt + (size_t)tq * 1024 + hq * 128 + hi * 8;
#pragma unroll
  for (int d0 = 0; d0 < 8; ++d0) qr[d0] = *(const GAS bf16x8*)(Qw + d0 * 16);
  const unsigned* mq = mrow + (size_t)tq * 64;
  const int sr = tid >> 4, sc = (tid & 15) * 8, vst0 = v_st(sr, sc), vst1 = v_st(32 + sr, sc);
  const int vb0 = (int)(size_t)V_lds + v_rd_base(lane);
  struct { bf16x8 vs0, vs1, ks0, ks1; } sr_[1];
#define SLOAD(i, k0) do { sr_[i].vs0 = *(const GAS bf16x8*)(&Vh[(size_t)((k0) + sr) * LDKV + sc]); sr_[i].vs1 = *(const GAS bf16x8*)(&Vh[(size_t)((k0) + 32 + sr) * LDKV + sc]); \
    sr_[i].ks0 = *(const GAS bf16x8*)(&Kh[(size_t)((k0) + sr) * LDKK + sc]); sr_[i].ks1 = *(const GAS bf16x8*)(&Kh[(size_t)((k0) + 32 + sr) * LDKK + sc]); } while (0)
#define SWRITE(b, i) do { *(LAS bf16x8*)(V_lds + (b) * SHM_V + vst0) = sr_[i].vs0;          \
    *(LAS bf16x8*)(V_lds + (b) * SHM_V + vst1) = sr_[i].vs1; const int kc = sc * 2;               \
    *(LAS bf16x8*)(K_lds + (b) * SHM_K + KSWZ(sr, kc)) = sr_[i].ks0;                       \
    *(LAS bf16x8*)(K_lds + (b) * SHM_K + KSWZ(32 + sr, kc)) = sr_[i].ks1; } while (0)
#define RESC(a) do { if (__any((a) < 1.f)) { if (hi == 0) al_l[r32] = (a); asm volatile("s_waitcnt lgkmcnt(0)" ::: "memory"); \
    _Pragma("unroll") for (int d = 0; d < 4; ++d) _Pragma("unroll") for (int r = 0; r < 16; ++r) o[d][r] *= al_l[crow(r, hi)]; } } while (0)
#define MASKB(P0, P1, j, BADD) do { const v2u mw_ = *(const GAS v2u*)(mq + 2 * (j)); \
    if ((j) + 3 <= qt) { mask_bias<false>(P0, P1, mw_.x, mw_.y, hi, 0, bt); BADD = bfar; } \
    else { mask_bias<true>(P0, P1, mw_.x, mw_.y, hi, tq - 64 * (j) - 4 * hi, bt); BADD = 0.f; } } while (0)
  f32x16 p0, p1; float mn, al, bd; bf16x8 pa0, pa1, pa2, pa3;
  const int NT = qt + 1;
  SLOAD(0, 0); asm volatile("s_waitcnt vmcnt(0)" ::: "memory"); SWRITE(0, 0); __syncthreads();
#pragma unroll 1
  for (int j = 0; j < NT; ++j) {
    const int bsel = j & 1;
    if (j + 1 < NT) SLOAD(0, (j + 1) * KVBLK);
    SBAR(); qkt(p0, p1, K_lds + bsel * SHM_K, qr, r32, hi);
    MASKB(p0, p1, j, bd); partialSM(p0, p1, bd, m_reg, mn, al);
    RESC(al);
    finishSM(p0, p1, al, l_reg, pa0, pa1, pa2, pa3); SBAR();
    pv_d0(o, vb0 + bsel * (int)SHM_V, pa0, pa1, pa2, pa3);
    if (j + 1 < NT) { asm volatile("s_waitcnt vmcnt(0)" ::: "memory"); SWRITE(bsel ^ 1, 0); }
    __syncthreads();
  }
  if (hi == 0) li_l[r32] = l_reg; asm volatile("s_waitcnt lgkmcnt(0)" ::: "memory");
  float rli[16];
#pragma unroll
  for (int r = 0; r < 16; ++r) rli[r] = __builtin_amdgcn_rcpf(li_l[crow(r, hi)]);
  bf16* Ow = Ob + (size_t)tq0 * 2048 + hq * 128;
#pragma unroll
  for (int r = 0; r < 16; ++r) { const int orow = crow(r, hi);
#pragma unroll
    for (int d0 = 0; d0 < 4; ++d0) Ow[(size_t)orow * 2048 + d0 * 32 + r32] = (bf16)f2bf(o[d0][r] * rli[r]); }
  __syncthreads();
#undef SLOAD
#undef SWRITE
#undef RESC
#undef MASKB
}
#undef KSWZ
#undef SBAR
}
__device__ __forceinline__ void phase_attn2(Frame& F, KA a) {
    const bf16* qn = (const bf16*)(a->ws + WS_QN); const bf16* kn = (const bf16*)(a->ws + WS_KN); const bf16* proj = (const bf16*)(a->ws + WS_PROJ);
    const unsigned* mask = (const unsigned*)(a->ws + WS_MASK); bf16* mix = (bf16*)(a->ws + WS_MIX); const float* relb = a->in[1];
    LAS float* btab = (LAS float*)(F.lds + att::OFF_BIAS);
    for (int i = F.tid; i < 8 * 129; i += NWAVES * 64) { const int h = i / 129, d = i - h * 129; btab[h * 132 + d] = relb[BUCKET[d] * 8 + h]; }
    __syncthreads();
    for (int u = F.bid; u < 256; u += F.G) {
        const int b = u >> 5, kvh = (u >> 4) & 1, ip = u & 15;
#pragma unroll 1
        for (int half = 0; half < 2; ++half) {
            const int qt = half ? ip : 31 - ip;
            att::attn_unit(qn + (size_t)b * T * 1024, kn + (size_t)b * T * 256 + kvh * 128, proj + (size_t)b * T * NPROJ_P + C_V + kvh * 128, mask + (size_t)b * T * 64, mix + (size_t)b * T * 2048,
                           kvh, qt, relb, (LAS char*)F.lds, F.tid);
        }
    }
}

__device__ __forceinline__ void phase_hgrn(Frame& F, KA a, int l) {
    LAS float* qs = (LAS float*)(F.lds); LAS float* fs = (LAS float*)(F.lds + 16384); LAS float* ks = (LAS float*)(F.lds + 32768); LAS float* vs = (LAS float*)(F.lds + 49152); LAS float* ob = (LAS float*)(F.lds + 65536);
    const bf16* proj = (const bf16*)(a->ws + WS_PROJ); bf16* mix = (bf16*)(a->ws + WS_MIX);
    const float* lbl = a->in[11]; const float* gn = a->in[12] + l * 128;
    const int tid = F.tid, j = tid >> 2, dsl = tid & 3, tt_s = tid >> 4, d8 = (tid & 15) * 8;
    for (int unit = F.bid; unit < BATCH * 8; unit += F.G) {
        const int b = unit >> 3, h = unit & 7;
        float lbv[8];
#pragma unroll
        for (int i = 0; i < 8; ++i) lbv[i] = (l == 0) ? 0.f : sigmf(lbl[1024 + h * 128 + d8 + i] - lbl[h * 128 + d8 + i]);
        float S[32];
#pragma unroll
        for (int i = 0; i < 32; ++i) S[i] = 0.f;
#pragma unroll 1
        for (int c = 0; c < T / 32; ++c) {
            {   const bf16* pr = proj + (size_t)(b * T + c * 32 + tt_s) * NPROJ_P + h * 128 + d8;
                const v4u wq = *(const GAS v4u*)(pr + C_HQ), wfv = *(const GAS v4u*)(pr + C_HF), wi = *(const GAS v4u*)(pr + C_HI);
                const float xq[8] = {blo(wq.x), bhi(wq.x), blo(wq.y), bhi(wq.y), blo(wq.z), bhi(wq.z), blo(wq.w), bhi(wq.w)};
                const float xf[8] = {blo(wfv.x), bhi(wfv.x), blo(wfv.y), bhi(wfv.y), blo(wfv.z), bhi(wfv.z), blo(wfv.w), bhi(wfv.w)};
                const float xi[8] = {blo(wi.x), bhi(wi.x), blo(wi.y), bhi(wi.y), blo(wi.z), bhi(wi.z), blo(wi.w), bhi(wi.w)};
                float q[8], f[8], k[8];
#pragma unroll
                for (int i = 0; i < 8; ++i) { q[i] = siluf(xq[i]) * ATT_SCALE; f[i] = lbv[i] + (1.0f - lbv[i]) * sigmf(xf[i]); k[i] = 1.0f - f[i]; }
                const int o = tt_s * 128 + d8;
                *(LAS f32x4*)(qs + o) = (f32x4){q[0], q[1], q[2], q[3]}; *(LAS f32x4*)(qs + o + 4) = (f32x4){q[4], q[5], q[6], q[7]};
                *(LAS f32x4*)(fs + o) = (f32x4){f[0], f[1], f[2], f[3]}; *(LAS f32x4*)(fs + o + 4) = (f32x4){f[4], f[5], f[6], f[7]};
                *(LAS f32x4*)(ks + o) = (f32x4){k[0], k[1], k[2], k[3]}; *(LAS f32x4*)(ks + o + 4) = (f32x4){k[4], k[5], k[6], k[7]};
                *(LAS f32x4*)(vs + o) = (f32x4){xi[0], xi[1], xi[2], xi[3]}; *(LAS f32x4*)(vs + o + 4) = (f32x4){xi[4], xi[5], xi[6], xi[7]};
            }
            __syncthreads();
#pragma unroll 1
            for (int tt = 0; tt < 32; ++tt) {
                const float v = vs[tt * 128 + j]; float o = 0.f;
                const LAS f32x4* f4 = (const LAS f32x4*)(fs + tt * 128 + dsl * 32); const LAS f32x4* k4 = (const LAS f32x4*)(ks + tt * 128 + dsl * 32); const LAS f32x4* q4 = (const LAS f32x4*)(qs + tt * 128 + dsl * 32);
#pragma unroll
                for (int i4 = 0; i4 < 8; ++i4) { const f32x4 ff = f4[i4], kk = k4[i4], qq = q4[i4];
                    S[4 * i4] = ff.x * S[4 * i4] + kk.x * v; o += qq.x * S[4 * i4];
                    S[4 * i4 + 1] = ff.y * S[4 * i4 + 1] + kk.y * v; o += qq.y * S[4 * i4 + 1];
                    S[4 * i4 + 2] = ff.z * S[4 * i4 + 2] + kk.z * v; o += qq.z * S[4 * i4 + 2];
                    S[4 * i4 + 3] = ff.w * S[4 * i4 + 3] + kk.w * v; o += qq.w * S[4 * i4 + 3]; }
                o += swz<1>(o); o += swz<2>(o);
                if (dsl == 0) ob[tt * 128 + j] = o;
            }
            __syncthreads();
            {   const size_t row = (size_t)(b * T + c * 32 + tt_s);
                const f32x4 o0 = *(const LAS f32x4*)(ob + tt_s * 128 + d8), o1 = *(const LAS f32x4*)(ob + tt_s * 128 + d8 + 4);
                float ss = (o0.x * o0.x + o0.y * o0.y) + (o0.z * o0.z + o0.w * o0.w) + (o1.x * o1.x + o1.y * o1.y) + (o1.z * o1.z + o1.w * o1.w);
                ss += swz<1>(ss); ss += swz<2>(ss); ss += swz<4>(ss); ss += swz<8>(ss);
                const float r = 1.0f / sqrtf(ss * (1.0f / 128.0f) + EPS);
                const v4u wg = *(const GAS v4u*)(proj + row * NPROJ_P + C_HG + h * 128 + d8);
                const float xg[8] = {blo(wg.x), bhi(wg.x), blo(wg.y), bhi(wg.y), blo(wg.z), bhi(wg.z), blo(wg.w), bhi(wg.w)};
                const float ov[8] = {o0.x, o0.y, o0.z, o0.w, o1.x, o1.y, o1.z, o1.w};
                unsigned pw[4];
#pragma unroll
                for (int i = 0; i < 4; ++i) pw[i] = pk2(ov[2 * i] * r * gn[d8 + 2 * i] * siluf(xg[2 * i]), ov[2 * i + 1] * r * gn[d8 + 2 * i + 1] * siluf(xg[2 * i + 1]));
                *(GAS v4u*)(mix + row * 2048 + 1024 + h * 128 + d8) = (v4u){pw[0], pw[1], pw[2], pw[3]};
            }
            __syncthreads();
        }
    }
}


namespace hg {
constexpr int LQ = 272, LT = 144;
constexpr int OFF_G = 0, OFF_TOT = 32768, OFF_BV = 34816, OFF_QH0 = 36864, OFF_QH1 = OFF_QH0 + 64 * LQ, OFF_KH = OFF_QH1 + 32 * LQ, OFF_KP = OFF_KH + 64 * LQ, OFF_K2T = OFF_KP + 64 * LQ, OFF_VT = OFF_K2T + 128 * LT, OFF_END = OFF_VT + 128 * LT;
static_assert(OFF_END <= LDSCTL_OFF, "hgrn LDS map");
__device__ __forceinline__ int crow(int r, int hi) { return (r & 3) + 8 * (r >> 2) + 4 * hi; }
__device__ __forceinline__ bf16x8 pack8(const f32x16& x, int s) { v4u w; w.x = pk2(x[8 * s], x[8 * s + 1]); w.y = pk2(x[8 * s + 2], x[8 * s + 3]); w.z = pk2(x[8 * s + 4], x[8 * s + 5]); w.w = pk2(x[8 * s + 6], x[8 * s + 7]); return __builtin_bit_cast(bf16x8, w); }
__device__ __forceinline__ f32x16 xblock(const LAS unsigned char* Kt, const LAS unsigned char* Qt, int r32, int hi) {
    f32x16 x;
#pragma unroll
    for (int i = 0; i < 16; ++i) x[i] = 0.f;
#pragma unroll
    for (int st = 0; st < 8; ++st) { const bf16x8 ka = *(const LAS bf16x8*)(Kt + r32 * LQ + (16 * st + 8 * hi) * 2), qb = *(const LAS bf16x8*)(Qt + r32 * LQ + (16 * st + 8 * hi) * 2);
        x = __builtin_amdgcn_mfma_f32_32x32x16_bf16(ka, qb, x, 0, 0, 0); }
    return x;
}
__device__ __forceinline__ void xtv(f32x16& od, const f32x16& x_, const LAS unsigned char* vt  , int hi) {
    f32x16 x = x_; asm volatile("s_nop 15\n\ts_nop 3" : "+v"(x));
#pragma unroll
    for (int st = 0; st < 2; ++st) { const v2u lo = *(const LAS v2u*)(vt + (16 * st + 4 * hi) * 2), hi2 = *(const LAS v2u*)(vt + (16 * st + 8 + 4 * hi) * 2);
        const v4u w = {lo.x, lo.y, hi2.x, hi2.y};
        od = __builtin_amdgcn_mfma_f32_32x32x16_bf16(pack8(x, st), __builtin_bit_cast(bf16x8, w), od, 0, 0, 0); }
}
}
__device__ __forceinline__ void phase_hgrn1(Frame& F, KA a, int l) {
    using namespace hg;
    LAS unsigned char* L = F.lds; LAS float* G = (LAS float*)(L + OFF_G); LAS float* TOT = (LAS float*)(L + OFF_TOT); LAS float* BV = (LAS float*)(L + OFF_BV);
    const bf16* proj = (const bf16*)(a->ws + WS_PROJ);
    float* OI = (float*)(a->ws + WS_HOI); bf16* UT = (bf16*)(a->ws + WS_HUT); bf16* QH = (bf16*)(a->ws + WS_HQH); float* DEC = (float*)(a->ws + WS_HDEC);
    const float* lbl = a->in[11];
    const int tid = F.tid, lane = F.lane, r32 = lane & 31, hi = lane >> 5, wave = F.wave;
    for (int u = F.bid; u < BATCH * 8 * 32; u += F.G) {
        const int c = u & 31, h = (u >> 5) & 7, b = u >> 8; const size_t row0 = (size_t)b * T + 64 * c;
        float qv[2][8], kv[2][8];
#pragma unroll
        for (int k = 0; k < 2; ++k) { const int slot = tid + 512 * k, t = slot >> 4, d8 = (slot & 15) * 8;
            const bf16* pr = proj + (row0 + t) * NPROJ_P + h * 128 + d8;
            const v4u wq = *(const GAS v4u*)(pr + C_HQ), wf = *(const GAS v4u*)(pr + C_HF), wi = *(const GAS v4u*)(pr + C_HI);
            const float xq[8] = {blo(wq.x), bhi(wq.x), blo(wq.y), bhi(wq.y), blo(wq.z), bhi(wq.z), blo(wq.w), bhi(wq.w)};
            const float xf[8] = {blo(wf.x), bhi(wf.x), blo(wf.y), bhi(wf.y), blo(wf.z), bhi(wf.z), blo(wf.w), bhi(wf.w)};
            float g[8];
#pragma unroll
            for (int i = 0; i < 8; ++i) { const float lb = (l == 0) ? 0.f : sigmf(lbl[1024 + h * 128 + d8 + i] - lbl[h * 128 + d8 + i]);
                const float f = lb + (1.0f - lb) * sigmf(xf[i]); qv[k][i] = siluf(xq[i]) * ATT_SCALE; kv[k][i] = 1.0f - f; g[i] = __logf(f); }
            *(LAS f32x4*)(G + t * 128 + d8) = (f32x4){g[0], g[1], g[2], g[3]}; *(LAS f32x4*)(G + t * 128 + d8 + 4) = (f32x4){g[4], g[5], g[6], g[7]};
            const unsigned vw[4] = {wi.x, wi.y, wi.z, wi.w};
#pragma unroll
            for (int i = 0; i < 8; ++i) *(LAS bf16*)(L + OFF_VT + (d8 + i) * LT + t * 2) = (bf16)((i & 1) ? (vw[i >> 1] >> 16) : (vw[i >> 1] & 0xffffu));
        }
        __syncthreads();
        { const int d = tid & 127, sb = tid >> 7; float run = 0.f;
#pragma unroll
            for (int i = 0; i < 16; ++i) { run += G[(16 * sb + i) * 128 + d]; G[(16 * sb + i) * 128 + d] = run; }
            TOT[sb * 128 + d] = run;
            __syncthreads();
            float off = 0.f;
#pragma unroll
            for (int q = 0; q < 3; ++q) off += (q < sb) ? TOT[q * 128 + d] : 0.f;
#pragma unroll
            for (int i = 0; i < 16; ++i) G[(16 * sb + i) * 128 + d] += off;
            if (sb == 0) { const float b1 = TOT[d] + TOT[128 + d], bl = b1 + TOT[256 + d] + TOT[384 + d]; BV[d] = b1; BV[128 + d] = bl;
                DEC[(size_t)u * 128 + d] = __expf(bl); }
        }
        __syncthreads();
#pragma unroll
        for (int k = 0; k < 2; ++k) { const int slot = tid + 512 * k, t = slot >> 4, d8 = (slot & 15) * 8; const int J = t >> 5;
            const f32x4 ba = *(const LAS f32x4*)(G + t * 128 + d8), bb = *(const LAS f32x4*)(G + t * 128 + d8 + 4);
            const f32x4 b1a = *(const LAS f32x4*)(BV + d8), b1b = *(const LAS f32x4*)(BV + d8 + 4), bla = *(const LAS f32x4*)(BV + 128 + d8), blb = *(const LAS f32x4*)(BV + 128 + d8 + 4);
            const float bt[8] = {ba.x, ba.y, ba.z, ba.w, bb.x, bb.y, bb.z, bb.w}, b1[8] = {b1a.x, b1a.y, b1a.z, b1a.w, b1b.x, b1b.y, b1b.z, b1b.w}, bl[8] = {bla.x, bla.y, bla.z, bla.w, blb.x, blb.y, blb.z, blb.w};
            float q0[8], q1[8], kh[8], kp[8], k2[8];
#pragma unroll
            for (int i = 0; i < 8; ++i) { const float bj = J ? b1[i] : 0.f, bj1 = J ? bl[i] : b1[i];
                q0[i] = qv[k][i] * __expf(bt[i]); q1[i] = qv[k][i] * __expf(bt[i] - b1[i]);
                kh[i] = kv[k][i] * __expf(bj1 - bt[i]); kp[i] = kv[k][i] * __expf(fminf(bj - bt[i], 80.f)); k2[i] = kv[k][i] * __expf(bl[i] - bt[i]); }
            const v4u w0 = {pk2(q0[0], q0[1]), pk2(q0[2], q0[3]), pk2(q0[4], q0[5]), pk2(q0[6], q0[7])};
            *(LAS v4u*)(L + OFF_QH0 + t * LQ + d8 * 2) = w0; *(GAS v4u*)(QH + (row0 + t) * 1024 + h * 128 + d8) = w0;
            if (J) *(LAS v4u*)(L + OFF_QH1 + (t - 32) * LQ + d8 * 2) = (v4u){pk2(q1[0], q1[1]), pk2(q1[2], q1[3]), pk2(q1[4], q1[5]), pk2(q1[6], q1[7])};
            *(LAS v4u*)(L + OFF_KH + t * LQ + d8 * 2) = (v4u){pk2(kh[0], kh[1]), pk2(kh[2], kh[3]), pk2(kh[4], kh[5]), pk2(kh[6], kh[7])};
            *(LAS v4u*)(L + OFF_KP + t * LQ + d8 * 2) = (v4u){pk2(kp[0], kp[1]), pk2(kp[2], kp[3]), pk2(kp[4], kp[5]), pk2(kp[6], kp[7])};
#pragma unroll
            for (int i = 0; i < 8; ++i) *(LAS bf16*)(L + OFF_K2T + (d8 + i) * LT + t * 2) = (bf16)f2bf(k2[i]);
        }
        __syncthreads();
        { const int I = wave >> 2, dvb = wave & 3;
            f32x16 od;
#pragma unroll
            for (int i = 0; i < 16; ++i) od[i] = 0.f;
            const LAS unsigned char* vrow = L + OFF_VT + (32 * dvb + r32) * LT;
            if (I == 0) {
                f32x16 x = xblock(L + OFF_KP, L + OFF_QH0, r32, hi);
#pragma unroll
                for (int i = 0; i < 16; ++i) x[i] = (crow(i, hi) <= r32) ? x[i] : 0.f;
                xtv(od, x, vrow, hi);
            } else {
                f32x16 x = xblock(L + OFF_KH, L + OFF_QH1, r32, hi);
                xtv(od, x, vrow, hi);
                x = xblock(L + OFF_KP + 32 * LQ, L + OFF_QH1, r32, hi);
#pragma unroll
                for (int i = 0; i < 16; ++i) x[i] = (crow(i, hi) <= r32) ? x[i] : 0.f;
                xtv(od, x, vrow + 64, hi);
            }
            float* op = OI + (row0 + 32 * I) * 1024 + h * 128 + 32 * dvb + r32;
#pragma unroll
            for (int i = 0; i < 16; ++i) op[(size_t)crow(i, hi) * 1024] = od[i];
#pragma unroll
            for (int e = 0; e < 2; ++e) { const int dvb2 = wave >> 1, dkb = 2 * (wave & 1) + e;
                f32x16 uacc;
#pragma unroll
                for (int i = 0; i < 16; ++i) uacc[i] = 0.f;
#pragma unroll
                for (int st = 0; st < 4; ++st) { const bf16x8 va = *(const LAS bf16x8*)(L + OFF_VT + (32 * dvb2 + r32) * LT + (16 * st + 8 * hi) * 2), kb = *(const LAS bf16x8*)(L + OFF_K2T + (32 * dkb + r32) * LT + (16 * st + 8 * hi) * 2);
                    uacc = __builtin_amdgcn_mfma_f32_32x32x16_bf16(va, kb, uacc, 0, 0, 0); }
                bf16* up = UT + (size_t)u * 16384 + (size_t)(32 * dvb2) * 128 + 32 * dkb + r32;
#pragma unroll
                for (int i = 0; i < 16; ++i) up[crow(i, hi) * 128] = (bf16)f2bf(uacc[i]);
            }
        }
        __syncthreads();
    }
}
__device__ __forceinline__ void phase_hgrn2(Frame& F, KA a, int l) {
    LAS unsigned char* L = F.lds; constexpr int LS = 272; LAS float* OB = (LAS float*)(L + 36864); LAS float* DECS = (LAS float*)(L + 69632); LAS unsigned char* QS = L + 70656;
    const bf16* proj = (const bf16*)(a->ws + WS_PROJ); bf16* mix = (bf16*)(a->ws + WS_MIX);
    const float* OI = (const float*)(a->ws + WS_HOI); const bf16* UT = (const bf16*)(a->ws + WS_HUT); const bf16* QH = (const bf16*)(a->ws + WS_HQH); const float* DEC = (const float*)(a->ws + WS_HDEC);
    const float* gn = a->in[12] + l * 128;
    const int tid = F.tid, lane = F.lane, r32 = lane & 31, hi = lane >> 5, wave = F.wave;
    const int dv = tid >> 2, dkq = tid & 3, I = wave >> 2, dvb = wave & 3, tn = tid >> 3, d16 = (tid & 7) * 16;
    for (int u = F.bid; u < BATCH * 8; u += F.G) {
        const int b = u >> 3, h = u & 7;
        float S[32];
#pragma unroll
        for (int i = 0; i < 32; ++i) S[i] = 0.f;
#pragma unroll
        for (int i = 0; i < 4; ++i) *(LAS v4u*)(L + dv * LS + (32 * dkq + 8 * i) * 2) = (v4u){0u, 0u, 0u, 0u};
        v4u qn0, qn1, g0, g1, uw[4]; f32x4 oi[4]; float dn = 0.f;
#define H2_ROWQ(c) (QH + ((size_t)b * T + 64 * (c) + tn) * 1024 + h * 128 + d16)
#define H2_LDQ(c) do { qn0 = *(const GAS v4u*)(H2_ROWQ(c)); qn1 = *(const GAS v4u*)(H2_ROWQ(c) + 8); if (tid < 128) dn = DEC[((size_t)u * 32 + (c)) * 128 + tid]; } while (0)
#define H2_STQ(c) do { *(LAS v4u*)(QS + ((c) & 1) * (64 * LS) + tn * LS + d16 * 2) = qn0; *(LAS v4u*)(QS + ((c) & 1) * (64 * LS) + tn * LS + d16 * 2 + 16) = qn1; if (tid < 128) DECS[((c) & 1) * 128 + tid] = dn; } while (0)
#define H2_LDN(c) do { const size_t row_ = (size_t)b * T + 64 * (c) + tn; \
            _Pragma("unroll") for (int i = 0; i < 4; ++i) oi[i] = *(const GAS f32x4*)(OI + row_ * 1024 + h * 128 + d16 + 4 * i); \
            g0 = *(const GAS v4u*)(proj + row_ * NPROJ_P + C_HG + h * 128 + d16); g1 = *(const GAS v4u*)(proj + row_ * NPROJ_P + C_HG + h * 128 + d16 + 8); } while (0)
#define H2_LDU(c) do { _Pragma("unroll") for (int i = 0; i < 4; ++i) uw[i] = *(const GAS v4u*)(UT + ((size_t)u * 32 + (c)) * 16384 + (size_t)dv * 128 + 32 * dkq + 8 * i); } while (0)
        H2_LDQ(0); H2_LDN(0); H2_LDU(0); H2_STQ(0);
#pragma unroll 1
        for (int c = 0; c < 32; ++c) {
            const size_t row0 = (size_t)b * T + 64 * c;
            if (c + 1 < 32) H2_LDQ(c + 1);
            __syncthreads();
            f32x16 acc;
#pragma unroll
            for (int i = 0; i < 16; ++i) acc[i] = 0.f;
            const LAS unsigned char* qs = QS + (c & 1) * (64 * LS) + (32 * I + r32) * LS + 16 * hi;
#pragma unroll
            for (int st = 0; st < 8; ++st) { const bf16x8 qa = *(const LAS bf16x8*)(qs + 32 * st), sb = *(const LAS bf16x8*)(L + (32 * dvb + r32) * LS + (16 * st + 8 * hi) * 2);
                acc = __builtin_amdgcn_mfma_f32_32x32x16_bf16(qa, sb, acc, 0, 0, 0); }
#pragma unroll
            for (int i = 0; i < 16; ++i) OB[(32 * I + hg::crow(i, hi)) * 128 + 32 * dvb + r32] = acc[i];
            __syncthreads();
            {
                const size_t row = row0 + tn; float ov[16]; float ss = 0.f;
#pragma unroll
                for (int i = 0; i < 4; ++i) { const f32x4 o4 = *(const LAS f32x4*)(OB + tn * 128 + d16 + 4 * i) + oi[i]; ov[4 * i] = o4.x; ov[4 * i + 1] = o4.y; ov[4 * i + 2] = o4.z; ov[4 * i + 3] = o4.w; ss += (o4.x * o4.x + o4.y * o4.y) + (o4.z * o4.z + o4.w * o4.w); }
                ss += swz<1>(ss); ss += swz<2>(ss); ss += swz<4>(ss);
                const float r = __builtin_amdgcn_rsqf(ss * (1.0f / 128.0f) + EPS);
                const float xg[16] = {blo(g0.x), bhi(g0.x), blo(g0.y), bhi(g0.y), blo(g0.z), bhi(g0.z), blo(g0.w), bhi(g0.w), blo(g1.x), bhi(g1.x), blo(g1.y), bhi(g1.y), blo(g1.z), bhi(g1.z), blo(g1.w), bhi(g1.w)};
                unsigned pw[8];
#pragma unroll
                for (int i = 0; i < 8; ++i) pw[i] = pk2(ov[2 * i] * r * gn[d16 + 2 * i] * siluf(xg[2 * i]), ov[2 * i + 1] * r * gn[d16 + 2 * i + 1] * siluf(xg[2 * i + 1]));
                *(GAS v4u*)(mix + row * 2048 + 1024 + h * 128 + d16) = (v4u){pw[0], pw[1], pw[2], pw[3]}; *(GAS v4u*)(mix + row * 2048 + 1024 + h * 128 + d16 + 8) = (v4u){pw[4], pw[5], pw[6], pw[7]};
            }
            if (c + 1 < 32) H2_LDN(c + 1);
            {
                const LAS float* dcs = DECS + (c & 1) * 128 + 32 * dkq;
#pragma unroll
                for (int i = 0; i < 4; ++i) { const unsigned ww[4] = {uw[i].x, uw[i].y, uw[i].z, uw[i].w};
                    const f32x4 d0 = *(const LAS f32x4*)(dcs + 8 * i), d1 = *(const LAS f32x4*)(dcs + 8 * i + 4); const float dcf[8] = {d0.x, d0.y, d0.z, d0.w, d1.x, d1.y, d1.z, d1.w};
#pragma unroll
                    for (int q = 0; q < 4; ++q) { S[8 * i + 2 * q] = dcf[2 * q] * S[8 * i + 2 * q] + blo(ww[q]); S[8 * i + 2 * q + 1] = dcf[2 * q + 1] * S[8 * i + 2 * q + 1] + bhi(ww[q]); }
                    *(LAS v4u*)(L + dv * LS + (32 * dkq + 8 * i) * 2) = (v4u){pk2(S[8 * i], S[8 * i + 1]), pk2(S[8 * i + 2], S[8 * i + 3]), pk2(S[8 * i + 4], S[8 * i + 5]), pk2(S[8 * i + 6], S[8 * i + 7])}; }
            }
            if (c + 1 < 32) { H2_LDU(c + 1); H2_STQ(c + 1); }
        }
#undef H2_ROWQ
#undef H2_LDQ
#undef H2_STQ
#undef H2_LDN
#undef H2_LDU
        __syncthreads();
    }
}

__device__ __forceinline__ void phase_norm_router(Frame& F, KA a, const float* src, bf16* dst) {
    LAS int* lcnt = (LAS int*)(F.lds); LAS int* lbase = (LAS int*)(F.lds + 64); LAS int* stash = (LAS int*)(F.lds + 128);
    float* rstd2 = (float*)(a->ws + WS_TAB + TAB_RSTD2); int* toke = (int*)(a->ws + WS_TAB + TAB_TOKE); int* tokpos = (int*)(a->ws + WS_TAB + TAB_TOKPOS); float* tokp = (float*)(a->ws + WS_TAB + TAB_TOKP);
    unsigned* gcnt = (unsigned*)(a->ws + WS_CTL) + CW_ECNT;
    const float* gain = a->in[3] + 2048; const float* wr = a->in[19];
    const int lane = F.lane;
    for (int chunk = F.bid; chunk < M / 64; chunk += F.G) {
        if (F.tid < 8) lcnt[F.tid] = 0;
        __syncthreads();
#pragma unroll 1
        for (int rr = 0; rr < 8; ++rr) {
            const int lrow = F.wave * 8 + rr; const size_t row = (size_t)chunk * 64 + lrow;
            const GAS f32x4* xr = (const GAS f32x4*)(src + row * D) + lane;
            f32x4 v[8]; float s = 0.f;
#pragma unroll
            for (int jj = 0; jj < 8; ++jj) { v[jj] = xr[64 * jj]; s += (v[jj].x * v[jj].x + v[jj].y * v[jj].y) + (v[jj].z * v[jj].z + v[jj].w * v[jj].w); }
            s = wave_sum(s); const float r = 1.0f / sqrtf(s * (1.0f / D) + EPS);
            GAS v2u* o8 = (GAS v2u*)(dst + row * D) + lane;
            float lg[8] = {0.f, 0.f, 0.f, 0.f, 0.f, 0.f, 0.f, 0.f};
#pragma unroll
            for (int jj = 0; jj < 8; ++jj) { v2u w; w.x = pk2(v[jj].x, v[jj].y); w.y = pk2(v[jj].z, v[jj].w); o8[64 * jj] = w;
                const int d0 = 4 * lane + 256 * jj; const f32x4 g4 = *(const GAS f32x4*)(gain + d0);
                const float xg[4] = {v[jj].x * g4.x, v[jj].y * g4.y, v[jj].z * g4.z, v[jj].w * g4.w};
#pragma unroll
                for (int q = 0; q < 4; ++q) { const f32x4 wa = *(const GAS f32x4*)(wr + (size_t)(d0 + q) * 8), wb = *(const GAS f32x4*)(wr + (size_t)(d0 + q) * 8 + 4);
                    lg[0] += xg[q] * wa.x; lg[1] += xg[q] * wa.y; lg[2] += xg[q] * wa.z; lg[3] += xg[q] * wa.w; lg[4] += xg[q] * wb.x; lg[5] += xg[q] * wb.y; lg[6] += xg[q] * wb.z; lg[7] += xg[q] * wb.w; } }
#pragma unroll
            for (int e = 0; e < 8; ++e) lg[e] = wave_sum(lg[e]) * r;
            int e0 = 0; float v0 = lg[0];
#pragma unroll
            for (int e = 1; e < 8; ++e) if (lg[e] > v0) { v0 = lg[e]; e0 = e; }
            int e1 = -1; float v1 = -INFINITY;
#pragma unroll
            for (int e = 0; e < 8; ++e) if (e != e0 && lg[e] > v1) { v1 = lg[e]; e1 = e; }
            const float p0 = 1.0f / (1.0f + __expf(v1 - v0)), p1 = 1.0f - p0;
            if (lane == 0) { rstd2[row] = r; const int lp0 = atomicAdd((int*)lcnt + e0, 1), lp1 = atomicAdd((int*)lcnt + e1, 1);
                stash[lrow * 4] = e0; stash[lrow * 4 + 1] = e1; stash[lrow * 4 + 2] = lp0; stash[lrow * 4 + 3] = lp1; tokp[row * 2] = p0; tokp[row * 2 + 1] = p1; }
        }
        __syncthreads();
        if (F.tid < 8) lbase[F.tid] = (int)__hip_atomic_fetch_add(gcnt + F.tid, (unsigned)lcnt[F.tid], __ATOMIC_RELAXED, __HIP_MEMORY_SCOPE_AGENT);
        __syncthreads();
        if (F.tid < 64) { const size_t row = (size_t)chunk * 64 + F.tid; const int e0 = stash[F.tid * 4], e1 = stash[F.tid * 4 + 1];
            toke[row * 2] = e0; toke[row * 2 + 1] = e1; tokpos[row * 2] = lbase[e0] + stash[F.tid * 4 + 2]; tokpos[row * 2 + 1] = lbase[e1] + stash[F.tid * 4 + 3]; }
        __syncthreads();
    }
}
struct ExpTab { int t[9]; };
__device__ __forceinline__ void load_exptab(KA a, int (&off)[9]) {
    const unsigned* gcnt = (const unsigned*)(a->ws + WS_CTL) + CW_ECNT;
    off[0] = 0;
#pragma unroll
    for (int e = 0; e < 8; ++e) { const unsigned c = __hip_atomic_load(gcnt + e, __ATOMIC_RELAXED, __HIP_MEMORY_SCOPE_AGENT); off[e + 1] = off[e] + (int)((c + 255u) >> 8); }
}
__device__ __forceinline__ void phase_gather(Frame& F, KA a) {
    int off[9]; load_exptab(a, off);
    const bf16* hb = (const bf16*)(a->ws + WS_HB); bf16* hs = (bf16*)(a->ws + WS_HSX);
    const float* rstd2 = (const float*)(a->ws + WS_TAB + TAB_RSTD2); float* rstds = (float*)(a->ws + WS_TAB + TAB_RSTDS);
    const int* toke = (const int*)(a->ws + WS_TAB + TAB_TOKE); const int* tokpos = (const int*)(a->ws + WS_TAB + TAB_TOKPOS); int* tokdest = (int*)(a->ws + WS_TAB + TAB_TOKDEST);
    const int gw = F.bid * NWAVES + F.wave, NGW = F.G * NWAVES;
    for (int pair = gw; pair < 2 * M; pair += NGW) {
        const int tok = pair >> 1; const int e = toke[pair], pos = tokpos[pair];
        int o = off[0];
#pragma unroll
        for (int q = 1; q < 8; ++q) o = (e == q) ? off[q] : o;
        const int dest = o * 256 + pos;
        const GAS v4u* s = (const GAS v4u*)(hb + (size_t)tok * D) + F.lane; GAS v2u* dd = (GAS v2u*)((unsigned char*)hs + (size_t)dest * D) + F.lane;
#pragma unroll
        for (int jj = 0; jj < 4; ++jj) { const v4u w = s[64 * jj]; unsigned w0 = 0u, w1 = 0u;
            w0 = __builtin_amdgcn_cvt_pk_fp8_f32(blo(w.x), bhi(w.x), w0, false); w0 = __builtin_amdgcn_cvt_pk_fp8_f32(blo(w.y), bhi(w.y), w0, true);
            w1 = __builtin_amdgcn_cvt_pk_fp8_f32(blo(w.z), bhi(w.z), w1, false); w1 = __builtin_amdgcn_cvt_pk_fp8_f32(blo(w.w), bhi(w.w), w1, true);
            dd[64 * jj] = (v2u){w0, w1}; }
        if (F.lane == 0) { rstds[dest] = rstd2[tok]; tokdest[pair] = dest; }
    }
}
__device__ __forceinline__ void phase_combine(Frame& F, KA a) {
    const float* y = (const float*)(a->ws + WS_Y); const int* tokdest = (const int*)(a->ws + WS_TAB + TAB_TOKDEST); const float* tokp = (const float*)(a->ws + WS_TAB + TAB_TOKP);
    const int gw = F.bid * NWAVES + F.wave, NGW = F.G * NWAVES;
    for (int row = gw; row < M; row += NGW) {
        const int d0 = tokdest[2 * row], d1 = tokdest[2 * row + 1]; const float p0 = tokp[2 * row], p1 = tokp[2 * row + 1];
        GAS f32x4* o = (GAS f32x4*)(a->out + (size_t)row * D) + F.lane; const GAS f32x4* y0 = (const GAS f32x4*)(y + (size_t)d0 * D) + F.lane; const GAS f32x4* y1 = (const GAS f32x4*)(y + (size_t)d1 * D) + F.lane;
#pragma unroll
        for (int jj = 0; jj < 8; ++jj) o[64 * jj] = o[64 * jj] + y0[64 * jj] * p0 + y1[64 * jj] * p1;
    }
}

#ifndef MK_ONE_LAUNCH
#define MK_ONE_LAUNCH 1
#endif
constexpr int PH_PER_LAYER = 16, NPHASE = 2 * PH_PER_LAYER;
constexpr int CONV_GG = 160;
__global__ void __launch_bounds__(NWAVES * 64, 2) mk_fwd(Args args) {
    extern __shared__ __attribute__((aligned(16))) unsigned char lds[];
    LAS unsigned char* const ldsb = (LAS unsigned char*)lds;
    const int wave_s = __builtin_amdgcn_readfirstlane(threadIdx.x >> 6);
    for (int u = threadIdx.x; u < (LDS_BYTES - LDSCTL_OFF) / 4; u += NWAVES * 64) ((LAS unsigned*)(ldsb + LDSCTL_OFF))[u] = 0u;
    __syncthreads();
    XcdBarrier bar; bar.bar = nullptr; bar.x = 0; bar.st = nullptr;
    if (MK_ONE_LAUNCH) { KA a = ka_get(); bar = xcd_barrier_post((unsigned*)(a->ws + WS_CTL) + CW_BAR, (volatile LAS unsigned*)(ldsb + MISC_OFF) + 8); }
    const int lo = args.ph_lo, hi = args.ph_hi;
#define IN(k) in_range((k), lo, hi)
#define SEAM(k) do { if (MK_ONE_LAUNCH && IN(k) && IN((k) + 1)) { XcdBarrier b2_ = bar; asm volatile("" : "+s"(b2_.bar)); xcd_barrier(b2_); } } while (0)
#pragma unroll 1
    for (int l = 0; l < 2; ++l) {
        const int pb = l * PH_PER_LAYER;
        if (IN(pb + 0)) { KA a = ka_get(); Frame F = make_frame(ldsb, wave_s); unsigned char* ws = a->ws; if (l == 0) phase_conv(F, a, 0, F.G == 256 ? 1 : 16, F.bid, F.G);
            phase_norm(F, (l == 0) ? a->in[0] : (const float*)(ws + WS_H), (bf16*)(ws + WS_XB), (float*)(ws + WS_RSTD1)); }
        SEAM(pb + 0);
        if (IN(pb + 1)) { KA a = ka_get(); Frame F = make_frame(ldsb, wave_s); unsigned char* ws = a->ws;
            const bool split = (l == 0 && F.G == 256);
            const int Gv = split ? CONV_GG : F.G;
            if (F.bid < Gv) {
                pg8::Gemm g{(const bf16*)(ws + WS_XB), (const bf16*)(ws + WS_WIN + l * WIN_SZ), M, NPROJ_P, D, D, F.tid, 0, 0}; pg8::StaticOrder S; S.init(M, F.G == 256 ? NPROJ_P - 256 : NPROJ_P, Gv, F.bid);
                pg8::EpiScaleBf16 E{(bf16*)(ws + WS_PROJ), NPROJ_P, (const float*)(ws + WS_RSTD1)};
                pg8::gemm_phase<pg8::EpiScaleBf16, pg8::StaticOrder, true, true>(F.lds + RING_OFF, g, S, E);
            } else phase_conv(F, a, 1, 16, F.bid - CONV_GG, F.G - CONV_GG);
        }
        SEAM(pb + 1);
        if (IN(pb + 2)) { KA a = ka_get(); Frame F = make_frame(ldsb, wave_s); phase_post(F, a, l); }
        SEAM(pb + 2);
        if (IN(pb + 3)) { KA a = ka_get(); Frame F = make_frame(ldsb, wave_s); unsigned char* ws = a->ws;
            pg8::Gemm g{(const bf16*)(ws + WS_PROJ) + C_CQ, (const bf16*)(ws + WS_WIDX + l * WIDX_SZ), M, 1024, 512, NPROJ_P, F.tid, 0, 0}; pg8::StaticOrder S; S.init(M, 1024, F.G, F.bid);
            pg8::EpiScaleBf16 E{(bf16*)(ws + WS_QIDX), 1024, (const float*)(ws + WS_RSTDCQ)};
            pg8::gemm_phase<pg8::EpiScaleBf16, pg8::StaticOrder, true, true>(F.lds + RING_OFF, g, S, E);
        }
        SEAM(pb + 3);
        if (IN(pb + 4)) { KA a = ka_get(); Frame F = make_frame(ldsb, wave_s); phase_index2(F, a); }
        SEAM(pb + 4);
        if (IN(pb + 5)) { KA a = ka_get(); Frame F = make_frame(ldsb, wave_s); phase_attn2(F, a); }
        SEAM(pb + 5);
        if (IN(pb + 6)) { KA a = ka_get(); Frame F = make_frame(ldsb, wave_s); phase_hgrn1(F, a, l); }
        SEAM(pb + 6);
        if (IN(pb + 7)) { KA a = ka_get(); Frame F = make_frame(ldsb, wave_s); unsigned char* ws = a->ws;
            const bool split = F.G >= 128;
            if (!split || F.bid < 64) phase_hgrn2(F, a, l);
            if (!split || F.bid >= 64) {
                pg8::Gemm g{(const bf16*)(ws + WS_MIX), (const bf16*)(ws + WS_WUA + l * WU_SZ), M, D, 1024, D, F.tid, 0, 0}; pg8::StaticOrder S; S.init(M, D, split ? F.G - 64 : F.G, split ? F.bid - 64 : F.bid);
                pg8::EpiGate<0> E{(float*)(ws + WS_TMP), nullptr, D, (const bf16*)(ws + WS_PROJ) + C_GA, NPROJ_P};
                pg8::gemm_phase<pg8::EpiGate<0>, pg8::StaticOrder, true, true>(F.lds + RING_OFF, g, S, E);
            }
            if (F.G == 256 && F.bid >= 192) {
                pg8::Gemm g{(const bf16*)(ws + WS_XB), (const bf16*)(ws + WS_WIN + l * WIN_SZ), M, NPROJ_P, D, D, F.tid, 0, 0}; pg8::OneUnit S{F.bid - 192, NPROJ_P / 256 - 1, true};
                pg8::EpiScaleBf16 E{(bf16*)(ws + WS_PROJ), NPROJ_P, (const float*)(ws + WS_RSTD1)};
                pg8::gemm_phase<pg8::EpiScaleBf16, pg8::OneUnit, true, true>(F.lds + RING_OFF, g, S, E);
            }
        }
        SEAM(pb + 7);
        if (IN(pb + 9)) { KA a = ka_get(); Frame F = make_frame(ldsb, wave_s); unsigned char* ws = a->ws;
            pg8::Gemm g{(const bf16*)(ws + WS_MIX) + 1024, (const bf16*)(ws + WS_WUH + l * WU_SZ), M, D, 1024, D, F.tid, 0, 0}; pg8::StaticOrder S; S.init(M, D, F.G, F.bid);
            pg8::EpiGate<1> E{(float*)(ws + WS_TMP), (bf16*)(ws + WS_MRG), D, (const bf16*)(ws + WS_PROJ) + C_GH, NPROJ_P};
            pg8::gemm_phase<pg8::EpiGate<1>, pg8::StaticOrder, true, true>(F.lds + RING_OFF, g, S, E);
        }
        SEAM(pb + 9);
        if (IN(pb + 10)) { KA a = ka_get(); Frame F = make_frame(ldsb, wave_s); unsigned char* ws = a->ws;
            pg8::Gemm g{(const bf16*)(ws + WS_MRG), (const bf16*)(ws + WS_WO + l * WO_SZ), M, D, D, D, F.tid, 0, 0}; pg8::StaticOrder S; S.init(M, D, F.G, F.bid);
            pg8::EpiResF32 E{(l == 0) ? a->in[0] : (const float*)(ws + WS_H), (l == 0) ? (float*)(ws + WS_H) : a->out, D, 1 << 20};
            pg8::gemm_phase<pg8::EpiResF32, pg8::StaticOrder, true, true>(F.lds + RING_OFF, g, S, E);
        }
        SEAM(pb + 10);
        if (IN(pb + 11)) { KA a = ka_get(); Frame F = make_frame(ldsb, wave_s); unsigned char* ws = a->ws;
            if (l == 0) phase_norm(F, (const float*)(ws + WS_H), (bf16*)(ws + WS_HB), (float*)(ws + WS_TAB + TAB_RSTD2)); else phase_norm_router(F, a, a->out, (bf16*)(ws + WS_HB)); }
        SEAM(pb + 11);
        if (l == 0) {
            if (IN(pb + 12)) { KA a = ka_get(); Frame F = make_frame(ldsb, wave_s); unsigned char* ws = a->ws;
                pg8::Gemm g{(const bf16*)(ws + WS_HB), (const bf16*)(ws + WS_W13D), M, 2 * FFD, D, D, F.tid, 0, 0}; pg8::StaticOrder S; S.init(M, 2 * FFD, F.G, F.bid);
                pg8::EpiSwiGLU E{(bf16*)(ws + WS_PROJ), FFD, 1 << 20, (const float*)(ws + WS_TAB + TAB_RSTD2)};
                pg8::gemm_phase<pg8::EpiSwiGLU, pg8::StaticOrder, true, true>(F.lds + RING_OFF, g, S, E);
            }
            SEAM(pb + 12);
            if (IN(pb + 13)) { KA a = ka_get(); Frame F = make_frame(ldsb, wave_s); unsigned char* ws = a->ws;
                pg8::Gemm g{(const bf16*)(ws + WS_PROJ), (const bf16*)(ws + WS_W2D), M, D, FFD, FFD, F.tid, 0, 0}; pg8::StaticOrder S; S.init(M, D, F.G, F.bid);
                pg8::EpiResF32 E{(const float*)(ws + WS_H), (float*)(ws + WS_H), D, 1 << 20};
                pg8::gemm_phase<pg8::EpiResF32, pg8::StaticOrder, true, true>(F.lds + RING_OFF, g, S, E);
            }
            SEAM(pb + 13);
        } else {
            if (IN(pb + 12)) { KA a = ka_get(); Frame F = make_frame(ldsb, wave_s); phase_gather(F, a); }
            SEAM(pb + 12);
            if (IN(pb + 13)) { KA a = ka_get(); Frame F = make_frame(ldsb, wave_s); unsigned char* ws = a->ws;
                int off[9]; load_exptab(a, off);
                pg8::Gemm g{(const bf16*)(ws + WS_HSX), (const bf16*)(ws + WS_W13M), MS, 2 * FFE, D / 2, D / 2, F.tid, 0x7f7f7f7f, 0x79797979};
                pg8::MoeOrder S{F.G, F.bid, 2 * FFE / 256, off[0], off[1], off[2], off[3], off[4], off[5], off[6], off[7], off[8]};
                pg8::EpiSwiGLUT<true> E{(bf16*)(ws + WS_ACTM), FFE, 2 * FFE / 256, (const float*)(ws + WS_TAB + TAB_RSTDS)};
                pg8::gemm_phase<pg8::EpiSwiGLUT<true>, pg8::MoeOrder, true, true, true>(F.lds + RING_OFF, g, S, E);
            }
            SEAM(pb + 13);
            if (IN(pb + 14)) { KA a = ka_get(); Frame F = make_frame(ldsb, wave_s); unsigned char* ws = a->ws;
                int off[9]; load_exptab(a, off);
                pg8::Gemm g{(const bf16*)(ws + WS_ACTM), (const bf16*)(ws + WS_W2M), MS, D, FFE / 2, FFE / 2, F.tid, 0x7c7c7c7c, 0x79797979};
                pg8::MoeOrder S{F.G, F.bid, D / 256, off[0], off[1], off[2], off[3], off[4], off[5], off[6], off[7], off[8]};
                pg8::EpiResF32 E{nullptr, (float*)(ws + WS_Y), D, D / 256};
                pg8::gemm_phase<pg8::EpiResF32, pg8::MoeOrder, true, true, true>(F.lds + RING_OFF, g, S, E);
            }
            SEAM(pb + 14);
            if (IN(pb + 15)) { KA a = ka_get(); Frame F = make_frame(ldsb, wave_s); phase_combine(F, a); }
        }
    }
#undef IN
#undef SEAM
}

extern "C" void kernel_launch(void* const* d_in, const int* in_sizes, int n_in, void* d_out, int out_size, void* d_ws, size_t ws_size, hipStream_t stream) {
    static int grid = 0;
    if (grid == 0) {
        if (n_in != 23 || out_size != M * D || ws_size < WS_END) { fprintf(stderr, "kernel_launch: unexpected shapes (n_in %d out %d ws %zu need %zu)\n", n_in, out_size, ws_size, (size_t)WS_END); grid = -1; return; }
        int dev = 0, cus = 0, per_cu = 0;
        if (hipGetDevice(&dev) != hipSuccess || hipDeviceGetAttribute(&cus, hipDeviceAttributeMultiprocessorCount, dev) != hipSuccess) { grid = -1; return; }
        if (hipFuncSetAttribute((const void*)mk_fwd, hipFuncAttributeMaxDynamicSharedMemorySize, LDS_BYTES) != hipSuccess) { fprintf(stderr, "kernel_launch: hipFuncSetAttribute failed\n"); grid = -1; return; }
        if (hipOccupancyMaxActiveBlocksPerMultiprocessor(&per_cu, (const void*)mk_fwd, NWAVES * 64, LDS_BYTES) != hipSuccess || per_cu < 1) fprintf(stderr, "kernel_launch: occupancy query says %d\n", per_cu);
        (void)hipGetLastError();
        grid = cus;
    }
    if (grid < 0) return;
    (void)hipMemsetAsync((char*)d_ws + WS_CTL, 0, CTL_ZERO_BYTES, stream);
    Args a{};
    for (int i = 0; i < 23; ++i) a.in[i] = (const float*)d_in[i];
    a.out = (float*)d_out; a.ws = (unsigned char*)d_ws;
#if MK_ONE_LAUNCH
    a.ph_lo = 0; a.ph_hi = NPHASE;
    hipLaunchKernelGGL(mk_fwd, dim3(grid), dim3(NWAVES * 64), LDS_BYTES, stream, a);
#else
    for (int p = 0; p < NPHASE; ++p) {
        if (p == 14 || p == 15) continue;
        a.ph_lo = p; a.ph_hi = p + 1;
        hipLaunchKernelGGL(mk_fwd, dim3(grid), dim3(NWAVES * 64), LDS_BYTES, stream, a);
    }
#endif
}
```

```cpp
#include <hip/hip_runtime.h>
#include <cstdio>
#include <cstdint>
namespace pg8 {
#define PG8_LAS __attribute__((address_space(3)))
typedef unsigned short bf16_t;
typedef short bf16x8 __attribute__((ext_vector_type(8)));
typedef float f32x4 __attribute__((ext_vector_type(4)));
typedef unsigned u32x4 __attribute__((ext_vector_type(4)));
typedef int i32x8 __attribute__((ext_vector_type(8)));
constexpr int BM = 256, BK = 64, HALF = 128, HTB = HALF * BK * 2  , STAGE_BYTES = 8 * HTB, NXCD = 8, WGM = 8;

__host__ __device__ __forceinline__ int lds_byte(int r, int c) { const int st = (r >> 4) * 2 + (c >> 5), rr = r & 15, cc = c & 31, ob = rr * 64 + cc * 2; return st * 1024 + (ob ^ (((ob >> 9) & 1) << 5)); }
__host__ __device__ __forceinline__ void stage_rc(int b, int& R, int& C) { const int st = b / 1024, sb = b % 1024, swz = sb ^ (((sb >> 9) & 1) << 5); R = (st >> 1) * 16 + swz / 64; C = (st & 1) * 32 + (swz % 64) / 2; }
__host__ __device__ __forceinline__ int perm32(int rho) { const int n = rho >> 4, i = rho & 15; return 8 * (i >> 2) + 4 * n + (i & 3); }

struct Unit { int pm, pn; };
struct Gemm { const bf16_t* A; const bf16_t* Bt; int M, N, K, lda, tid; int scaleA, scaleB; };

struct StaticOrder {
    int nM, nN, nwg, G, c;
    __host__ __device__ void init(int M, int N, int G_, int c_) { nM = M / BM; nN = N / BM; nwg = nM * nN; G = G_; c = c_; }
    __host__ __device__ bool next(int i, Unit& u) const {
        const long L = (long)i * G + c; if (L >= nwg) return false;
        int wgid = (int)L; { const int q = nwg / NXCD, r = nwg % NXCD, xcd = wgid % NXCD, off = wgid / NXCD; wgid = (xcd < r ? xcd * (q + 1) : r * (q + 1) + (xcd - r) * q) + off; }
        const int nig = WGM * nN, gid = wgid / nig, fm = gid * WGM, gsz = (nM - fm) < WGM ? (nM - fm) : WGM;
        u.pm = fm + ((wgid % nig) % gsz); u.pn = (wgid % nig) / gsz; return true;
    }
    __device__ __forceinline__ void a_ready(const Unit&) const {}
    __device__ __forceinline__ void done(const Unit&) const {}
};

__device__ __forceinline__ unsigned cvt_pk_bf16(float lo, float hi) { unsigned r; asm volatile("v_cvt_pk_bf16_f32 %0, %1, %2" : "=v"(r) : "v"(lo), "v"(hi)); return r; }
__device__ __forceinline__ float bflo(unsigned w) { return __builtin_bit_cast(float, w << 16); }
__device__ __forceinline__ float bfhi(unsigned w) { return __builtin_bit_cast(float, w & 0xffff0000u); }
__device__ __forceinline__ float sigm(float x) { return __builtin_amdgcn_rcpf(1.0f + __builtin_amdgcn_exp2f(-1.4426950408889634f * x)); }
__device__ __forceinline__ float silu(float x) { return x * __builtin_amdgcn_rcpf(1.0f + __builtin_amdgcn_exp2f(-1.4426950408889634f * x)); }

struct EpiScaleBf16 {
    static constexpr bool PERM = true, AFTER_DRAIN = false;
    bf16_t* O; int ldc; const float* rs;
    __device__ __forceinline__ void operator()(const f32x4 (&acc)[2][2][4][2], const Unit& u, int wr, int wc, int fr, int fq) const {
        const int row0 = u.pm * BM + wr * 64 + fr, col0 = u.pn * BM + wc * 32 + 8 * fq;
#pragma unroll
        for (int ai = 0; ai < 2; ++ai)
#pragma unroll
            for (int m = 0; m < 4; ++m) { const int row = row0 + ai * HALF + m * 16; const float s = rs[row]; bf16_t* rowp = O + (size_t)row * ldc + col0;
#pragma unroll
                for (int bj = 0; bj < 2; ++bj) { const f32x4 v0 = acc[ai][bj][m][0] * s, v1 = acc[ai][bj][m][1] * s;
                    u32x4 w; w.x = cvt_pk_bf16(v0[0], v0[1]); w.y = cvt_pk_bf16(v0[2], v0[3]); w.z = cvt_pk_bf16(v1[0], v1[1]); w.w = cvt_pk_bf16(v1[2], v1[3]);
                    *(u32x4*)(rowp + bj * HALF) = w; } }
    }
};
template <int MODE> struct EpiGate {
    static constexpr bool PERM = true, AFTER_DRAIN = false;
    float* C; bf16_t* O; int ldc; const bf16_t* G; int ldg;
    __device__ __forceinline__ void operator()(const f32x4 (&acc)[2][2][4][2], const Unit& u, int wr, int wc, int fr, int fq) const {
        const int row0 = u.pm * BM + wr * 64 + fr, col0 = u.pn * BM + wc * 32 + 8 * fq;
#pragma unroll
        for (int ai = 0; ai < 2; ++ai)
#pragma unroll
            for (int m = 0; m < 4; ++m) { const int row = row0 + ai * HALF + m * 16;
#pragma unroll
                for (int bj = 0; bj < 2; ++bj) { const int col = col0 + bj * HALF;
                    const u32x4 gw = *(const u32x4*)(G + (size_t)row * ldg + col);
                    f32x4 g0, g1; g0[0] = sigm(bflo(gw.x)); g0[1] = sigm(bfhi(gw.x)); g0[2] = sigm(bflo(gw.y)); g0[3] = sigm(bfhi(gw.y));
                    g1[0] = sigm(bflo(gw.z)); g1[1] = sigm(bfhi(gw.z)); g1[2] = sigm(bflo(gw.w)); g1[3] = sigm(bfhi(gw.w));
                    float* cp = C + (size_t)row * ldc + col;
                    if (MODE == 0) { *(f32x4*)cp = acc[ai][bj][m][0] * g0; *(f32x4*)(cp + 4) = acc[ai][bj][m][1] * g1; }
                    else { const f32x4 v0 = *(const f32x4*)cp + acc[ai][bj][m][0] * g0, v1 = *(const f32x4*)(cp + 4) + acc[ai][bj][m][1] * g1;
                        u32x4 w; w.x = cvt_pk_bf16(v0[0], v0[1]); w.y = cvt_pk_bf16(v0[2], v0[3]); w.z = cvt_pk_bf16(v1[0], v1[1]); w.w = cvt_pk_bf16(v1[2], v1[3]);
                        *(u32x4*)(O + (size_t)row * ldc + col) = w; } } }
    }
};
struct EpiResF32 {
    static constexpr bool PERM = true, AFTER_DRAIN = false;
    const float* res; float* out; int ldc, npn;
    __device__ __forceinline__ void operator()(const f32x4 (&acc)[2][2][4][2], const Unit& u, int wr, int wc, int fr, int fq) const {
        const int row0 = u.pm * BM + wr * 64 + fr, col0 = (u.pn % npn) * BM + wc * 32 + 8 * fq;
#pragma unroll
        for (int ai = 0; ai < 2; ++ai)
#pragma unroll
            for (int m = 0; m < 4; ++m) { const size_t off = (size_t)(row0 + ai * HALF + m * 16) * ldc + col0;
#pragma unroll
                for (int bj = 0; bj < 2; ++bj) { f32x4 v0 = acc[ai][bj][m][0], v1 = acc[ai][bj][m][1];
                    if (res) { v0 += *(const f32x4*)(res + off + bj * HALF); v1 += *(const f32x4*)(res + off + bj * HALF + 4); }
                    *(f32x4*)(out + off + bj * HALF) = v0; *(f32x4*)(out + off + bj * HALF + 4) = v1; } }
    }
};
template <bool F8OUT> struct EpiSwiGLUT {
    static constexpr bool PERM = true, AFTER_DRAIN = false;
    bf16_t* O; int ldc, npn; const float* rs;
    __device__ __forceinline__ void operator()(const f32x4 (&acc)[2][2][4][2], const Unit& u, int wr, int wc, int fr, int fq) const {
        const int row0 = u.pm * BM + wr * 64 + fr, col0 = (u.pn % npn) * HALF + wc * 32 + 8 * fq;
#pragma unroll
        for (int ai = 0; ai < 2; ++ai)
#pragma unroll
            for (int m = 0; m < 4; ++m) { const int row = row0 + ai * HALF + m * 16; const float r = rs[row];
                float o[8];
#pragma unroll
                for (int n = 0; n < 2; ++n)
#pragma unroll
                    for (int j = 0; j < 4; ++j) { const float a1 = acc[ai][0][m][n][j] * r, a3 = acc[ai][1][m][n][j] * r; o[4 * n + j] = silu(a1) * a3; }
                if constexpr (F8OUT) {
                    unsigned w0 = 0u, w1 = 0u;
#pragma unroll
                    for (int j = 0; j < 8; ++j) o[j] = __builtin_amdgcn_fmed3f(o[j] * 8.0f, -440.f, 440.f);
                    w0 = __builtin_amdgcn_cvt_pk_fp8_f32(o[0], o[1], w0, false); w0 = __builtin_amdgcn_cvt_pk_fp8_f32(o[2], o[3], w0, true);
                    w1 = __builtin_amdgcn_cvt_pk_fp8_f32(o[4], o[5], w1, false); w1 = __builtin_amdgcn_cvt_pk_fp8_f32(o[6], o[7], w1, true);
                    typedef unsigned u32x2_ __attribute__((ext_vector_type(2)));
                    *(u32x2_*)((unsigned char*)O + (size_t)row * ldc + col0) = (u32x2_){w0, w1};
                } else {
                u32x4 w; w.x = cvt_pk_bf16(o[0], o[1]); w.y = cvt_pk_bf16(o[2], o[3]); w.z = cvt_pk_bf16(o[4], o[5]); w.w = cvt_pk_bf16(o[6], o[7]);
                *(u32x4*)(O + (size_t)row * ldc + col0) = w; } }
    }
};
typedef EpiSwiGLUT<false> EpiSwiGLU;
struct OneUnit { int pm, pn; bool has;
    __device__ __forceinline__ bool next(int i, Unit& u) const { if (i > 0 || !has) return false; u.pm = pm; u.pn = pn; return true; }
    __device__ __forceinline__ void a_ready(const Unit&) const {}
    __device__ __forceinline__ void done(const Unit&) const {}
};
struct MoeOrder {
    int G, c, nN; int t0, t1, t2, t3, t4, t5, t6, t7, t8;
    __device__ __forceinline__ bool next(int i, Unit& u) const {
        const long L = (long)i * G + c; if (L >= (long)t8 * nN) return false;
        int ts = t0, te = t1;
        if (L >= (long)t1 * nN) { ts = t1; te = t2; } if (L >= (long)t2 * nN) { ts = t2; te = t3; } if (L >= (long)t3 * nN) { ts = t3; te = t4; } if (L >= (long)t4 * nN) { ts = t4; te = t5; }
        if (L >= (long)t5 * nN) { ts = t5; te = t6; } if (L >= (long)t6 * nN) { ts = t6; te = t7; } if (L >= (long)t7 * nN) { ts = t7; te = t8; }
        int e = 0; e += (L >= (long)t1 * nN); e += (L >= (long)t2 * nN); e += (L >= (long)t3 * nN); e += (L >= (long)t4 * nN); e += (L >= (long)t5 * nN); e += (L >= (long)t6 * nN); e += (L >= (long)t7 * nN);
        const int Ll = (int)(L - (long)ts * nN), Te = te - ts;
        u.pm = ts + Ll % Te; u.pn = e * nN + Ll / Te; return true;
    }
    __device__ __forceinline__ void a_ready(const Unit&) const {}
    __device__ __forceinline__ void done(const Unit&) const {}
};
template <bool FP8> struct FragT;
template <> struct FragT<false> { bf16x8 k[2]; };
template <> struct FragT<true>  { i32x8 v; };
__device__ __forceinline__ void ld_frag(FragT<false>& f, const PG8_LAS unsigned char* p, int o0, int o1) { f.k[0] = *(const PG8_LAS bf16x8*)(p + o0); f.k[1] = *(const PG8_LAS bf16x8*)(p + o1); }
__device__ __forceinline__ void ld_frag(FragT<true>& f, const PG8_LAS unsigned char* p, int o0, int o1) { const u32x4 a = *(const PG8_LAS u32x4*)(p + o0), b = *(const PG8_LAS u32x4*)(p + o1);
    f.v = (i32x8){(int)a.x, (int)a.y, (int)a.z, (int)a.w, (int)b.x, (int)b.y, (int)b.z, (int)b.w}; }
__device__ __forceinline__ f32x4 mma_frag(const FragT<false>& b, const FragT<false>& a, f32x4 c, int, int) { c = __builtin_amdgcn_mfma_f32_16x16x32_bf16(b.k[0], a.k[0], c, 0, 0, 0); return __builtin_amdgcn_mfma_f32_16x16x32_bf16(b.k[1], a.k[1], c, 0, 0, 0); }
__device__ __forceinline__ f32x4 mma_frag(const FragT<true>& b, const FragT<true>& a, f32x4 c, int sb, int sa) {
    asm volatile("v_mfma_scale_f32_16x16x128_f8f6f4 %0, %1, %2, %0, %3, %4 op_sel_hi:[0,0,0]" : "+v"(c) : "v"(b.v), "v"(a.v), "v"(sb), "v"(sa)); return c; }
template <class Epi, class Sched, bool ALIGN_EPI = false, bool SP2 = false, bool FP8 = false>
__device__ __forceinline__ void gemm_phase(PG8_LAS unsigned char* lds, const Gemm g, const Sched& S, const Epi& E) {
    const int tid = g.tid, wid = __builtin_amdgcn_readfirstlane(tid >> 6), lane = tid & 63, wr = wid >> 2, wc = wid & 3, fr = lane & 15, fq = lane >> 4;
    const int K = g.K, nt = K / BK;
    unsigned voffA[2], voffB[2];
#pragma unroll
    for (int i = 0; i < 2; ++i) { int R, C; stage_rc(tid * 16 + i * 8192, R, C); const int Rb = Epi::PERM ? ((R & ~31) + perm32(R & 31)) : R;
        voffA[i] = (unsigned)(R * g.lda + C) * 2u; voffB[i] = (unsigned)(Rb * K + C) * 2u; }
    const size_t kstep = (size_t)(BK * 2);
    const size_t hstepB = (size_t)HALF * K * 2, hstepA = (size_t)HALF * g.lda * 2;
    const size_t tstepA = 2 * hstepA, tstepB = 2 * hstepB;
    const unsigned ldsw = (unsigned)wid * 1024u;
    const int aoff = FP8 ? lds_byte(wr * 64 + fr, fq * 16) : lds_byte(wr * 64 + fr, fq * 8), boff = FP8 ? lds_byte(wc * 32 + fr, fq * 16) : lds_byte(wc * 32 + fr, fq * 8);
    const int aoff1 = FP8 ? aoff + 16 : aoff + 1024, boff1 = FP8 ? boff + 16 : boff + 1024;
    int scA = g.scaleA, scB = g.scaleB; asm volatile("" : "+v"(scA), "+v"(scB));
#define PG8_SA(b, h) (((b) * 2 + (h)) * HTB)
#define PG8_SB(b, h) ((4 + (b) * 2 + (h)) * HTB)
#define PG8_STAGE(bufoff, gbase, voff) do { _Pragma("unroll") for (int _i = 0; _i < 2; ++_i) \
        __builtin_amdgcn_global_load_lds((const unsigned*)((const char*)(gbase) + (voff)[_i]), (PG8_LAS unsigned*)(lds + (bufoff) + ldsw + _i * 8192), 16, 0, 0); } while (0)
#define PG8_LDA(dst, b, h) do { _Pragma("unroll") for (int m = 0; m < 4; ++m) ld_frag(dst[m], lds + PG8_SA(b, h) + m * 2048, aoff, aoff1); } while (0)
#define PG8_LDB(dst, b, h) do { _Pragma("unroll") for (int n = 0; n < 2; ++n) ld_frag(dst[n], lds + PG8_SB(b, h) + n * 2048, boff, boff1); } while (0)
#define PG8_MMA(ai, bj, At, Bt) do { __builtin_amdgcn_s_setprio(1); _Pragma("unroll") for (int m = 0; m < 4; ++m) _Pragma("unroll") for (int n = 0; n < 2; ++n) \
        acc[ai][bj][m][n] = mma_frag(Bt[n], At[m], acc[ai][bj][m][n], scB, scA); __builtin_amdgcn_s_setprio(0); } while (0)
#define PG8_WAIT_V(n) asm volatile("s_waitcnt vmcnt(" #n ")" ::: "memory")
#define PG8_WAIT_L(n) asm volatile("s_waitcnt lgkmcnt(" #n ")" ::: "memory")
#define PG8_BAR __builtin_amdgcn_s_barrier()
#define PG8_SCHED __builtin_amdgcn_sched_barrier(0)
    Unit cur, nxt; int ui = 0;
    if (!S.next(0, cur)) return;
    f32x4 acc[2][2][4][2];
#pragma unroll
    for (int a = 0; a < 2; ++a)
#pragma unroll
        for (int b = 0; b < 2; ++b)
#pragma unroll
            for (int m = 0; m < 4; ++m)
#pragma unroll
                for (int n = 0; n < 2; ++n) acc[a][b][m][n] = (f32x4){0.f, 0.f, 0.f, 0.f};
    FragT<FP8> At[4], B0[2], B1[2];
    const char* cA = (const char*)g.A + (size_t)cur.pm * tstepA; const char* cB = (const char*)g.Bt + (size_t)cur.pn * tstepB;
    S.a_ready(cur);
    if constexpr (SP2) {
        PG8_STAGE(PG8_SB(0, 0), cB, voffB); PG8_STAGE(PG8_SB(0, 1), cB + hstepB, voffB); PG8_STAGE(PG8_SA(0, 0), cA, voffA); PG8_STAGE(PG8_SA(0, 1), cA + hstepA, voffA);
        if (wr == 1) PG8_BAR;
        PG8_WAIT_V(2); PG8_BAR;
        PG8_STAGE(PG8_SB(1, 0), cB + kstep, voffB); PG8_STAGE(PG8_SA(1, 0), cA + kstep, voffA); PG8_STAGE(PG8_SB(1, 1), cB + hstepB + kstep, voffB);
        PG8_WAIT_V(6); PG8_BAR;
    } else {
        PG8_STAGE(PG8_SB(0, 0), cB, voffB); PG8_STAGE(PG8_SA(0, 0), cA, voffA); PG8_STAGE(PG8_SB(0, 1), cB + hstepB, voffB); PG8_STAGE(PG8_SA(0, 1), cA + hstepA, voffA);
        if (wr == 1) PG8_BAR;
        PG8_WAIT_V(4); PG8_BAR;
        PG8_STAGE(PG8_SB(1, 0), cB + kstep, voffB); PG8_STAGE(PG8_SA(1, 0), cA + kstep, voffA); PG8_STAGE(PG8_SB(1, 1), cB + hstepB + kstep, voffB);
        PG8_WAIT_V(6); PG8_BAR;
    }
    for (;;) {
        const bool has_next = S.next(ui + 1, nxt);
        const char* nA = has_next ? (const char*)g.A + (size_t)nxt.pm * tstepA : cA; const char* nB = has_next ? (const char*)g.Bt + (size_t)nxt.pn * tstepB : cB;
        for (int t = 0; t < nt; t += 2) {
            const bool last = (t == nt - 2);
            const char* a1 = cA + (size_t)(t + 1) * kstep;
            const char* a2 = last ? nA : cA + (size_t)(t + 2) * kstep; const char* b2 = last ? nB : cB + (size_t)(t + 2) * kstep;
            const char* a3 = a2 + kstep; const char* b3 = b2 + kstep;
            if (last && has_next) S.a_ready(nxt);
            if constexpr (SP2) {
            PG8_LDB(B0, 0, 0); PG8_LDB(B1, 0, 1); PG8_SCHED; PG8_LDA(At, 0, 0); PG8_STAGE(PG8_SA(1, 1), a1 + hstepA, voffA);
            PG8_WAIT_V(8); PG8_WAIT_L(0); PG8_BAR; PG8_MMA(0, 0, At, B0); PG8_MMA(0, 1, At, B1); PG8_BAR; PG8_SCHED;
            PG8_LDA(At, 0, 1); PG8_STAGE(PG8_SB(0, 0), b2, voffB); PG8_STAGE(PG8_SB(0, 1), b2 + hstepB, voffB); PG8_STAGE(PG8_SA(0, 0), a2, voffA);
            PG8_WAIT_V(8); PG8_WAIT_L(0); PG8_BAR; PG8_MMA(1, 0, At, B0); PG8_MMA(1, 1, At, B1); PG8_BAR; PG8_SCHED;
            PG8_LDB(B0, 1, 0); PG8_LDB(B1, 1, 1); PG8_SCHED; PG8_LDA(At, 1, 0); PG8_STAGE(PG8_SA(0, 1), a2 + hstepA, voffA);
            PG8_WAIT_V(8); PG8_WAIT_L(0); PG8_BAR; PG8_MMA(0, 0, At, B0); PG8_MMA(0, 1, At, B1); PG8_BAR; PG8_SCHED;
            PG8_LDA(At, 1, 1); PG8_STAGE(PG8_SB(1, 0), b3, voffB); PG8_STAGE(PG8_SB(1, 1), b3 + hstepB, voffB); PG8_STAGE(PG8_SA(1, 0), a3, voffA);
            PG8_WAIT_V(8); PG8_WAIT_L(0); PG8_BAR; PG8_MMA(1, 0, At, B0); PG8_MMA(1, 1, At, B1); PG8_BAR; PG8_SCHED;
            } else {
            PG8_LDB(B0, 0, 0); PG8_SCHED; PG8_LDA(At, 0, 0); PG8_STAGE(PG8_SA(1, 1), a1 + hstepA, voffA);
            PG8_WAIT_L(8); PG8_BAR; PG8_WAIT_L(0); PG8_MMA(0, 0, At, B0); PG8_BAR; PG8_SCHED;
            PG8_LDB(B1, 0, 1); PG8_STAGE(PG8_SB(0, 0), b2, voffB);
            PG8_BAR; PG8_WAIT_L(0); PG8_MMA(0, 1, At, B1); PG8_BAR;
            PG8_LDA(At, 0, 1); PG8_STAGE(PG8_SA(0, 0), a2, voffA);
            PG8_BAR; PG8_WAIT_L(0); PG8_MMA(1, 0, At, B0); PG8_BAR; PG8_SCHED;
            PG8_STAGE(PG8_SB(0, 1), b2 + hstepB, voffB);
            PG8_WAIT_V(6); PG8_BAR; PG8_MMA(1, 1, At, B1); PG8_BAR;
            PG8_LDB(B0, 1, 0); PG8_SCHED; PG8_LDA(At, 1, 0); PG8_STAGE(PG8_SA(0, 1), a2 + hstepA, voffA);
            PG8_WAIT_L(8); PG8_BAR; PG8_WAIT_L(0); PG8_MMA(0, 0, At, B0); PG8_BAR; PG8_SCHED;
            PG8_LDB(B1, 1, 1); PG8_STAGE(PG8_SB(1, 0), b3, voffB);
            PG8_BAR; PG8_WAIT_L(0); PG8_MMA(0, 1, At, B1); PG8_BAR;
            PG8_LDA(At, 1, 1); PG8_STAGE(PG8_SA(1, 0), a3, voffA);
            PG8_BAR; PG8_WAIT_L(0); PG8_MMA(1, 0, At, B0); PG8_BAR; PG8_SCHED;
            PG8_STAGE(PG8_SB(1, 1), b3 + hstepB, voffB);
            PG8_WAIT_V(6); PG8_BAR; PG8_MMA(1, 1, At, B1); PG8_BAR;
            }
        }
        if constexpr (FP8) asm volatile("s_nop 15\n\ts_nop 15" : "+v"(acc[1][1][0][0]), "+v"(acc[1][1][0][1]), "+v"(acc[1][1][1][0]), "+v"(acc[1][1][1][1]), "+v"(acc[1][1][2][0]), "+v"(acc[1][1][2][1]), "+v"(acc[1][1][3][0]), "+v"(acc[1][1][3][1]) :: "memory");
        if constexpr (ALIGN_EPI) { if (wr == 0) PG8_BAR; }
        if constexpr (!Epi::AFTER_DRAIN) { E(acc, cur, wr, wc, fr, fq); S.done(cur); }
        if (!has_next) break;
#pragma unroll
        for (int a = 0; a < 2; ++a)
#pragma unroll
            for (int b = 0; b < 2; ++b)
#pragma unroll
                for (int m = 0; m < 4; ++m)
#pragma unroll
                    for (int n = 0; n < 2; ++n) acc[a][b][m][n] = (f32x4){0.f, 0.f, 0.f, 0.f};
        cur = nxt; cA = nA; cB = nB; ++ui;
        if constexpr (ALIGN_EPI) { if (wr == 1) PG8_BAR; }
    }
    PG8_WAIT_V(0);
    if constexpr (!ALIGN_EPI) { if (wr == 0) PG8_BAR; }
    PG8_BAR;
    if constexpr (Epi::AFTER_DRAIN) { E.fused(acc, cur, wr, wc, fr, fq, lds, wid, lane); S.done(cur); }
#undef PG8_SA
#undef PG8_SB
#undef PG8_STAGE
#undef PG8_LDA
#undef PG8_LDB
#undef PG8_MMA
#undef PG8_WAIT_V
#undef PG8_WAIT_L
#undef PG8_BAR
#undef PG8_SCHED
}
}

#define GAS __attribute__((address_space(1)))
#define LAS __attribute__((address_space(3)))
typedef unsigned short bf16;
typedef unsigned v4u __attribute__((ext_vector_type(4)));
typedef float f32x4 __attribute__((ext_vector_type(4)));
typedef short bf16x8 __attribute__((ext_vector_type(8)));
typedef GAS unsigned gu32;
typedef GAS unsigned long long gu64;
#define RLX_AGENT __ATOMIC_RELAXED, __HIP_MEMORY_SCOPE_AGENT
#define LDS_WAIT() asm volatile("s_waitcnt lgkmcnt(0)" ::: "memory")
#define VM_WAIT() asm volatile("s_waitcnt vmcnt(0)" ::: "memory")
__device__ __forceinline__ unsigned long long rt() { return __builtin_amdgcn_s_memrealtime(); }
__device__ __forceinline__ unsigned f2bf(float f) { unsigned u = __builtin_bit_cast(unsigned, f); return (u + 0x7fffu + ((u >> 16) & 1u)) >> 16; }
__device__ __forceinline__ unsigned pk2(float lo, float hi) { unsigned r; asm volatile("v_cvt_pk_bf16_f32 %0, %1, %2" : "=v"(r) : "v"(lo), "v"(hi)); return r; }

#define XB_TMO      128
#define XB_XCNT(j)  (256  + 64 * (j))
#define XB_XSUB(j)  (1280 + 64 * (j))
#define XB_XGEN(j)  (2304 + 64 * (j))
#define XB_TOP      3328
#define XB_TOPGEN   3392
#define XCD_BAR_WORDS 3456
#define XB_SPIN_CAP (1u << 18)

__device__ __forceinline__ unsigned xb_ld(unsigned* p)              { return __hip_atomic_load(p, __ATOMIC_RELAXED, __HIP_MEMORY_SCOPE_AGENT); }
__device__ __forceinline__ unsigned xb_add(unsigned* p, unsigned v) { return __hip_atomic_fetch_add(p, v, __ATOMIC_RELAXED, __HIP_MEMORY_SCOPE_AGENT); }
__device__ __forceinline__ unsigned xb_xcc_id() { return (unsigned)__builtin_amdgcn_s_getreg((3 << 11) | 20) & 0xFu; }
#define XB_SPIN(cond, bar) do { unsigned _sp = 0; while (cond) { __builtin_amdgcn_s_sleep(1); \
    if ((++_sp & 255u) == 0u) { if (xb_ld(&(bar)[XB_TMO])) break; if (_sp > XB_SPIN_CAP) { atomicAdd(&(bar)[XB_TMO], 1u); break; } } } } while (0)

struct XcdBarrier {
    unsigned* bar; unsigned x;
    volatile LAS unsigned* st;
};

__device__ __forceinline__ XcdBarrier xcd_barrier_post(unsigned* bar, volatile LAS unsigned* st) {
    XcdBarrier b; b.bar = bar; b.x = xb_xcc_id(); b.st = st;
    if (threadIdx.x == 0) (void)xb_add(&bar[XB_XCNT(b.x)], 1u);
    return b;
}
__device__ __forceinline__ void xcd_barrier_complete(unsigned* bar, unsigned x, unsigned& nloc, unsigned& nx) {
    const unsigned G = gridDim.x * gridDim.y * gridDim.z;
    unsigned sum, cnt, mine, sp = 0u;
    for (;;) {
        sum = 0u; cnt = 0u; mine = 0u;
#pragma unroll
        for (unsigned j = 0; j < 16; ++j) { const unsigned c = xb_ld(&bar[XB_XCNT(j)]); sum += c; cnt += (c > 0u) ? 1u : 0u; mine = (j == x) ? c : mine; }
        if (sum == G) break;
        __builtin_amdgcn_s_sleep(1);
        if ((++sp & 255u) == 0u) { if (xb_ld(&bar[XB_TMO])) break; if (sp > XB_SPIN_CAP) { atomicAdd(&bar[XB_TMO], 1u); break; } }
    }
    nloc = mine > 0u ? mine : 1u; nx = cnt > 0u ? cnt : 1u;
}

__device__ __forceinline__ void xcd_barrier(const XcdBarrier& b) {
    asm volatile("s_waitcnt vmcnt(0)" ::: "memory");
    __syncthreads();
    if (threadIdx.x == 0) {
        unsigned* bar = b.bar;
        __builtin_amdgcn_s_waitcnt(0);
        unsigned nloc = b.st[0], nx = b.st[1];
        if (nloc == 0u) { xcd_barrier_complete(bar, b.x, nloc, nx); b.st[0] = nloc; b.st[1] = nx; }
        const unsigned old = xb_add(&bar[XB_XSUB(b.x)], 1u);
        const unsigned gen = old / nloc;
        if (old + 1u == (gen + 1u) * nloc) {
            __builtin_amdgcn_fence(__ATOMIC_RELEASE, "agent");
            asm volatile("s_waitcnt vmcnt(0)" ::: "memory");
            const unsigned og = xb_add(&bar[XB_TOP], 1u);
            const unsigned tg = og / nx;
            if (og + 1u == (tg + 1u) * nx) xb_add(&bar[XB_TOPGEN], 1u);
            else XB_SPIN(xb_ld(&bar[XB_TOPGEN]) == tg, bar);
            __builtin_amdgcn_fence(__ATOMIC_ACQUIRE, "agent");
            xb_add(&bar[XB_XGEN(b.x)], 1u);
            asm volatile("s_waitcnt vmcnt(0)" ::: "memory");
        } else {
            XB_SPIN(xb_ld(&bar[XB_XGEN(b.x)]) == gen, bar);
            __builtin_amdgcn_fence(__ATOMIC_ACQUIRE, "agent");
            asm volatile("s_waitcnt vmcnt(0)" ::: "memory");
        }
    }
    __syncthreads();
}

constexpr int NWAVES = 8;
constexpr int BATCH = 8, T = 2048, D = 2048, M = BATCH * T;
constexpr int NPROJ = 10320, NPROJ_P = 10496;
constexpr int C_Q = 0, C_K = 1024, C_V = 1280, C_CQ = 1536, C_KID = 2048, C_WID = 2112, C_HQ = 2128, C_HF = 3152, C_HI = 4176, C_HG = 5200, C_GA = 6224, C_GH = 8272;
constexpr int FFD = 5632, FFE = 7168, NEXP = 8;
constexpr int MS = 34816;
constexpr float EPS = 1e-6f;
constexpr float ATT_SCALE = 0.08838834764831845f;
constexpr float IDX_WSCALE = 0.25f * 0.125f;
constexpr int NSEL = 256;

constexpr size_t MiB = 1u << 20;
constexpr size_t WS_CTL = 0, CTL_ZERO_BYTES = 1 * MiB;
constexpr size_t WS_WIN = 2 * MiB, WIN_SZ = 41 * MiB;
constexpr size_t WS_WIDX = 84 * MiB, WIDX_SZ = 1 * MiB;
constexpr size_t WS_WUA = 86 * MiB, WS_WUH = 94 * MiB, WU_SZ = 4 * MiB;
constexpr size_t WS_WO = 102 * MiB, WO_SZ = 8 * MiB;
constexpr size_t WS_W13D = 118 * MiB, WS_W2D = 162 * MiB;
constexpr size_t WS_W13M = 184 * MiB, WS_W2M = 632 * MiB;
constexpr size_t WS_XB = 856 * MiB;
constexpr size_t WS_PROJ = 920 * MiB;
constexpr size_t WS_QN = 1248 * MiB, WS_QIDX = 1280 * MiB, WS_KN = 1312 * MiB, WS_KIDX = 1320 * MiB, WS_WIDXV = 1322 * MiB, WS_MASK = 1323 * MiB;
constexpr size_t WS_RSTD1 = 1327 * MiB, WS_RSTDCQ = WS_RSTD1 + 65536;
constexpr size_t WS_MIX = 1328 * MiB;
constexpr size_t WS_TMP = 1392 * MiB;
constexpr size_t WS_MRG = 1520 * MiB;
constexpr size_t WS_H = 1584 * MiB;
constexpr size_t WS_ACTM = 920 * MiB;
constexpr size_t WS_Y = 1396 * MiB, WS_HS = 1396 * MiB;
constexpr size_t WS_TAB = 1712 * MiB;
constexpr size_t TAB_RSTD2 = 0, TAB_RSTDS = 1 * 65536, TAB_TOKE = 4 * 65536, TAB_TOKPOS = 6 * 65536, TAB_TOKP = 8 * 65536, TAB_TOKDEST = 10 * 65536;
constexpr size_t WS_ISCR = 408 * MiB;
constexpr size_t WS_HOI = 472 * MiB;
constexpr size_t WS_HSX = 536 * MiB;
constexpr size_t WS_HDEC = 604 * MiB;
constexpr size_t WS_HQH = 744 * MiB, WS_HUT = 776 * MiB;
static_assert(WS_W13M + 8ull * 2 * FFE * 2048 <= WS_ISCR && WS_HDEC + 2 * MiB <= WS_W2M && WS_W2M + 8ull * 2048 * FFE <= WS_HQH && WS_HUT + 64 * MiB <= WS_XB, "dedicated regions sit in the unused halves of the expert-weight slots");
constexpr size_t WS_HB = 1714 * MiB;
constexpr size_t WS_END = 1778 * MiB;
static_assert(WS_WIN + 2 * WIN_SZ <= WS_WIDX && WS_W2M + 8ull * 2048 * 7168 * 2 <= WS_XB && WS_PROJ + (size_t)M * NPROJ_P * 2 <= WS_QN && WS_ACTM + (size_t)MS * FFE * 2 <= WS_Y && WS_Y + (size_t)MS * 2048 * 4 <= WS_TAB && WS_H + (size_t)M * D * 4 <= WS_TAB && WS_MRG + (size_t)M * D * 2 <= WS_H && WS_TMP + (size_t)M * D * 4 <= WS_MRG && WS_MIX + (size_t)M * D * 2 <= WS_TMP && WS_RSTDCQ + 65536 <= WS_MIX && WS_XB + (size_t)M * D * 2 <= WS_PROJ && WS_TAB + 12 * 65536 <= WS_END, "ws map");
constexpr int CW_BAR = 4096;
constexpr int CW_ECNT = 16384;

constexpr int RING_OFF = 0, RING_BYTES = 131072;
constexpr int LDSCTL_OFF = 135168, MISC_OFF = LDSCTL_OFF + 320;
constexpr int LDS_BYTES = 147456;

__device__ const unsigned char BUCKET[129] = {0, 1, 2, 3, 4, 5, 6, 7, 8, 9, 10, 11, 12, 13, 14, 15, 16, 16, 16, 17, 17, 18, 18, 18, 19, 19, 19, 20, 20, 20, 20, 21, 21, 21, 21, 22, 22, 22, 22, 22, 23, 23, 23, 23, 23, 23, 24, 24, 24, 24, 24, 24, 25, 25, 25, 25, 25, 25, 25, 26, 26, 26, 26, 26, 26, 26, 26, 27, 27, 27, 27, 27, 27, 27, 27, 27, 27, 28, 28, 28, 28, 28, 28, 28, 28, 28, 28, 29, 29, 29, 29, 29, 29, 29, 29, 29, 29, 29, 29, 30, 30, 30, 30, 30, 30, 30, 30, 30, 30, 30, 30, 30, 30, 31, 31, 31, 31, 31, 31, 31, 31, 31, 31, 31, 31, 31, 31, 31, 31};

typedef unsigned v2u __attribute__((ext_vector_type(2)));
struct Args { const float* in[23]; float* out; unsigned char* ws; int ph_lo, ph_hi; };
typedef const __attribute__((address_space(4))) Args* KA;
__device__ __forceinline__ KA ka_get() { KA p = (KA)__builtin_amdgcn_kernarg_segment_ptr(); asm volatile("" : "+s"(p)); return p; }

struct Frame {
    LAS unsigned char* lds;
    int tid, lane, wave, G, bid;
};
__device__ __forceinline__ Frame make_frame(LAS unsigned char* lds, int wave_s) {
    Frame F; int ln; asm volatile("v_mbcnt_lo_u32_b32 %0, -1, 0\n\tv_mbcnt_hi_u32_b32 %0, -1, %0" : "=v"(ln));
    int w = wave_s, b = blockIdx.x, g = gridDim.x; asm volatile("" : "+s"(w), "+s"(b), "+s"(g));
    F.lds = lds; F.lane = ln; F.wave = w; F.tid = w * 64 + ln; F.G = g; F.bid = b; return F;
}
__device__ __forceinline__ bool in_range(int k, int lo, int hi) { asm volatile("" : "+s"(k)); return lo <= k && k < hi; }
template <int O> __device__ __forceinline__ float swz(float v) { return __builtin_bit_cast(float, __builtin_amdgcn_ds_swizzle(__builtin_bit_cast(int, v), (O << 10) | 0x1f)); }
__device__ __forceinline__ void swap32(unsigned a, unsigned& r0, unsigned& r1) { unsigned b = a; asm volatile("" : "+v"(b)); auto rr = __builtin_amdgcn_permlane32_swap(a, b, false, false); r0 = rr[0]; r1 = rr[1]; }
__device__ __forceinline__ float x32_sum(float v) { unsigned r0, r1; swap32(__builtin_bit_cast(unsigned, v), r0, r1); return __builtin_bit_cast(float, r0) + __builtin_bit_cast(float, r1); }
__device__ __forceinline__ float x32_max(float v) { unsigned r0, r1; swap32(__builtin_bit_cast(unsigned, v), r0, r1); return fmaxf(__builtin_bit_cast(float, r0), __builtin_bit_cast(float, r1)); }
__device__ __forceinline__ float wave_sum(float v) { v += swz<1>(v); v += swz<2>(v); v += swz<4>(v); v += swz<8>(v); v += swz<16>(v); return x32_sum(v); }
__device__ __forceinline__ float wave_max(float v) { v = fmaxf(v, swz<1>(v)); v = fmaxf(v, swz<2>(v)); v = fmaxf(v, swz<4>(v)); v = fmaxf(v, swz<8>(v)); v = fmaxf(v, swz<16>(v)); return x32_max(v); }
__device__ __forceinline__ float bf2f(bf16 v) { return __builtin_bit_cast(float, (unsigned)v << 16); }
__device__ __forceinline__ float blo(unsigned w) { return __builtin_bit_cast(float, w << 16); }
__device__ __forceinline__ float bhi(unsigned w) { return __builtin_bit_cast(float, w & 0xffff0000u); }
__device__ __forceinline__ float sigmf(float x) { return __builtin_amdgcn_rcpf(1.0f + __builtin_amdgcn_exp2f(-1.4426950408889634f * x)); }
__device__ __forceinline__ float siluf(float x) { return x * __builtin_amdgcn_rcpf(1.0f + __builtin_amdgcn_exp2f(-1.4426950408889634f * x)); }

struct ConvD { const float* src; bf16* dst; const float* gain; int K, N, Npad, nb; size_t sstride, dstride; int grp, gstride, goff; int f8; };
__device__ __forceinline__ void get_conv(int id, KA a, ConvD& d) {
    const int l = id >> 3, k = id & 7;
    bf16* ws16 = (bf16*)a->ws;
    d.gain = nullptr; d.nb = 1; d.sstride = 0; d.dstride = 0; d.grp = 30; d.gstride = 0; d.goff = 0; d.f8 = 0;
    if (k == 0) { d.src = a->in[4] + (size_t)l * 2048 * NPROJ; d.dst = (bf16*)(a->ws + WS_WIN + l * WIN_SZ); d.gain = a->in[2] + l * 2048; d.K = 2048; d.N = NPROJ; d.Npad = NPROJ_P; }
    else if (k == 1) { d.src = a->in[8] + (size_t)l * 512 * 1024; d.dst = (bf16*)(a->ws + WS_WIDX + l * WIDX_SZ); d.gain = a->in[7] + l * 512; d.K = 512; d.N = 1024; d.Npad = 1024; }
    else if (k == 2) { d.src = a->in[13] + (size_t)l * 1024 * 2048; d.dst = (bf16*)(a->ws + WS_WUA + l * WU_SZ); d.K = 1024; d.N = 2048; d.Npad = 2048; }
    else if (k == 3) { d.src = a->in[14] + (size_t)l * 1024 * 2048; d.dst = (bf16*)(a->ws + WS_WUH + l * WU_SZ); d.K = 1024; d.N = 2048; d.Npad = 2048; }
    else if (k == 4) { d.src = a->in[15] + (size_t)l * 2048 * 2048; d.dst = (bf16*)(a->ws + WS_WO + l * WO_SZ); d.K = 2048; d.N = 2048; d.Npad = 2048; }
    else if (l == 0) {
        if (k == 5) { d.src = a->in[16]; d.dst = (bf16*)(a->ws + WS_W13D); d.gain = a->in[3]; d.K = 2048; d.N = FFD; d.Npad = FFD; d.grp = 7; d.gstride = 256; d.goff = 0; }
        else if (k == 6) { d.src = a->in[17]; d.dst = (bf16*)(a->ws + WS_W13D); d.gain = a->in[3]; d.K = 2048; d.N = FFD; d.Npad = FFD; d.grp = 7; d.gstride = 256; d.goff = 128; }
        else { d.src = a->in[18]; d.dst = (bf16*)(a->ws + WS_W2D); d.K = FFD; d.N = 2048; d.Npad = 2048; }
    } else {
        if (k == 5) { d.src = a->in[20]; d.dst = (bf16*)(a->ws + WS_W13M); d.gain = a->in[3] + 2048; d.K = 2048; d.N = FFE; d.Npad = FFE; d.nb = NEXP; d.sstride = (size_t)2048 * FFE; d.dstride = (size_t)2 * FFE * 2048; d.grp = 7; d.gstride = 256; d.goff = 0; d.f8 = 1; }
        else if (k == 6) { d.src = a->in[21]; d.dst = (bf16*)(a->ws + WS_W13M); d.gain = a->in[3] + 2048; d.K = 2048; d.N = FFE; d.Npad = FFE; d.nb = NEXP; d.sstride = (size_t)2048 * FFE; d.dstride = (size_t)2 * FFE * 2048; d.grp = 7; d.gstride = 256; d.goff = 128; d.f8 = 1; }
        else { d.src = a->in[22]; d.dst = (bf16*)(a->ws + WS_W2M); d.K = FFE; d.N = 2048; d.Npad = 2048; d.nb = NEXP; d.sstride = (size_t)FFE * 2048; d.dstride = (size_t)2048 * FFE; d.f8 = 1; }
    }
    (void)ws16;
}
__device__ __forceinline__ void conv_item(const ConvD& d, long item, LAS float* scr, int lane) {
    const int nblk = d.Npad / 64, kblk = d.K / 64; const int per = kblk * nblk, it32 = (int)item;
    const int e = it32 / per; const int r = it32 - e * per; const int kb = r / nblk, nbi = r - kb * nblk, k0 = 64 * kb, n0 = 64 * nbi;
    const float* src = d.src + (size_t)e * d.sstride; bf16* dst = d.dst + (size_t)e * d.dstride; unsigned char* dst8 = (unsigned char*)d.dst + (size_t)e * d.dstride;
    const int nn = (lane & 15) * 4, kq = lane >> 4;
    const int c = lane & 7;
    f32x4 g0 = {1.f, 1.f, 1.f, 1.f}, g1 = g0;
    if (d.gain) { g0 = *(const GAS f32x4*)(d.gain + k0 + 8 * c); g1 = *(const GAS f32x4*)(d.gain + k0 + 8 * c + 4); }
    f32x4 v[16];
    if (n0 + 64 <= d.N) {
#pragma unroll
        for (int i = 0; i < 16; ++i) { const int kk = 4 * i + kq; v[i] = *(const GAS f32x4*)(src + (size_t)(k0 + kk) * d.N + n0 + nn); }
    } else {
#pragma unroll
        for (int i = 0; i < 16; ++i) { const int kk = 4 * i + kq; v[i] = (n0 + nn < d.N) ? *(const GAS f32x4*)(src + (size_t)(k0 + kk) * d.N + n0 + nn) : (f32x4){0.f, 0.f, 0.f, 0.f}; }
    }
#pragma unroll
    for (int i = 0; i < 16; ++i) { const int kk = 4 * i + kq; LAS float* p = scr + kk * 65 + nn; p[0] = v[i][0]; p[1] = v[i][1]; p[2] = v[i][2]; p[3] = v[i][3]; }
    LDS_WAIT(); asm volatile("" ::: "memory");
    const float g[8] = {g0[0], g0[1], g0[2], g0[3], g1[0], g1[1], g1[2], g1[3]};
#pragma unroll
    for (int j = 0; j < 8; ++j) { const int n = (lane >> 3) + 8 * j; const LAS float* s = scr + (8 * c) * 65 + n;
        const int ng = n0 + n; const int row = (ng >> d.grp) * d.gstride + d.goff + (ng & ((1 << d.grp) - 1));
        if (d.f8) { unsigned w0 = 0u, w1 = 0u;
            w0 = __builtin_amdgcn_cvt_pk_fp8_f32(s[0 * 65] * g[0] * 64.f, s[1 * 65] * g[1] * 64.f, w0, false); w0 = __builtin_amdgcn_cvt_pk_fp8_f32(s[2 * 65] * g[2] * 64.f, s[3 * 65] * g[3] * 64.f, w0, true);
            w1 = __builtin_amdgcn_cvt_pk_fp8_f32(s[4 * 65] * g[4] * 64.f, s[5 * 65] * g[5] * 64.f, w1, false); w1 = __builtin_amdgcn_cvt_pk_fp8_f32(s[6 * 65] * g[6] * 64.f, s[7 * 65] * g[7] * 64.f, w1, true);
            *(GAS v2u*)(dst8 + (size_t)row * d.K + k0 + 8 * c) = (v2u){w0, w1}; }
        else { v4u o; o.x = pk2(s[0 * 65] * g[0], s[1 * 65] * g[1]); o.y = pk2(s[2 * 65] * g[2], s[3 * 65] * g[3]); o.z = pk2(s[4 * 65] * g[4], s[5 * 65] * g[5]); o.w = pk2(s[6 * 65] * g[6], s[7 * 65] * g[7]);
            *(GAS v4u*)(dst + (size_t)row * d.K + k0 + 8 * c) = o; } }
    LDS_WAIT(); asm volatile("" ::: "memory");
}
__device__ __forceinline__ void phase_conv(Frame& F, KA a, int id_lo, int id_hi, int vb, int vG) {
    LAS float* scr = (LAS float*)(F.lds + F.wave * 16640);
    const long gw = (long)vb * NWAVES + F.wave, NGW = (long)vG * NWAVES;
    long base = 0;
#pragma unroll 1
    for (int id = id_lo; id < id_hi; ++id) {
        ConvD d; get_conv(id, a, d);
        const long items = (long)d.nb * (d.K / 64) * (d.Npad / 64);
        long first = (gw - base % NGW + NGW) % NGW;
#pragma unroll 1
        for (long it = first; it < items; it += NGW) conv_item(d, it, scr, F.lane);
        base += items;
    }
}

__device__ __forceinline__ void phase_norm(Frame& F, const float* src, bf16* dst, float* rstd) {
    const int gw = F.bid * NWAVES + F.wave, NGW = F.G * NWAVES;
    for (int row = gw; row < M; row += NGW) {
        const GAS f32x4* xr = (const GAS f32x4*)(src + (size_t)row * D) + F.lane;
        f32x4 v[8]; float s = 0.f;
#pragma unroll
        for (int j = 0; j < 8; ++j) { v[j] = xr[64 * j]; s += (v[j].x * v[j].x + v[j].y * v[j].y) + (v[j].z * v[j].z + v[j].w * v[j].w); }
        s = wave_sum(s);
        GAS v2u* o8 = (GAS v2u*)(dst + (size_t)row * D) + F.lane;
#pragma unroll
        for (int j = 0; j < 8; ++j) { v2u w; w.x = pk2(v[j].x, v[j].y); w.y = pk2(v[j].z, v[j].w); o8[64 * j] = w; }
        if (F.lane == 0) rstd[row] = 1.0f / sqrtf(s * (1.0f / D) + EPS);
    }
}

__device__ __forceinline__ void phase_post(Frame& F, KA a, int l) {
    const int gw = F.bid * NWAVES + F.wave, NGW = F.G * NWAVES, lane = F.lane;
    const bf16* proj = (const bf16*)(a->ws + WS_PROJ);
    bf16* qn = (bf16*)(a->ws + WS_QN); bf16* kn = (bf16*)(a->ws + WS_KN); bf16* kidx = (bf16*)(a->ws + WS_KIDX); float* widx = (float*)(a->ws + WS_WIDXV); float* rstdcq = (float*)(a->ws + WS_RSTDCQ);
    const float* qg = a->in[5] + l * 128; const float* kg = a->in[6] + l * 128; const float* lng = a->in[9] + l * 64; const float* lnb = a->in[10] + l * 64;
    for (int row = gw; row < M; row += NGW) {
        const bf16* pr = proj + (size_t)row * NPROJ_P;
        {
            const v4u w0 = *(const GAS v4u*)(pr + C_Q + 16 * lane), w1 = *(const GAS v4u*)(pr + C_Q + 16 * lane + 8);
            float x[16] = {blo(w0.x), bhi(w0.x), blo(w0.y), bhi(w0.y), blo(w0.z), bhi(w0.z), blo(w0.w), bhi(w0.w), blo(w1.x), bhi(w1.x), blo(w1.y), bhi(w1.y), blo(w1.z), bhi(w1.z), blo(w1.w), bhi(w1.w)};
            float ss = 0.f;
#pragma unroll
            for (int i = 0; i < 16; ++i) ss += x[i] * x[i];
            ss += swz<1>(ss); ss += swz<2>(ss); ss += swz<4>(ss);
            const float r = ATT_SCALE / sqrtf(ss * (1.0f / 128.0f) + EPS); const int d0 = (lane & 7) * 16;
            unsigned o[8];
#pragma unroll
            for (int i = 0; i < 8; ++i) o[i] = pk2(x[2 * i] * r * qg[d0 + 2 * i], x[2 * i + 1] * r * qg[d0 + 2 * i + 1]);
            *(GAS v4u*)(qn + (size_t)row * 1024 + 16 * lane) = (v4u){o[0], o[1], o[2], o[3]}; *(GAS v4u*)(qn + (size_t)row * 1024 + 16 * lane + 8) = (v4u){o[4], o[5], o[6], o[7]};
        }
        {
            const v2u w = *(const GAS v2u*)(pr + C_K + 4 * lane);
            const float x0 = blo(w.x), x1 = bhi(w.x), x2 = blo(w.y), x3 = bhi(w.y);
            float ss = x0 * x0 + x1 * x1 + x2 * x2 + x3 * x3;
            ss += swz<1>(ss); ss += swz<2>(ss); ss += swz<4>(ss); ss += swz<8>(ss); ss += swz<16>(ss);
            const float r = 1.0f / sqrtf(ss * (1.0f / 128.0f) + EPS); const int d0 = (lane & 31) * 4;
            v2u o; o.x = pk2(x0 * r * kg[d0], x1 * r * kg[d0 + 1]); o.y = pk2(x2 * r * kg[d0 + 2], x3 * r * kg[d0 + 3]);
            *(GAS v2u*)(kn + (size_t)row * 256 + 4 * lane) = o;
        }
        {
            const v4u w = *(const GAS v4u*)(pr + C_CQ + 8 * lane);
            const float x[8] = {blo(w.x), bhi(w.x), blo(w.y), bhi(w.y), blo(w.z), bhi(w.z), blo(w.w), bhi(w.w)};
            float ss = 0.f;
#pragma unroll
            for (int i = 0; i < 8; ++i) ss += x[i] * x[i];
            ss = wave_sum(ss);
            if (lane == 0) rstdcq[row] = 1.0f / sqrtf(ss * (1.0f / 512.0f) + EPS);
        }
        {
            const float x = bf2f(pr[C_KID + lane]);
            const float mu = wave_sum(x) * (1.0f / 64.0f); const float dd = x - mu; const float var = wave_sum(dd * dd) * (1.0f / 64.0f);
            const float y = dd / sqrtf(var + EPS) * lng[lane] + lnb[lane];
            kidx[(size_t)row * 64 + lane] = (bf16)f2bf(y);
        }
        if (lane < 16) widx[(size_t)row * 16 + lane] = bf2f(pr[C_WID + lane]) * IDX_WSCALE;
    }
}

__device__ __forceinline__ unsigned ordkey(float v) { const unsigned u = __builtin_bit_cast(unsigned, v); return (u & 0x80000000u) ? ~u : (u | 0x80000000u); }
typedef float f32x16 __attribute__((ext_vector_type(16)));
typedef float f32x2 __attribute__((ext_vector_type(2)));
__device__ __forceinline__ int wave_total6(int cl) { int c = 0;
#pragma unroll
    for (int b = 0; b < 6; ++b) c += __popcll(__ballot((cl >> b) & 1)) << b;
    return c; }
__device__ __forceinline__ void select_row(unsigned (&key)[32], int t, unsigned long long* mrow, int lane) {
    if (t + 1 <= NSEL) {
#pragma unroll
        for (int j = 0; j < 32; ++j) { const unsigned long long bs = __ballot(key[j] != 0u); if (lane == 0) mrow[j] = bs; }
    } else {
#pragma unroll
        for (int st = 0; st < 5; ++st) { const int j = 16 >> st; const unsigned m = st == 0 ? 0x0000FFFFu : st == 1 ? 0x00FF00FFu : st == 2 ? 0x0F0F0F0Fu : st == 3 ? 0x33333333u : 0x55555555u;
#pragma unroll
            for (int k = 0; k < 32; ++k) if (!(k & j)) { const unsigned x = ((key[k] >> j) ^ key[k + j]) & m; key[k] ^= x << j; key[k + j] ^= x; } }
        unsigned G = 0u, E = 0xffffffffu;
#pragma unroll
        for (int bit = 31; bit >= 0; --bit) {
            const unsigned m = E & key[bit];
            const bool take = wave_total6(__popc(G) + __popc(m)) >= NSEL;
            E = take ? m : (E & ~m); G = take ? G : (G | m);
        }
        const int need = NSEL - wave_total6(__popc(G)); int running = 0;
        const unsigned long long lt = (lane == 0) ? 0ull : (~0ull >> (64 - lane));
#pragma unroll
        for (int j = 0; j < 32; ++j) {
            const bool eq = (E >> j) & 1u; const unsigned long long be = __ballot(eq);
            const int rank = running + __popcll(be & lt);
            const bool sel = ((G >> j) & 1u) || (eq && rank < need);
            running += __popcll(be);
            const unsigned long long bs = __ballot(sel); if (lane == 0) mrow[j] = bs;
        }
    }
}
__device__ __forceinline__ void phase_index2(Frame& F, KA a) {
    LAS unsigned char* Ws = F.lds + 66048;
    LAS unsigned char* Qs = F.lds;
    const bf16* qidx = (const bf16*)(a->ws + WS_QIDX); const bf16* kidx = (const bf16*)(a->ws + WS_KIDX); const float* widx = (const float*)(a->ws + WS_WIDXV);
    unsigned long long* mask = (unsigned long long*)(a->ws + WS_MASK);
    float* scr = (float*)(a->ws + WS_ISCR) + (size_t)F.bid * 65536;
    const int tid = F.tid, lane = F.lane, r = lane & 31, hi = lane >> 5, wave = F.wave;
    for (int u = F.bid; u < 256; u += F.G) {
        const int b = u >> 5, ii = u & 31;
#pragma unroll 1
        for (int half = 0; half < 2; ++half) {
            const int qb = half ? 63 - ii : ii; const int row0 = b * T + 32 * qb;
#pragma unroll
            for (int c = 0; c < 8; ++c) { const int row = tid >> 4, ch = (tid & 15) + 16 * c;
                *(LAS v4u*)(Qs + row * 2064 + ch * 16) = *(const GAS v4u*)(qidx + (size_t)(row0 + row) * 1024 + ch * 8); }
            if (tid < 128) *(LAS f32x4*)(Ws + 16 * tid) = *(const GAS f32x4*)(widx + (size_t)row0 * 16 + 4 * tid);
            __syncthreads();
#pragma unroll 1
            for (int kb = wave; kb <= qb; kb += 8) {
                bf16x8 kf[4]; const bf16* kp = kidx + (size_t)(b * T + 32 * kb + r) * 64 + 8 * hi;
#pragma unroll
                for (int ks = 0; ks < 4; ++ks) kf[ks] = *(const GAS bf16x8*)(kp + 16 * ks);
                f32x16 sc;
#pragma unroll
                for (int i = 0; i < 16; ++i) sc[i] = 0.f;
                const LAS unsigned char* qrow = Qs + r * 2064 + hi * 16; const LAS float* wrow = (const LAS float*)(Ws + r * 64);
                bf16x8 qa[4], qb[4];
#pragma unroll
                for (int ks = 0; ks < 4; ++ks) qa[ks] = *(const LAS bf16x8*)(qrow + ks * 32);
#pragma unroll 1
                for (int h = 0; h < 16; h += 2) {
#pragma unroll
                    for (int ks = 0; ks < 4; ++ks) qb[ks] = *(const LAS bf16x8*)(qrow + (h + 1) * 128 + ks * 32);
                    const float wA = wrow[h], wB = wrow[h + 1];
                    f32x16 accA, accB;
#pragma unroll
                    for (int i = 0; i < 16; ++i) { accA[i] = 0.f; accB[i] = 0.f; }
                    __builtin_amdgcn_sched_barrier(0);
#pragma unroll
                    for (int ks = 0; ks < 4; ++ks) accA = __builtin_amdgcn_mfma_f32_32x32x16_bf16(kf[ks], qa[ks], accA, 0, 0, 0);
                    __builtin_amdgcn_sched_barrier(0);
                    if (h + 2 < 16) {
#pragma unroll
                        for (int ks = 0; ks < 4; ++ks) qa[ks] = *(const LAS bf16x8*)(qrow + (h + 2) * 128 + ks * 32); }
#pragma unroll
                    for (int ks = 0; ks < 4; ++ks) accB = __builtin_amdgcn_mfma_f32_32x32x16_bf16(kf[ks], qb[ks], accB, 0, 0, 0);
                    __builtin_amdgcn_sched_barrier(0);
#pragma unroll
                    for (int i = 0; i < 16; ++i) sc[i] = fmaf(wA, __builtin_amdgcn_fmed3f(accA[i], 0.f, 3.0e38f), sc[i]);
#pragma unroll
                    for (int i = 0; i < 16; ++i) sc[i] = fmaf(wB, __builtin_amdgcn_fmed3f(accB[i], 0.f, 3.0e38f), sc[i]);
                }
                LAS float* Tw = (LAS float*)(F.lds + 68096 + wave * 4224);
#pragma unroll
                for (int i = 0; i < 16; ++i) Tw[r * 33 + (i & 3) + 8 * (i >> 2) + 4 * hi] = sc[i];
                asm volatile("s_waitcnt lgkmcnt(0)" ::: "memory");
#pragma unroll
                for (int j = 0; j < 16; ++j) { const int q = 2 * j + hi; scr[(size_t)q * 2048 + 32 * kb + r] = Tw[q * 33 + r]; }
                asm volatile("s_waitcnt lgkmcnt(0)" ::: "memory");
            }
            __syncthreads();
#pragma unroll 1
            for (int pass = 0; pass < 2; ++pass) {
                const int q0 = 4 * wave + 2 * pass, ta = 32 * qb + q0, tb = ta + 1; const size_t rowa = (size_t)row0 + q0;
                unsigned ka[32], kb2[32];
#pragma unroll
                for (int j = 0; j < 32; ++j) { const int s = lane + 64 * j; float vx = 0.f, vy = 0.f;
                    if (s <= 32 * qb + 31) { vx = *(const GAS float*)(scr + (size_t)q0 * 2048 + s); vy = *(const GAS float*)(scr + (size_t)(q0 + 1) * 2048 + s); }
                    ka[j] = (s <= ta) ? ordkey(vx) : 0u; kb2[j] = (s <= tb) ? ordkey(vy) : 0u; }
                select_row(ka, ta, mask + rowa * 32, lane);
                select_row(kb2, tb, mask + (rowa + 1) * 32, lane);
            }
            __syncthreads();
        }
    }
}

namespace att {
using s16x4  = __attribute__((ext_vector_type(4))) short;
constexpr int KVBLK = 64; constexpr size_t SHM_V = 16384, SHM_K = 16384; constexpr int OFF_WS = 65536, OFF_BIAS = 67584;
constexpr float THR = 8.f, LOG2E = 1.4426950408889634f;
#define KSWZ(row, colB) ((row) * 256 + ((colB) ^ (((row) & 7) << 4)))
#define SBAR() __builtin_amdgcn_sched_barrier(0)
__device__ __forceinline__ int crow(int r, int hi) { return (r & 3) + 8 * (r >> 2) + 4 * hi; }
__device__ __forceinline__ unsigned cvtpk(float lo, float hi) { unsigned r; asm volatile("v_cvt_pk_bf16_f32 %0, %1, %2" : "=v"(r) : "v"(lo), "v"(hi)); return r; }
template <bool NEAR> __device__ __forceinline__ void mask_bias(f32x16& p0, f32x16& p1, unsigned w0, unsigned w1, int hi, int dbase, const LAS float* bt) {
    const unsigned s0 = w0 >> (4 * hi), s1 = w1 >> (4 * hi);
#pragma unroll
    for (int r = 0; r < 16; ++r) { const int bp = (r & 3) + 8 * (r >> 2);
        float a = p0[r], b = p1[r];
        if (NEAR) { int i0 = dbase - bp, i1 = dbase - bp - 32; i0 = i0 < 0 ? 0 : (i0 > 128 ? 128 : i0); i1 = i1 < 0 ? 0 : (i1 > 128 ? 128 : i1); a += bt[i0]; b += bt[i1]; }
        p0[r] = ((s0 >> bp) & 1u) ? a : -INFINITY; p1[r] = ((s1 >> bp) & 1u) ? b : -INFINITY; }
}
__device__ __forceinline__ void partialSM(f32x16& p0, f32x16& p1, float badd, float& m_reg, float& mn, float& alpha) {
  float pmax = p0[0];
#pragma unroll
  for (int r = 1; r < 16; ++r) pmax = __builtin_amdgcn_fmed3f(pmax, p0[r], INFINITY);
#pragma unroll
  for (int r = 0; r < 16; ++r) pmax = __builtin_amdgcn_fmed3f(pmax, p1[r], INFINITY);
  pmax += badd;
  pmax = x32_max(pmax);
  if (__builtin_expect(__all(pmax - m_reg <= THR), 1)) { mn = m_reg; alpha = 1.f; }
  else { mn = fmaxf(m_reg, pmax); alpha = __builtin_amdgcn_exp2f((m_reg - mn) * LOG2E); m_reg = mn; }
  const float mnC = (badd - mn) * LOG2E;
#pragma unroll
  for (int r = 0; r < 16; ++r) p0[r] = fmaf(p0[r], LOG2E, mnC);
#pragma unroll
  for (int r = 0; r < 16; ++r) p1[r] = fmaf(p1[r], LOG2E, mnC);
#pragma unroll
  for (int r = 0; r < 16; ++r) p0[r] = __builtin_amdgcn_exp2f(p0[r]);
}
__device__ __forceinline__ void finishSM(f32x16& p0, f32x16& p1, float alpha, float& l_reg, bf16x8& pa0, bf16x8& pa1, bf16x8& pa2, bf16x8& pa3) {
#pragma unroll
  for (int r = 0; r < 16; ++r) p1[r] = __builtin_amdgcn_exp2f(p1[r]);
  float ps = 0;
#pragma unroll
  for (int r = 0; r < 16; ++r) ps += p0[r];
#pragma unroll
  for (int r = 0; r < 16; ++r) ps += p1[r];
  ps = x32_sum(ps);
  l_reg = l_reg * alpha + ps;
#define PK4(P, BASE, OUT) do { unsigned a0 = cvtpk(P[BASE + 0], P[BASE + 1]), a1 = cvtpk(P[BASE + 2], P[BASE + 3]);   \
    unsigned b0 = cvtpk(P[BASE + 4], P[BASE + 5]), b1 = cvtpk(P[BASE + 6], P[BASE + 7]);                              \
    auto r0 = __builtin_amdgcn_permlane32_swap(a0, b0, false, false); auto r1 = __builtin_amdgcn_permlane32_swap(a1, b1, false, false); \
    v4u w = {r0[0], r1[0], r0[1], r1[1]}; OUT = __builtin_bit_cast(bf16x8, w); } while (0)
  PK4(p0, 0, pa0); PK4(p0, 8, pa1); PK4(p1, 0, pa2); PK4(p1, 8, pa3);
#undef PK4
}
__device__ __forceinline__ void qkt(f32x16& p0, f32x16& p1, const LAS char* Ks, const bf16x8* qr, int r32, int hi) {
#pragma unroll
  for (int r = 0; r < 16; ++r) { p0[r] = 0.f; p1[r] = 0.f; }
#pragma unroll
  for (int d0 = 0; d0 < 8; ++d0) { const int cb = (d0 * 16 + hi * 8) * 2;
    const bf16x8 b0 = *(const LAS bf16x8*)(Ks + KSWZ(r32, cb));
    const bf16x8 b1 = *(const LAS bf16x8*)(Ks + KSWZ(32 + r32, cb));
    p0 = __builtin_amdgcn_mfma_f32_32x32x16_bf16(b0, qr[d0], p0, 0, 0, 0);
    p1 = __builtin_amdgcn_mfma_f32_32x32x16_bf16(b1, qr[d0], p1, 0, 0, 0); }
}
__device__ __forceinline__ int v_st(int k, int c) { const int kk = (k & ~0xC) | ((k & 4) << 1) | ((k & 8) >> 1); return ((kk >> 3) * 4 + (c >> 5)) * 512 + ((kk & 7) * 32 + (c & 31)) * 2; }
__device__ __forceinline__ int v_rd_base(int lane) { return ((lane & 3) << 3) | (((lane >> 2) & 3) << 6) | (((lane >> 4) & 1) << 5) | (((lane >> 5) & 1) << 8); }
constexpr int v_rd_off(int d0, int ks, int half) { return d0 * 512 + ks * 4096 + half * 2048; }
template <int OFF> __device__ __forceinline__ s16x4 tr_read(int vb) { s16x4 r; asm volatile("ds_read_b64_tr_b16 %0, %1 offset:%2" : "=&v"(r) : "v"(vb), "i"(OFF) : "memory"); return r; }
template <int D0> __device__ __forceinline__ void pv_one(f32x16& od, int vb, bf16x8 pa0, bf16x8 pa1, bf16x8 pa2, bf16x8 pa3) {
  const s16x4 l0 = tr_read<v_rd_off(D0, 0, 0)>(vb), h0 = tr_read<v_rd_off(D0, 0, 1)>(vb), l1 = tr_read<v_rd_off(D0, 1, 0)>(vb), h1 = tr_read<v_rd_off(D0, 1, 1)>(vb);
  const s16x4 l2 = tr_read<v_rd_off(D0, 2, 0)>(vb), h2 = tr_read<v_rd_off(D0, 2, 1)>(vb), l3 = tr_read<v_rd_off(D0, 3, 0)>(vb), h3 = tr_read<v_rd_off(D0, 3, 1)>(vb);
  asm volatile("s_waitcnt lgkmcnt(0)" ::: "memory"); SBAR();
#define PK(L, H) (bf16x8){L[0], L[1], L[2], L[3], H[0], H[1], H[2], H[3]}
  od = __builtin_amdgcn_mfma_f32_32x32x16_bf16(pa0, PK(l0, h0), od, 0, 0, 0);
  od = __builtin_amdgcn_mfma_f32_32x32x16_bf16(pa1, PK(l1, h1), od, 0, 0, 0);
  od = __builtin_amdgcn_mfma_f32_32x32x16_bf16(pa2, PK(l2, h2), od, 0, 0, 0);
  od = __builtin_amdgcn_mfma_f32_32x32x16_bf16(pa3, PK(l3, h3), od, 0, 0, 0);
#undef PK
}
__device__ __forceinline__ void pv_d0(f32x16* o, int vb, bf16x8 pa0, bf16x8 pa1, bf16x8 pa2, bf16x8 pa3) {
  pv_one<0>(o[0], vb, pa0, pa1, pa2, pa3); pv_one<1>(o[1], vb, pa0, pa1, pa2, pa3); pv_one<2>(o[2], vb, pa0, pa1, pa2, pa3); pv_one<3>(o[3], vb, pa0, pa1, pa2, pa3);
}
__device__ __forceinline__ void attn_unit(const bf16* __restrict__ Qt, const bf16* __restrict__ Kh, const bf16* __restrict__ Vh, const unsigned* __restrict__ mrow, bf16* __restrict__ Ob,
                                          int kvh, int qt, const float* relb, LAS char* lds, int tid) {
  constexpr int LDKK = 256, LDKV = NPROJ_P;
  const int wid = __builtin_amdgcn_readfirstlane(tid >> 6), lane = tid & 63, r32 = lane & 31, hi = lane >> 5;
  LAS char* V_lds = lds; LAS char* K_lds = lds + 2 * SHM_V;
  LAS float* wsf = (LAS float*)(lds + OFF_WS) + wid * 64; LAS float* li_l = wsf; LAS float* al_l = wsf + 32;
  const int hq = kvh * 4 + (wid >> 1), tq0 = 64 * qt + 32 * (wid & 1), tq = tq0 + r32;
  const LAS float* bt = (const LAS float*)(lds + OFF_BIAS) + hq * 132;
  const float bfar = relb[31 * 8 + hq];
  float m_reg = -1e30f, l_reg = 0; f32x16 o[4]; bf16x8 qr[8];
#pragma unroll
  for (int d = 0; d < 4; ++d)
#pragma unroll
    for (int r = 0; r < 16; ++r) o[d][r] = 0.f;
  const bf16* Qw = Qt + (size_t)tq * 1024 + hq * 128 + hi * 8;
#pragma unroll
  for (int d0 = 0; d0 < 8; ++d0) qr[d0] = *(const GAS bf16x8*)(Qw + d0 * 16);
  const unsigned* mq = mrow + (size_t)tq * 64;
  const int sr = tid >> 4, sc = (tid & 15) * 8, vst0 = v_st(sr, sc), vst1 = v_st(32 + sr, sc);
  const int vb0 = (int)(size_t)V_lds + v_rd_base(lane);
  struct { bf16x8 vs0, vs1, ks0, ks1; } sr_[1];
#define SLOAD(i, k0) do { sr_[i].vs0 = *(const GAS bf16x8*)(&Vh[(size_t)((k0) + sr) * LDKV + sc]); sr_[i].vs1 = *(const GAS bf16x8*)(&Vh[(size_t)((k0) + 32 + sr) * LDKV + sc]); \
    sr_[i].ks0 = *(const GAS bf16x8*)(&Kh[(size_t)((k0) + sr) * LDKK + sc]); sr_[i].ks1 = *(const GAS bf16x8*)(&Kh[(size_t)((k0) + 32 + sr) * LDKK + sc]); } while (0)
#define SWRITE(b, i) do { *(LAS bf16x8*)(V_lds + (b) * SHM_V + vst0) = sr_[i].vs0;          \
    *(LAS bf16x8*)(V_lds + (b) * SHM_V + vst1) = sr_[i].vs1; const int kc = sc * 2;               \
    *(LAS bf16x8*)(K_lds + (b) * SHM_K + KSWZ(sr, kc)) = sr_[i].ks0;                       \
    *(LAS bf16x8*)(K_lds + (b) * SHM_K + KSWZ(32 + sr, kc)) = sr_[i].ks1; } while (0)
#define RESC(a) do { if (__any((a) < 1.f)) { if (hi == 0) al_l[r32] = (a); asm volatile("s_waitcnt lgkmcnt(0)" ::: "memory"); \
    _Pragma("unroll") for (int d = 0; d < 4; ++d) _Pragma("unroll") for (int r = 0; r < 16; ++r) o[d][r] *= al_l[crow(r, hi)]; } } while (0)
#define MASKB(P0, P1, j, BADD) do { const v2u mw_ = *(const GAS v2u*)(mq + 2 * (j)); \
    if ((j) + 3 <= qt) { mask_bias<false>(P0, P1, mw_.x, mw_.y, hi, 0, bt); BADD = bfar; } \
    else { mask_bias<true>(P0, P1, mw_.x, mw_.y, hi, tq - 64 * (j) - 4 * hi, bt); BADD = 0.f; } } while (0)
  f32x16 p0, p1; float mn, al, bd; bf16x8 pa0, pa1, pa2, pa3;
  const int NT = qt + 1;
  SLOAD(0, 0); asm volatile("s_waitcnt vmcnt(0)" ::: "memory"); SWRITE(0, 0); __syncthreads();
#pragma unroll 1
  for (int j = 0; j < NT; ++j) {
    const int bsel = j & 1;
    if (j + 1 < NT) SLOAD(0, (j + 1) * KVBLK);
    SBAR(); qkt(p0, p1, K_lds + bsel * SHM_K, qr, r32, hi);
    MASKB(p0, p1, j, bd); partialSM(p0, p1, bd, m_reg, mn, al);
    RESC(al);
    finishSM(p0, p1, al, l_reg, pa0, pa1, pa2, pa3); SBAR();
    pv_d0(o, vb0 + bsel * (int)SHM_V, pa0, pa1, pa2, pa3);
    if (j + 1 < NT) { asm volatile("s_waitcnt vmcnt(0)" ::: "memory"); SWRITE(bsel ^ 1, 0); }
    __syncthreads();
  }
  if (hi == 0) li_l[r32] = l_reg; asm volatile("s_waitcnt lgkmcnt(0)" ::: "memory");
  float rli[16];
#pragma unroll
  for (int r = 0; r < 16; ++r) rli[r] = __builtin_amdgcn_rcpf(li_l[crow(r, hi)]);
  bf16* Ow = Ob + (size_t)tq0 * 2048 + hq * 128;
#pragma unroll
  for (int r = 0; r < 16; ++r) { const int orow = crow(r, hi);
#pragma unroll
    for (int d0 = 0; d0 < 4; ++d0) Ow[(size_t)orow * 2048 + d0 * 32 + r32] = (bf16)f2bf(o[d0][r] * rli[r]); }
  __syncthreads();
#undef SLOAD
#undef SWRITE
#undef RESC
#undef MASKB
}
#undef KSWZ
#undef SBAR
}
__device__ __forceinline__ void phase_attn2(Frame& F, KA a) {
    const bf16* qn = (const bf16*)(a->ws + WS_QN); const bf16* kn = (const bf16*)(a->ws + WS_KN); const bf16* proj = (const bf16*)(a->ws + WS_PROJ);
    const unsigned* mask = (const unsigned*)(a->ws + WS_MASK); bf16* mix = (bf16*)(a->ws + WS_MIX); const float* relb = a->in[1];
    LAS float* btab = (LAS float*)(F.lds + att::OFF_BIAS);
    for (int i = F.tid; i < 8 * 129; i += NWAVES * 64) { const int h = i / 129, d = i - h * 129; btab[h * 132 + d] = relb[BUCKET[d] * 8 + h]; }
    __syncthreads();
    for (int u = F.bid; u < 256; u += F.G) {
        const int b = u >> 5, kvh = (u >> 4) & 1, ip = u & 15;
#pragma unroll 1
        for (int half = 0; half < 2; ++half) {
            const int qt = half ? ip : 31 - ip;
            att::attn_unit(qn + (size_t)b * T * 1024, kn + (size_t)b * T * 256 + kvh * 128, proj + (size_t)b * T * NPROJ_P + C_V + kvh * 128, mask + (size_t)b * T * 64, mix + (size_t)b * T * 2048,
                           kvh, qt, relb, (LAS char*)F.lds, F.tid);
        }
    }
}

__device__ __forceinline__ void phase_hgrn(Frame& F, KA a, int l) {
    LAS float* qs = (LAS float*)(F.lds); LAS float* fs = (LAS float*)(F.lds + 16384); LAS float* ks = (LAS float*)(F.lds + 32768); LAS float* vs = (LAS float*)(F.lds + 49152); LAS float* ob = (LAS float*)(F.lds + 65536);
    const bf16* proj = (const bf16*)(a->ws + WS_PROJ); bf16* mix = (bf16*)(a->ws + WS_MIX);
    const float* lbl = a->in[11]; const float* gn = a->in[12] + l * 128;
    const int tid = F.tid, j = tid >> 2, dsl = tid & 3, tt_s = tid >> 4, d8 = (tid & 15) * 8;
    for (int unit = F.bid; unit < BATCH * 8; unit += F.G) {
        const int b = unit >> 3, h = unit & 7;
        float lbv[8];
#pragma unroll
        for (int i = 0; i < 8; ++i) lbv[i] = (l == 0) ? 0.f : sigmf(lbl[1024 + h * 128 + d8 + i] - lbl[h * 128 + d8 + i]);
        float S[32];
#pragma unroll
        for (int i = 0; i < 32; ++i) S[i] = 0.f;
#pragma unroll 1
        for (int c = 0; c < T / 32; ++c) {
            {   const bf16* pr = proj + (size_t)(b * T + c * 32 + tt_s) * NPROJ_P + h * 128 + d8;
                const v4u wq = *(const GAS v4u*)(pr + C_HQ), wfv = *(const GAS v4u*)(pr + C_HF), wi = *(const GAS v4u*)(pr + C_HI);
                const float xq[8] = {blo(wq.x), bhi(wq.x), blo(wq.y), bhi(wq.y), blo(wq.z), bhi(wq.z), blo(wq.w), bhi(wq.w)};
                const float xf[8] = {blo(wfv.x), bhi(wfv.x), blo(wfv.y), bhi(wfv.y), blo(wfv.z), bhi(wfv.z), blo(wfv.w), bhi(wfv.w)};
                const float xi[8] = {blo(wi.x), bhi(wi.x), blo(wi.y), bhi(wi.y), blo(wi.z), bhi(wi.z), blo(wi.w), bhi(wi.w)};
                float q[8], f[8], k[8];
#pragma unroll
                for (int i = 0; i < 8; ++i) { q[i] = siluf(xq[i]) * ATT_SCALE; f[i] = lbv[i] + (1.0f - lbv[i]) * sigmf(xf[i]); k[i] = 1.0f - f[i]; }
                const int o = tt_s * 128 + d8;
                *(LAS f32x4*)(qs + o) = (f32x4){q[0], q[1], q[2], q[3]}; *(LAS f32x4*)(qs + o + 4) = (f32x4){q[4], q[5], q[6], q[7]};
                *(LAS f32x4*)(fs + o) = (f32x4){f[0], f[1], f[2], f[3]}; *(LAS f32x4*)(fs + o + 4) = (f32x4){f[4], f[5], f[6], f[7]};
                *(LAS f32x4*)(ks + o) = (f32x4){k[0], k[1], k[2], k[3]}; *(LAS f32x4*)(ks + o + 4) = (f32x4){k[4], k[5], k[6], k[7]};
                *(LAS f32x4*)(vs + o) = (f32x4){xi[0], xi[1], xi[2], xi[3]}; *(LAS f32x4*)(vs + o + 4) = (f32x4){xi[4], xi[5], xi[6], xi[7]};
            }
            __syncthreads();
#pragma unroll 1
            for (int tt = 0; tt < 32; ++tt) {
                const float v = vs[tt * 128 + j]; float o = 0.f;
                const LAS f32x4* f4 = (const LAS f32x4*)(fs + tt * 128 + dsl * 32); const LAS f32x4* k4 = (const LAS f32x4*)(ks + tt * 128 + dsl * 32); const LAS f32x4* q4 = (const LAS f32x4*)(qs + tt * 128 + dsl * 32);
#pragma unroll
                for (int i4 = 0; i4 < 8; ++i4) { const f32x4 ff = f4[i4], kk = k4[i4], qq = q4[i4];
                    S[4 * i4] = ff.x * S[4 * i4] + kk.x * v; o += qq.x * S[4 * i4];
                    S[4 * i4 + 1] = ff.y * S[4 * i4 + 1] + kk.y * v; o += qq.y * S[4 * i4 + 1];
                    S[4 * i4 + 2] = ff.z * S[4 * i4 + 2] + kk.z * v; o += qq.z * S[4 * i4 + 2];
                    S[4 * i4 + 3] = ff.w * S[4 * i4 + 3] + kk.w * v; o += qq.w * S[4 * i4 + 3]; }
                o += swz<1>(o); o += swz<2>(o);
                if (dsl == 0) ob[tt * 128 + j] = o;
            }
            __syncthreads();
            {   const size_t row = (size_t)(b * T + c * 32 + tt_s);
                const f32x4 o0 = *(const LAS f32x4*)(ob + tt_s * 128 + d8), o1 = *(const LAS f32x4*)(ob + tt_s * 128 + d8 + 4);
                float ss = (o0.x * o0.x + o0.y * o0.y) + (o0.z * o0.z + o0.w * o0.w) + (o1.x * o1.x + o1.y * o1.y) + (o1.z * o1.z + o1.w * o1.w);
                ss += swz<1>(ss); ss += swz<2>(ss); ss += swz<4>(ss); ss += swz<8>(ss);
                const float r = 1.0f / sqrtf(ss * (1.0f / 128.0f) + EPS);
                const v4u wg = *(const GAS v4u*)(proj + row * NPROJ_P + C_HG + h * 128 + d8);
                const float xg[8] = {blo(wg.x), bhi(wg.x), blo(wg.y), bhi(wg.y), blo(wg.z), bhi(wg.z), blo(wg.w), bhi(wg.w)};
                const float ov[8] = {o0.x, o0.y, o0.z, o0.w, o1.x, o1.y, o1.z, o1.w};
                unsigned pw[4];
#pragma unroll
                for (int i = 0; i < 4; ++i) pw[i] = pk2(ov[2 * i] * r * gn[d8 + 2 * i] * siluf(xg[2 * i]), ov[2 * i + 1] * r * gn[d8 + 2 * i + 1] * siluf(xg[2 * i + 1]));
                *(GAS v4u*)(mix + row * 2048 + 1024 + h * 128 + d8) = (v4u){pw[0], pw[1], pw[2], pw[3]};
            }
            __syncthreads();
        }
    }
}


namespace hg {
constexpr int LQ = 272, LT = 144;
constexpr int OFF_G = 0, OFF_TOT = 32768, OFF_BV = 34816, OFF_QH0 = 36864, OFF_QH1 = OFF_QH0 + 64 * LQ, OFF_KH = OFF_QH1 + 32 * LQ, OFF_KP = OFF_KH + 64 * LQ, OFF_K2T = OFF_KP + 64 * LQ, OFF_VT = OFF_K2T + 128 * LT, OFF_END = OFF_VT + 128 * LT;
static_assert(OFF_END <= LDSCTL_OFF, "hgrn LDS map");
__device__ __forceinline__ int crow(int r, int hi) { return (r & 3) + 8 * (r >> 2) + 4 * hi; }
__device__ __forceinline__ bf16x8 pack8(const f32x16& x, int s) { v4u w; w.x = pk2(x[8 * s], x[8 * s + 1]); w.y = pk2(x[8 * s + 2], x[8 * s + 3]); w.z = pk2(x[8 * s + 4], x[8 * s + 5]); w.w = pk2(x[8 * s + 6], x[8 * s + 7]); return __builtin_bit_cast(bf16x8, w); }
__device__ __forceinline__ f32x16 xblock(const LAS unsigned char* Kt, const LAS unsigned char* Qt, int r32, int hi) {
    f32x16 x;
#pragma unroll
    for (int i = 0; i < 16; ++i) x[i] = 0.f;
#pragma unroll
    for (int st = 0; st < 8; ++st) { const bf16x8 ka = *(const LAS bf16x8*)(Kt + r32 * LQ + (16 * st + 8 * hi) * 2), qb = *(const LAS bf16x8*)(Qt + r32 * LQ + (16 * st + 8 * hi) * 2);
        x = __builtin_amdgcn_mfma_f32_32x32x16_bf16(ka, qb, x, 0, 0, 0); }
    return x;
}
__device__ __forceinline__ void xtv(f32x16& od, const f32x16& x_, const LAS unsigned char* vt  , int hi) {
    f32x16 x = x_; asm volatile("s_nop 15\n\ts_nop 3" : "+v"(x));
#pragma unroll
    for (int st = 0; st < 2; ++st) { const v2u lo = *(const LAS v2u*)(vt + (16 * st + 4 * hi) * 2), hi2 = *(const LAS v2u*)(vt + (16 * st + 8 + 4 * hi) * 2);
        const v4u w = {lo.x, lo.y, hi2.x, hi2.y};
        od = __builtin_amdgcn_mfma_f32_32x32x16_bf16(pack8(x, st), __builtin_bit_cast(bf16x8, w), od, 0, 0, 0); }
}
}
__device__ __forceinline__ void phase_hgrn1(Frame& F, KA a, int l) {
    using namespace hg;
    LAS unsigned char* L = F.lds; LAS float* G = (LAS float*)(L + OFF_G); LAS float* TOT = (LAS float*)(L + OFF_TOT); LAS float* BV = (LAS float*)(L + OFF_BV);
    const bf16* proj = (const bf16*)(a->ws + WS_PROJ);
    float* OI = (float*)(a->ws + WS_HOI); bf16* UT = (bf16*)(a->ws + WS_HUT); bf16* QH = (bf16*)(a->ws + WS_HQH); float* DEC = (float*)(a->ws + WS_HDEC);
    const float* lbl = a->in[11];
    const int tid = F.tid, lane = F.lane, r32 = lane & 31, hi = lane >> 5, wave = F.wave;
    for (int u = F.bid; u < BATCH * 8 * 32; u += F.G) {
        const int c = u & 31, h = (u >> 5) & 7, b = u >> 8; const size_t row0 = (size_t)b * T + 64 * c;
        float qv[2][8], kv[2][8];
#pragma unroll
        for (int k = 0; k < 2; ++k) { const int slot = tid + 512 * k, t = slot >> 4, d8 = (slot & 15) * 8;
            const bf16* pr = proj + (row0 + t) * NPROJ_P + h * 128 + d8;
            const v4u wq = *(const GAS v4u*)(pr + C_HQ), wf = *(const GAS v4u*)(pr + C_HF), wi = *(const GAS v4u*)(pr + C_HI);
            const float xq[8] = {blo(wq.x), bhi(wq.x), blo(wq.y), bhi(wq.y), blo(wq.z), bhi(wq.z), blo(wq.w), bhi(wq.w)};
            const float xf[8] = {blo(wf.x), bhi(wf.x), blo(wf.y), bhi(wf.y), blo(wf.z), bhi(wf.z), blo(wf.w), bhi(wf.w)};
            float g[8];
#pragma unroll
            for (int i = 0; i < 8; ++i) { const float lb = (l == 0) ? 0.f : sigmf(lbl[1024 + h * 128 + d8 + i] - lbl[h * 128 + d8 + i]);
                const float f = lb + (1.0f - lb) * sigmf(xf[i]); qv[k][i] = siluf(xq[i]) * ATT_SCALE; kv[k][i] = 1.0f - f; g[i] = __logf(f); }
            *(LAS f32x4*)(G + t * 128 + d8) = (f32x4){g[0], g[1], g[2], g[3]}; *(LAS f32x4*)(G + t * 128 + d8 + 4) = (f32x4){g[4], g[5], g[6], g[7]};
            const unsigned vw[4] = {wi.x, wi.y, wi.z, wi.w};
#pragma unroll
            for (int i = 0; i < 8; ++i) *(LAS bf16*)(L + OFF_VT + (d8 + i) * LT + t * 2) = (bf16)((i & 1) ? (vw[i >> 1] >> 16) : (vw[i >> 1] & 0xffffu));
        }
        __syncthreads();
        { const int d = tid & 127, sb = tid >> 7; float run = 0.f;
#pragma unroll
            for (int i = 0; i < 16; ++i) { run += G[(16 * sb + i) * 128 + d]; G[(16 * sb + i) * 128 + d] = run; }
            TOT[sb * 128 + d] = run;
            __syncthreads();
            float off = 0.f;
#pragma unroll
            for (int q = 0; q < 3; ++q) off += (q < sb) ? TOT[q * 128 + d] : 0.f;
#pragma unroll
            for (int i = 0; i < 16; ++i) G[(16 * sb + i) * 128 + d] += off;
            if (sb == 0) { const float b1 = TOT[d] + TOT[128 + d], bl = b1 + TOT[256 + d] + TOT[384 + d]; BV[d] = b1; BV[128 + d] = bl;
                DEC[(size_t)u * 128 + d] = __expf(bl); }
        }
        __syncthreads();
#pragma unroll
        for (int k = 0; k < 2; ++k) { const int slot = tid + 512 * k, t = slot >> 4, d8 = (slot & 15) * 8; const int J = t >> 5;
            const f32x4 ba = *(const LAS f32x4*)(G + t * 128 + d8), bb = *(const LAS f32x4*)(G + t * 128 + d8 + 4);
            const f32x4 b1a = *(const LAS f32x4*)(BV + d8), b1b = *(const LAS f32x4*)(BV + d8 + 4), bla = *(const LAS f32x4*)(BV + 128 + d8), blb = *(const LAS f32x4*)(BV + 128 + d8 + 4);
            const float bt[8] = {ba.x, ba.y, ba.z, ba.w, bb.x, bb.y, bb.z, bb.w}, b1[8] = {b1a.x, b1a.y, b1a.z, b1a.w, b1b.x, b1b.y, b1b.z, b1b.w}, bl[8] = {bla.x, bla.y, bla.z, bla.w, blb.x, blb.y, blb.z, blb.w};
            float q0[8], q1[8], kh[8], kp[8], k2[8];
#pragma unroll
            for (int i = 0; i < 8; ++i) { const float bj = J ? b1[i] : 0.f, bj1 = J ? bl[i] : b1[i];
                q0[i] = qv[k][i] * __expf(bt[i]); q1[i] = qv[k][i] * __expf(bt[i] - b1[i]);
                kh[i] = kv[k][i] * __expf(bj1 - bt[i]); kp[i] = kv[k][i] * __expf(fminf(bj - bt[i], 80.f)); k2[i] = kv[k][i] * __expf(bl[i] - bt[i]); }
            const v4u w0 = {pk2(q0[0], q0[1]), pk2(q0[2], q0[3]), pk2(q0[4], q0[5]), pk2(q0[6], q0[7])};
            *(LAS v4u*)(L + OFF_QH0 + t * LQ + d8 * 2) = w0; *(GAS v4u*)(QH + (row0 + t) * 1024 + h * 128 + d8) = w0;
            if (J) *(LAS v4u*)(L + OFF_QH1 + (t - 32) * LQ + d8 * 2) = (v4u){pk2(q1[0], q1[1]), pk2(q1[2], q1[3]), pk2(q1[4], q1[5]), pk2(q1[6], q1[7])};
            *(LAS v4u*)(L + OFF_KH + t * LQ + d8 * 2) = (v4u){pk2(kh[0], kh[1]), pk2(kh[2], kh[3]), pk2(kh[4], kh[5]), pk2(kh[6], kh[7])};
            *(LAS v4u*)(L + OFF_KP + t * LQ + d8 * 2) = (v4u){pk2(kp[0], kp[1]), pk2(kp[2], kp[3]), pk2(kp[4], kp[5]), pk2(kp[6], kp[7])};
#pragma unroll
            for (int i = 0; i < 8; ++i) *(LAS bf16*)(L + OFF_K2T + (d8 + i) * LT + t * 2) = (bf16)f2bf(k2[i]);
        }
        __syncthreads();
        { const int I = wave >> 2, dvb = wave & 3;
            f32x16 od;
#pragma unroll
            for (int i = 0; i < 16; ++i) od[i] = 0.f;
            const LAS unsigned char* vrow = L + OFF_VT + (32 * dvb + r32) * LT;
            if (I == 0) {
                f32x16 x = xblock(L + OFF_KP, L + OFF_QH0, r32, hi);
#pragma unroll
                for (int i = 0; i < 16; ++i) x[i] = (crow(i, hi) <= r32) ? x[i] : 0.f;
                xtv(od, x, vrow, hi);
            } else {
                f32x16 x = xblock(L + OFF_KH, L + OFF_QH1, r32, hi);
                xtv(od, x, vrow, hi);
                x = xblock(L + OFF_KP + 32 * LQ, L + OFF_QH1, r32, hi);
#pragma unroll
                for (int i = 0; i < 16; ++i) x[i] = (crow(i, hi) <= r32) ? x[i] : 0.f;
                xtv(od, x, vrow + 64, hi);
            }
            float* op = OI + (row0 + 32 * I) * 1024 + h * 128 + 32 * dvb + r32;
#pragma unroll
            for (int i = 0; i < 16; ++i) op[(size_t)crow(i, hi) * 1024] = od[i];
#pragma unroll
            for (int e = 0; e < 2; ++e) { const int dvb2 = wave >> 1, dkb = 2 * (wave & 1) + e;
                f32x16 uacc;
#pragma unroll
                for (int i = 0; i < 16; ++i) uacc[i] = 0.f;
#pragma unroll
                for (int st = 0; st < 4; ++st) { const bf16x8 va = *(const LAS bf16x8*)(L + OFF_VT + (32 * dvb2 + r32) * LT + (16 * st + 8 * hi) * 2), kb = *(const LAS bf16x8*)(L + OFF_K2T + (32 * dkb + r32) * LT + (16 * st + 8 * hi) * 2);
                    uacc = __builtin_amdgcn_mfma_f32_32x32x16_bf16(va, kb, uacc, 0, 0, 0); }
                bf16* up = UT + (size_t)u * 16384 + (size_t)(32 * dvb2) * 128 + 32 * dkb + r32;
#pragma unroll
                for (int i = 0; i < 16; ++i) up[crow(i, hi) * 128] = (bf16)f2bf(uacc[i]);
            }
        }
        __syncthreads();
    }
}
__device__ __forceinline__ void phase_hgrn2(Frame& F, KA a, int l) {
    LAS unsigned char* L = F.lds; constexpr int LS = 272; LAS float* OB = (LAS float*)(L + 36864); LAS float* DECS = (LAS float*)(L + 69632); LAS unsigned char* QS = L + 70656;
    const bf16* proj = (const bf16*)(a->ws + WS_PROJ); bf16* mix = (bf16*)(a->ws + WS_MIX);
    const float* OI = (const float*)(a->ws + WS_HOI); const bf16* UT = (const bf16*)(a->ws + WS_HUT); const bf16* QH = (const bf16*)(a->ws + WS_HQH); const float* DEC = (const float*)(a->ws + WS_HDEC);
    const float* gn = a->in[12] + l * 128;
    const int tid = F.tid, lane = F.lane, r32 = lane & 31, hi = lane >> 5, wave = F.wave;
    const int dv = tid >> 2, dkq = tid & 3, I = wave >> 2, dvb = wave & 3, tn = tid >> 3, d16 = (tid & 7) * 16;
    for (int u = F.bid; u < BATCH * 8; u += F.G) {
        const int b = u >> 3, h = u & 7;
        float S[32];
#pragma unroll
        for (int i = 0; i < 32; ++i) S[i] = 0.f;
#pragma unroll
        for (int i = 0; i < 4; ++i) *(LAS v4u*)(L + dv * LS + (32 * dkq + 8 * i) * 2) = (v4u){0u, 0u, 0u, 0u};
        v4u qn0, qn1, g0, g1, uw[4]; f32x4 oi[4]; float dn = 0.f;
#define H2_ROWQ(c) (QH + ((size_t)b * T + 64 * (c) + tn) * 1024 + h * 128 + d16)
#define H2_LDQ(c) do { qn0 = *(const GAS v4u*)(H2_ROWQ(c)); qn1 = *(const GAS v4u*)(H2_ROWQ(c) + 8); if (tid < 128) dn = DEC[((size_t)u * 32 + (c)) * 128 + tid]; } while (0)
#define H2_STQ(c) do { *(LAS v4u*)(QS + ((c) & 1) * (64 * LS) + tn * LS + d16 * 2) = qn0; *(LAS v4u*)(QS + ((c) & 1) * (64 * LS) + tn * LS + d16 * 2 + 16) = qn1; if (tid < 128) DECS[((c) & 1) * 128 + tid] = dn; } while (0)
#define H2_LDN(c) do { const size_t row_ = (size_t)b * T + 64 * (c) + tn; \
            _Pragma("unroll") for (int i = 0; i < 4; ++i) oi[i] = *(const GAS f32x4*)(OI + row_ * 1024 + h * 128 + d16 + 4 * i); \
            g0 = *(const GAS v4u*)(proj + row_ * NPROJ_P + C_HG + h * 128 + d16); g1 = *(const GAS v4u*)(proj + row_ * NPROJ_P + C_HG + h * 128 + d16 + 8); } while (0)
#define H2_LDU(c) do { _Pragma("unroll") for (int i = 0; i < 4; ++i) uw[i] = *(const GAS v4u*)(UT + ((size_t)u * 32 + (c)) * 16384 + (size_t)dv * 128 + 32 * dkq + 8 * i); } while (0)
        H2_LDQ(0); H2_LDN(0); H2_LDU(0); H2_STQ(0);
#pragma unroll 1
        for (int c = 0; c < 32; ++c) {
            const size_t row0 = (size_t)b * T + 64 * c;
            if (c + 1 < 32) H2_LDQ(c + 1);
            __syncthreads();
            f32x16 acc;
#pragma unroll
            for (int i = 0; i < 16; ++i) acc[i] = 0.f;
            const LAS unsigned char* qs = QS + (c & 1) * (64 * LS) + (32 * I + r32) * LS + 16 * hi;
#pragma unroll
            for (int st = 0; st < 8; ++st) { const bf16x8 qa = *(const LAS bf16x8*)(qs + 32 * st), sb = *(const LAS bf16x8*)(L + (32 * dvb + r32) * LS + (16 * st + 8 * hi) * 2);
                acc = __builtin_amdgcn_mfma_f32_32x32x16_bf16(qa, sb, acc, 0, 0, 0); }
#pragma unroll
            for (int i = 0; i < 16; ++i) OB[(32 * I + hg::crow(i, hi)) * 128 + 32 * dvb + r32] = acc[i];
            __syncthreads();
            {
                const size_t row = row0 + tn; float ov[16]; float ss = 0.f;
#pragma unroll
                for (int i = 0; i < 4; ++i) { const f32x4 o4 = *(const LAS f32x4*)(OB + tn * 128 + d16 + 4 * i) + oi[i]; ov[4 * i] = o4.x; ov[4 * i + 1] = o4.y; ov[4 * i + 2] = o4.z; ov[4 * i + 3] = o4.w; ss += (o4.x * o4.x + o4.y * o4.y) + (o4.z * o4.z + o4.w * o4.w); }
                ss += swz<1>(ss); ss += swz<2>(ss); ss += swz<4>(ss);
                const float r = __builtin_amdgcn_rsqf(ss * (1.0f / 128.0f) + EPS);
                const float xg[16] = {blo(g0.x), bhi(g0.x), blo(g0.y), bhi(g0.y), blo(g0.z), bhi(g0.z), blo(g0.w), bhi(g0.w), blo(g1.x), bhi(g1.x), blo(g1.y), bhi(g1.y), blo(g1.z), bhi(g1.z), blo(g1.w), bhi(g1.w)};
                unsigned pw[8];
#pragma unroll
                for (int i = 0; i < 8; ++i) pw[i] = pk2(ov[2 * i] * r * gn[d16 + 2 * i] * siluf(xg[2 * i]), ov[2 * i + 1] * r * gn[d16 + 2 * i + 1] * siluf(xg[2 * i + 1]));
                *(GAS v4u*)(mix + row * 2048 + 1024 + h * 128 + d16) = (v4u){pw[0], pw[1], pw[2], pw[3]}; *(GAS v4u*)(mix + row * 2048 + 1024 + h * 128 + d16 + 8) = (v4u){pw[4], pw[5], pw[6], pw[7]};
            }
            if (c + 1 < 32) H2_LDN(c + 1);
            {
                const LAS float* dcs = DECS + (c & 1) * 128 + 32 * dkq;
#pragma unroll
                for (int i = 0; i < 4; ++i) { const unsigned ww[4] = {uw[i].x, uw[i].y, uw[i].z, uw[i].w};
                    const f32x4 d0 = *(const LAS f32x4*)(dcs + 8 * i), d1 = *(const LAS f32x4*)(dcs + 8 * i + 4); const float dcf[8] = {d0.x, d0.y, d0.z, d0.w, d1.x, d1.y, d1.z, d1.w};
#pragma unroll
                    for (int q = 0; q < 4; ++q) { S[8 * i + 2 * q] = dcf[2 * q] * S[8 * i + 2 * q] + blo(ww[q]); S[8 * i + 2 * q + 1] = dcf[2 * q + 1] * S[8 * i + 2 * q + 1] + bhi(ww[q]); }
                    *(LAS v4u*)(L + dv * LS + (32 * dkq + 8 * i) * 2) = (v4u){pk2(S[8 * i], S[8 * i + 1]), pk2(S[8 * i + 2], S[8 * i + 3]), pk2(S[8 * i + 4], S[8 * i + 5]), pk2(S[8 * i + 6], S[8 * i + 7])}; }
            }
            if (c + 1 < 32) { H2_LDU(c + 1); H2_STQ(c + 1); }
        }
#undef H2_ROWQ
#undef H2_LDQ
#undef H2_STQ
#undef H2_LDN
#undef H2_LDU
        __syncthreads();
    }
}

__device__ __forceinline__ void phase_norm_router(Frame& F, KA a, const float* src, bf16* dst) {
    LAS int* lcnt = (LAS int*)(F.lds); LAS int* lbase = (LAS int*)(F.lds + 64); LAS int* stash = (LAS int*)(F.lds + 128);
    float* rstd2 = (float*)(a->ws + WS_TAB + TAB_RSTD2); int* toke = (int*)(a->ws + WS_TAB + TAB_TOKE); int* tokpos = (int*)(a->ws + WS_TAB + TAB_TOKPOS); float* tokp = (float*)(a->ws + WS_TAB + TAB_TOKP);
    unsigned* gcnt = (unsigned*)(a->ws + WS_CTL) + CW_ECNT;
    const float* gain = a->in[3] + 2048; const float* wr = a->in[19];
    const int lane = F.lane;
    for (int chunk = F.bid; chunk < M / 64; chunk += F.G) {
        if (F.tid < 8) lcnt[F.tid] = 0;
        __syncthreads();
#pragma unroll 1
        for (int rr = 0; rr < 8; ++rr) {
            const int lrow = F.wave * 8 + rr; const size_t row = (size_t)chunk * 64 + lrow;
            const GAS f32x4* xr = (const GAS f32x4*)(src + row * D) + lane;
            f32x4 v[8]; float s = 0.f;
#pragma unroll
            for (int jj = 0; jj < 8; ++jj) { v[jj] = xr[64 * jj]; s += (v[jj].x * v[jj].x + v[jj].y * v[jj].y) + (v[jj].z * v[jj].z + v[jj].w * v[jj].w); }
            s = wave_sum(s); const float r = 1.0f / sqrtf(s * (1.0f / D) + EPS);
            GAS v2u* o8 = (GAS v2u*)(dst + row * D) + lane;
            float lg[8] = {0.f, 0.f, 0.f, 0.f, 0.f, 0.f, 0.f, 0.f};
#pragma unroll
            for (int jj = 0; jj < 8; ++jj) { v2u w; w.x = pk2(v[jj].x, v[jj].y); w.y = pk2(v[jj].z, v[jj].w); o8[64 * jj] = w;
                const int d0 = 4 * lane + 256 * jj; const f32x4 g4 = *(const GAS f32x4*)(gain + d0);
                const float xg[4] = {v[jj].x * g4.x, v[jj].y * g4.y, v[jj].z * g4.z, v[jj].w * g4.w};
#pragma unroll
                for (int q = 0; q < 4; ++q) { const f32x4 wa = *(const GAS f32x4*)(wr + (size_t)(d0 + q) * 8), wb = *(const GAS f32x4*)(wr + (size_t)(d0 + q) * 8 + 4);
                    lg[0] += xg[q] * wa.x; lg[1] += xg[q] * wa.y; lg[2] += xg[q] * wa.z; lg[3] += xg[q] * wa.w; lg[4] += xg[q] * wb.x; lg[5] += xg[q] * wb.y; lg[6] += xg[q] * wb.z; lg[7] += xg[q] * wb.w; } }
#pragma unroll
            for (int e = 0; e < 8; ++e) lg[e] = wave_sum(lg[e]) * r;
            int e0 = 0; float v0 = lg[0];
#pragma unroll
            for (int e = 1; e < 8; ++e) if (lg[e] > v0) { v0 = lg[e]; e0 = e; }
            int e1 = -1; float v1 = -INFINITY;
#pragma unroll
            for (int e = 0; e < 8; ++e) if (e != e0 && lg[e] > v1) { v1 = lg[e]; e1 = e; }
            const float p0 = 1.0f / (1.0f + __expf(v1 - v0)), p1 = 1.0f - p0;
            if (lane == 0) { rstd2[row] = r; const int lp0 = atomicAdd((int*)lcnt + e0, 1), lp1 = atomicAdd((int*)lcnt + e1, 1);
                stash[lrow * 4] = e0; stash[lrow * 4 + 1] = e1; stash[lrow * 4 + 2] = lp0; stash[lrow * 4 + 3] = lp1; tokp[row * 2] = p0; tokp[row * 2 + 1] = p1; }
        }
        __syncthreads();
        if (F.tid < 8) lbase[F.tid] = (int)__hip_atomic_fetch_add(gcnt + F.tid, (unsigned)lcnt[F.tid], __ATOMIC_RELAXED, __HIP_MEMORY_SCOPE_AGENT);
        __syncthreads();
        if (F.tid < 64) { const size_t row = (size_t)chunk * 64 + F.tid; const int e0 = stash[F.tid * 4], e1 = stash[F.tid * 4 + 1];
            toke[row * 2] = e0; toke[row * 2 + 1] = e1; tokpos[row * 2] = lbase[e0] + stash[F.tid * 4 + 2]; tokpos[row * 2 + 1] = lbase[e1] + stash[F.tid * 4 + 3]; }
        __syncthreads();
    }
}
struct ExpTab { int t[9]; };
__device__ __forceinline__ void load_exptab(KA a, int (&off)[9]) {
    const unsigned* gcnt = (const unsigned*)(a->ws + WS_CTL) + CW_ECNT;
    off[0] = 0;
#pragma unroll
    for (int e = 0; e < 8; ++e) { const unsigned c = __hip_atomic_load(gcnt + e, __ATOMIC_RELAXED, __HIP_MEMORY_SCOPE_AGENT); off[e + 1] = off[e] + (int)((c + 255u) >> 8); }
}
__device__ __forceinline__ void phase_gather(Frame& F, KA a) {
    int off[9]; load_exptab(a, off);
    const bf16* hb = (const bf16*)(a->ws + WS_HB); bf16* hs = (bf16*)(a->ws + WS_HSX);
    const float* rstd2 = (const float*)(a->ws + WS_TAB + TAB_RSTD2); float* rstds = (float*)(a->ws + WS_TAB + TAB_RSTDS);
    const int* toke = (const int*)(a->ws + WS_TAB + TAB_TOKE); const int* tokpos = (const int*)(a->ws + WS_TAB + TAB_TOKPOS); int* tokdest = (int*)(a->ws + WS_TAB + TAB_TOKDEST);
    const int gw = F.bid * NWAVES + F.wave, NGW = F.G * NWAVES;
    for (int pair = gw; pair < 2 * M; pair += NGW) {
        const int tok = pair >> 1; const int e = toke[pair], pos = tokpos[pair];
        int o = off[0];
#pragma unroll
        for (int q = 1; q < 8; ++q) o = (e == q) ? off[q] : o;
        const int dest = o * 256 + pos;
        const GAS v4u* s = (const GAS v4u*)(hb + (size_t)tok * D) + F.lane; GAS v2u* dd = (GAS v2u*)((unsigned char*)hs + (size_t)dest * D) + F.lane;
#pragma unroll
        for (int jj = 0; jj < 4; ++jj) { const v4u w = s[64 * jj]; unsigned w0 = 0u, w1 = 0u;
            w0 = __builtin_amdgcn_cvt_pk_fp8_f32(blo(w.x), bhi(w.x), w0, false); w0 = __builtin_amdgcn_cvt_pk_fp8_f32(blo(w.y), bhi(w.y), w0, true);
            w1 = __builtin_amdgcn_cvt_pk_fp8_f32(blo(w.z), bhi(w.z), w1, false); w1 = __builtin_amdgcn_cvt_pk_fp8_f32(blo(w.w), bhi(w.w), w1, true);
            dd[64 * jj] = (v2u){w0, w1}; }
        if (F.lane == 0) { rstds[dest] = rstd2[tok]; tokdest[pair] = dest; }
    }
}
__device__ __forceinline__ void phase_combine(Frame& F, KA a) {
    const float* y = (const float*)(a->ws + WS_Y); const int* tokdest = (const int*)(a->ws + WS_TAB + TAB_TOKDEST); const float* tokp = (const float*)(a->ws + WS_TAB + TAB_TOKP);
    const int gw = F.bid * NWAVES + F.wave, NGW = F.G * NWAVES;
    for (int row = gw; row < M; row += NGW) {
        const int d0 = tokdest[2 * row], d1 = tokdest[2 * row + 1]; const float p0 = tokp[2 * row], p1 = tokp[2 * row + 1];
        GAS f32x4* o = (GAS f32x4*)(a->out + (size_t)row * D) + F.lane; const GAS f32x4* y0 = (const GAS f32x4*)(y + (size_t)d0 * D) + F.lane; const GAS f32x4* y1 = (const GAS f32x4*)(y + (size_t)d1 * D) + F.lane;
#pragma unroll
        for (int jj = 0; jj < 8; ++jj) o[64 * jj] = o[64 * jj] + y0[64 * jj] * p0 + y1[64 * jj] * p1;
    }
}

#ifndef MK_ONE_LAUNCH
#define MK_ONE_LAUNCH 1
#endif
constexpr int PH_PER_LAYER = 16, NPHASE = 2 * PH_PER_LAYER;
constexpr int CONV_GG = 171;
__global__ void __launch_bounds__(NWAVES * 64, 2) mk_fwd(Args args) {
    extern __shared__ __attribute__((aligned(16))) unsigned char lds[];
    LAS unsigned char* const ldsb = (LAS unsigned char*)lds;
    const int wave_s = __builtin_amdgcn_readfirstlane(threadIdx.x >> 6);
    for (int u = threadIdx.x; u < (LDS_BYTES - LDSCTL_OFF) / 4; u += NWAVES * 64) ((LAS unsigned*)(ldsb + LDSCTL_OFF))[u] = 0u;
    __syncthreads();
    XcdBarrier bar; bar.bar = nullptr; bar.x = 0; bar.st = nullptr;
    if (MK_ONE_LAUNCH) { KA a = ka_get(); bar = xcd_barrier_post((unsigned*)(a->ws + WS_CTL) + CW_BAR, (volatile LAS unsigned*)(ldsb + MISC_OFF) + 8); }
    const int lo = args.ph_lo, hi = args.ph_hi;
#define IN(k) in_range((k), lo, hi)
#define SEAM(k) do { if (MK_ONE_LAUNCH && IN(k) && IN((k) + 1)) { XcdBarrier b2_ = bar; asm volatile("" : "+s"(b2_.bar)); xcd_barrier(b2_); } } while (0)
#pragma unroll 1
    for (int l = 0; l < 2; ++l) {
        const int pb = l * PH_PER_LAYER;
        if (IN(pb + 0)) { KA a = ka_get(); Frame F = make_frame(ldsb, wave_s); unsigned char* ws = a->ws; if (l == 0) phase_conv(F, a, 0, F.G == 256 ? 1 : 16, F.bid, F.G);
            phase_norm(F, (l == 0) ? a->in[0] : (const float*)(ws + WS_H), (bf16*)(ws + WS_XB), (float*)(ws + WS_RSTD1)); }
        SEAM(pb + 0);
        if (IN(pb + 1)) { KA a = ka_get(); Frame F = make_frame(ldsb, wave_s); unsigned char* ws = a->ws;
            const bool split = (l == 0 && F.G == 256);
            const int Gv = split ? CONV_GG : F.G;
            if (F.bid < Gv) {
                pg8::Gemm g{(const bf16*)(ws + WS_XB), (const bf16*)(ws + WS_WIN + l * WIN_SZ), M, NPROJ_P, D, D, F.tid, 0, 0}; pg8::StaticOrder S; S.init(M, F.G == 256 ? NPROJ_P - 256 : NPROJ_P, Gv, F.bid);
                pg8::EpiScaleBf16 E{(bf16*)(ws + WS_PROJ), NPROJ_P, (const float*)(ws + WS_RSTD1)};
                pg8::gemm_phase<pg8::EpiScaleBf16, pg8::StaticOrder, true, true>(F.lds + RING_OFF, g, S, E);
            } else phase_conv(F, a, 1, 16, F.bid - CONV_GG, F.G - CONV_GG);
        }
        SEAM(pb + 1);
        if (IN(pb + 2)) { KA a = ka_get(); Frame F = make_frame(ldsb, wave_s); phase_post(F, a, l); }
        SEAM(pb + 2);
        if (IN(pb + 3)) { KA a = ka_get(); Frame F = make_frame(ldsb, wave_s); unsigned char* ws = a->ws;
            pg8::Gemm g{(const bf16*)(ws + WS_PROJ) + C_CQ, (const bf16*)(ws + WS_WIDX + l * WIDX_SZ), M, 1024, 512, NPROJ_P, F.tid, 0, 0}; pg8::StaticOrder S; S.init(M, 1024, F.G, F.bid);
            pg8::EpiScaleBf16 E{(bf16*)(ws + WS_QIDX), 1024, (const float*)(ws + WS_RSTDCQ)};
            pg8::gemm_phase<pg8::EpiScaleBf16, pg8::StaticOrder, true, true>(F.lds + RING_OFF, g, S, E);
        }
        SEAM(pb + 3);
        if (IN(pb + 4)) { KA a = ka_get(); Frame F = make_frame(ldsb, wave_s); phase_index2(F, a); }
        SEAM(pb + 4);
        if (IN(pb + 5)) { KA a = ka_get(); Frame F = make_frame(ldsb, wave_s); phase_attn2(F, a); }
        SEAM(pb + 5);
        if (IN(pb + 6)) { KA a = ka_get(); Frame F = make_frame(ldsb, wave_s); phase_hgrn1(F, a, l); }
        SEAM(pb + 6);
        if (IN(pb + 7)) { KA a = ka_get(); Frame F = make_frame(ldsb, wave_s); unsigned char* ws = a->ws;
            const bool split = F.G >= 128;
            if (!split || F.bid < 64) phase_hgrn2(F, a, l);
            if (!split || F.bid >= 64) {
                pg8::Gemm g{(const bf16*)(ws + WS_MIX), (const bf16*)(ws + WS_WUA + l * WU_SZ), M, D, 1024, D, F.tid, 0, 0}; pg8::StaticOrder S; S.init(M, D, split ? F.G - 64 : F.G, split ? F.bid - 64 : F.bid);
                pg8::EpiGate<0> E{(float*)(ws + WS_TMP), nullptr, D, (const bf16*)(ws + WS_PROJ) + C_GA, NPROJ_P};
                pg8::gemm_phase<pg8::EpiGate<0>, pg8::StaticOrder, true, true>(F.lds + RING_OFF, g, S, E);
            }
            if (F.G == 256 && F.bid >= 192) {
                pg8::Gemm g{(const bf16*)(ws + WS_XB), (const bf16*)(ws + WS_WIN + l * WIN_SZ), M, NPROJ_P, D, D, F.tid, 0, 0}; pg8::OneUnit S{F.bid - 192, NPROJ_P / 256 - 1, true};
                pg8::EpiScaleBf16 E{(bf16*)(ws + WS_PROJ), NPROJ_P, (const float*)(ws + WS_RSTD1)};
                pg8::gemm_phase<pg8::EpiScaleBf16, pg8::OneUnit, true, true>(F.lds + RING_OFF, g, S, E);
            }
        }
        SEAM(pb + 7);
        if (IN(pb + 9)) { KA a = ka_get(); Frame F = make_frame(ldsb, wave_s); unsigned char* ws = a->ws;
            pg8::Gemm g{(const bf16*)(ws + WS_MIX) + 1024, (const bf16*)(ws + WS_WUH + l * WU_SZ), M, D, 1024, D, F.tid, 0, 0}; pg8::StaticOrder S; S.init(M, D, F.G, F.bid);
            pg8::EpiGate<1> E{(float*)(ws + WS_TMP), (bf16*)(ws + WS_MRG), D, (const bf16*)(ws + WS_PROJ) + C_GH, NPROJ_P};
            pg8::gemm_phase<pg8::EpiGate<1>, pg8::StaticOrder, true, true>(F.lds + RING_OFF, g, S, E);
        }
        SEAM(pb + 9);
        if (IN(pb + 10)) { KA a = ka_get(); Frame F = make_frame(ldsb, wave_s); unsigned char* ws = a->ws;
            pg8::Gemm g{(const bf16*)(ws + WS_MRG), (const bf16*)(ws + WS_WO + l * WO_SZ), M, D, D, D, F.tid, 0, 0}; pg8::StaticOrder S; S.init(M, D, F.G, F.bid);
            pg8::EpiResF32 E{(l == 0) ? a->in[0] : (const float*)(ws + WS_H), (l == 0) ? (float*)(ws + WS_H) : a->out, D, 1 << 20};
            pg8::gemm_phase<pg8::EpiResF32, pg8::StaticOrder, true, true>(F.lds + RING_OFF, g, S, E);
        }
        SEAM(pb + 10);
        if (IN(pb + 11)) { KA a = ka_get(); Frame F = make_frame(ldsb, wave_s); unsigned char* ws = a->ws;
            if (l == 0) phase_norm(F, (const float*)(ws + WS_H), (bf16*)(ws + WS_HB), (float*)(ws + WS_TAB + TAB_RSTD2)); else phase_norm_router(F, a, a->out, (bf16*)(ws + WS_HB)); }
        SEAM(pb + 11);
        if (l == 0) {
            if (IN(pb + 12)) { KA a = ka_get(); Frame F = make_frame(ldsb, wave_s); unsigned char* ws = a->ws;
                pg8::Gemm g{(const bf16*)(ws + WS_HB), (const bf16*)(ws + WS_W13D), M, 2 * FFD, D, D, F.tid, 0, 0}; pg8::StaticOrder S; S.init(M, 2 * FFD, F.G, F.bid);
                pg8::EpiSwiGLU E{(bf16*)(ws + WS_PROJ), FFD, 1 << 20, (const float*)(ws + WS_TAB + TAB_RSTD2)};
                pg8::gemm_phase<pg8::EpiSwiGLU, pg8::StaticOrder, true, true>(F.lds + RING_OFF, g, S, E);
            }
            SEAM(pb + 12);
            if (IN(pb + 13)) { KA a = ka_get(); Frame F = make_frame(ldsb, wave_s); unsigned char* ws = a->ws;
                pg8::Gemm g{(const bf16*)(ws + WS_PROJ), (const bf16*)(ws + WS_W2D), M, D, FFD, FFD, F.tid, 0, 0}; pg8::StaticOrder S; S.init(M, D, F.G, F.bid);
                pg8::EpiResF32 E{(const float*)(ws + WS_H), (float*)(ws + WS_H), D, 1 << 20};
                pg8::gemm_phase<pg8::EpiResF32, pg8::StaticOrder, true, true>(F.lds + RING_OFF, g, S, E);
            }
            SEAM(pb + 13);
        } else {
            if (IN(pb + 12)) { KA a = ka_get(); Frame F = make_frame(ldsb, wave_s); phase_gather(F, a); }
            SEAM(pb + 12);
            if (IN(pb + 13)) { KA a = ka_get(); Frame F = make_frame(ldsb, wave_s); unsigned char* ws = a->ws;
                int off[9]; load_exptab(a, off);
                pg8::Gemm g{(const bf16*)(ws + WS_HSX), (const bf16*)(ws + WS_W13M), MS, 2 * FFE, D / 2, D / 2, F.tid, 0x7f7f7f7f, 0x79797979};
                pg8::MoeOrder S{F.G, F.bid, 2 * FFE / 256, off[0], off[1], off[2], off[3], off[4], off[5], off[6], off[7], off[8]};
                pg8::EpiSwiGLUT<true> E{(bf16*)(ws + WS_ACTM), FFE, 2 * FFE / 256, (const float*)(ws + WS_TAB + TAB_RSTDS)};
                pg8::gemm_phase<pg8::EpiSwiGLUT<true>, pg8::MoeOrder, true, true, true>(F.lds + RING_OFF, g, S, E);
            }
            SEAM(pb + 13);
            if (IN(pb + 14)) { KA a = ka_get(); Frame F = make_frame(ldsb, wave_s); unsigned char* ws = a->ws;
                int off[9]; load_exptab(a, off);
                pg8::Gemm g{(const bf16*)(ws + WS_ACTM), (const bf16*)(ws + WS_W2M), MS, D, FFE / 2, FFE / 2, F.tid, 0x7c7c7c7c, 0x79797979};
                pg8::MoeOrder S{F.G, F.bid, D / 256, off[0], off[1], off[2], off[3], off[4], off[5], off[6], off[7], off[8]};
                pg8::EpiResF32 E{nullptr, (float*)(ws + WS_Y), D, D / 256};
                pg8::gemm_phase<pg8::EpiResF32, pg8::MoeOrder, true, true, true>(F.lds + RING_OFF, g, S, E);
            }
            SEAM(pb + 14);
            if (IN(pb + 15)) { KA a = ka_get(); Frame F = make_frame(ldsb, wave_s); phase_combine(F, a); }
        }
    }
#undef IN
#undef SEAM
}

extern "C" void kernel_launch(void* const* d_in, const int* in_sizes, int n_in, void* d_out, int out_size, void* d_ws, size_t ws_size, hipStream_t stream) {
    static int grid = 0;
    if (grid == 0) {
        if (n_in != 23 || out_size != M * D || ws_size < WS_END) { fprintf(stderr, "kernel_launch: unexpected shapes (n_in %d out %d ws %zu need %zu)\n", n_in, out_size, ws_size, (size_t)WS_END); grid = -1; return; }
        int dev = 0, cus = 0, per_cu = 0;
        if (hipGetDevice(&dev) != hipSuccess || hipDeviceGetAttribute(&cus, hipDeviceAttributeMultiprocessorCount, dev) != hipSuccess) { grid = -1; return; }
        if (hipFuncSetAttribute((const void*)mk_fwd, hipFuncAttributeMaxDynamicSharedMemorySize, LDS_BYTES) != hipSuccess) { fprintf(stderr, "kernel_launch: hipFuncSetAttribute failed\n"); grid = -1; return; }
        if (hipOccupancyMaxActiveBlocksPerMultiprocessor(&per_cu, (const void*)mk_fwd, NWAVES * 64, LDS_BYTES) != hipSuccess || per_cu < 1) fprintf(stderr, "kernel_launch: occupancy query says %d\n", per_cu);
        (void)hipGetLastError();
        grid = cus;
    }
    if (grid < 0) return;
    (void)hipMemsetAsync((char*)d_ws + WS_CTL, 0, CTL_ZERO_BYTES, stream);
    Args a{};
    for (int i = 0; i < 23; ++i) a.in[i] = (const float*)d_in[i];
    a.out = (float*)d_out; a.ws = (unsigned char*)d_ws;
#if MK_ONE_LAUNCH
    a.ph_lo = 0; a.ph_hi = NPHASE;
    hipLaunchKernelGGL(mk_fwd, dim3(grid), dim3(NWAVES * 64), LDS_BYTES, stream, a);
#else
    for (int p = 0; p < NPHASE; ++p) {
        if (p == 14 || p == 15) continue;
        a.ph_lo = p; a.ph_hi = p + 1;
        hipLaunchKernelGGL(mk_fwd, dim3(grid), dim3(NWAVES * 64), LDS_BYTES, stream, a);
    }
#endif
}
```

```cpp
#include <hip/hip_runtime.h>
#include <cstdio>
#include <cstdint>
namespace pg8 {
#define PG8_LAS __attribute__((address_space(3)))
typedef unsigned short bf16_t;
typedef short bf16x8 __attribute__((ext_vector_type(8)));
typedef float f32x4 __attribute__((ext_vector_type(4)));
typedef unsigned u32x4 __attribute__((ext_vector_type(4)));
typedef int i32x8 __attribute__((ext_vector_type(8)));
constexpr int BM = 256, BK = 64, HALF = 128, HTB = HALF * BK * 2  , STAGE_BYTES = 8 * HTB, NXCD = 8, WGM = 8;

__host__ __device__ __forceinline__ int lds_byte(int r, int c) { const int st = (r >> 4) * 2 + (c >> 5), rr = r & 15, cc = c & 31, ob = rr * 64 + cc * 2; return st * 1024 + (ob ^ (((ob >> 9) & 1) << 5)); }
__host__ __device__ __forceinline__ void stage_rc(int b, int& R, int& C) { const int st = b / 1024, sb = b % 1024, swz = sb ^ (((sb >> 9) & 1) << 5); R = (st >> 1) * 16 + swz / 64; C = (st & 1) * 32 + (swz % 64) / 2; }
__host__ __device__ __forceinline__ int perm32(int rho) { const int n = rho >> 4, i = rho & 15; return 8 * (i >> 2) + 4 * n + (i & 3); }

struct Unit { int pm, pn; };
struct Gemm { const bf16_t* A; const bf16_t* Bt; int M, N, K, lda, tid; int scaleA, scaleB; };

struct StaticOrder {
    int nM, nN, nwg, G, c;
    __host__ __device__ void init(int M, int N, int G_, int c_) { nM = M / BM; nN = N / BM; nwg = nM * nN; G = G_; c = c_; }
    __host__ __device__ bool next(int i, Unit& u) const {
        const long L = (long)i * G + c; if (L >= nwg) return false;
        int wgid = (int)L; { const int q = nwg / NXCD, r = nwg % NXCD, xcd = wgid % NXCD, off = wgid / NXCD; wgid = (xcd < r ? xcd * (q + 1) : r * (q + 1) + (xcd - r) * q) + off; }
        const int nig = WGM * nN, gid = wgid / nig, fm = gid * WGM, gsz = (nM - fm) < WGM ? (nM - fm) : WGM;
        u.pm = fm + ((wgid % nig) % gsz); u.pn = (wgid % nig) / gsz; return true;
    }
    __device__ __forceinline__ void a_ready(const Unit&) const {}
    __device__ __forceinline__ void done(const Unit&) const {}
};

__device__ __forceinline__ unsigned cvt_pk_bf16(float lo, float hi) { unsigned r; asm volatile("v_cvt_pk_bf16_f32 %0, %1, %2" : "=v"(r) : "v"(lo), "v"(hi)); return r; }
__device__ __forceinline__ float bflo(unsigned w) { return __builtin_bit_cast(float, w << 16); }
__device__ __forceinline__ float bfhi(unsigned w) { return __builtin_bit_cast(float, w & 0xffff0000u); }
__device__ __forceinline__ float sigm(float x) { return __builtin_amdgcn_rcpf(1.0f + __builtin_amdgcn_exp2f(-1.4426950408889634f * x)); }
__device__ __forceinline__ float silu(float x) { return x * __builtin_amdgcn_rcpf(1.0f + __builtin_amdgcn_exp2f(-1.4426950408889634f * x)); }

struct EpiScaleBf16 {
    static constexpr bool PERM = true, AFTER_DRAIN = false;
    bf16_t* O; int ldc; const float* rs;
    __device__ __forceinline__ void operator()(const f32x4 (&acc)[2][2][4][2], const Unit& u, int wr, int wc, int fr, int fq) const {
        const int row0 = u.pm * BM + wr * 64 + fr, col0 = u.pn * BM + wc * 32 + 8 * fq;
#pragma unroll
        for (int ai = 0; ai < 2; ++ai)
#pragma unroll
            for (int m = 0; m < 4; ++m) { const int row = row0 + ai * HALF + m * 16; const float s = rs[row]; bf16_t* rowp = O + (size_t)row * ldc + col0;
#pragma unroll
                for (int bj = 0; bj < 2; ++bj) { const f32x4 v0 = acc[ai][bj][m][0] * s, v1 = acc[ai][bj][m][1] * s;
                    u32x4 w; w.x = cvt_pk_bf16(v0[0], v0[1]); w.y = cvt_pk_bf16(v0[2], v0[3]); w.z = cvt_pk_bf16(v1[0], v1[1]); w.w = cvt_pk_bf16(v1[2], v1[3]);
                    *(u32x4*)(rowp + bj * HALF) = w; } }
    }
};
template <int MODE> struct EpiGate {
    static constexpr bool PERM = true, AFTER_DRAIN = false;
    float* C; bf16_t* O; int ldc; const bf16_t* G; int ldg;
    __device__ __forceinline__ void operator()(const f32x4 (&acc)[2][2][4][2], const Unit& u, int wr, int wc, int fr, int fq) const {
        const int row0 = u.pm * BM + wr * 64 + fr, col0 = u.pn * BM + wc * 32 + 8 * fq;
#pragma unroll
        for (int ai = 0; ai < 2; ++ai)
#pragma unroll
            for (int m = 0; m < 4; ++m) { const int row = row0 + ai * HALF + m * 16;
#pragma unroll
                for (int bj = 0; bj < 2; ++bj) { const int col = col0 + bj * HALF;
                    const u32x4 gw = *(const u32x4*)(G + (size_t)row * ldg + col);
                    f32x4 g0, g1; g0[0] = sigm(bflo(gw.x)); g0[1] = sigm(bfhi(gw.x)); g0[2] = sigm(bflo(gw.y)); g0[3] = sigm(bfhi(gw.y));
                    g1[0] = sigm(bflo(gw.z)); g1[1] = sigm(bfhi(gw.z)); g1[2] = sigm(bflo(gw.w)); g1[3] = sigm(bfhi(gw.w));
                    float* cp = C + (size_t)row * ldc + col;
                    if (MODE == 0) { *(f32x4*)cp = acc[ai][bj][m][0] * g0; *(f32x4*)(cp + 4) = acc[ai][bj][m][1] * g1; }
                    else { const f32x4 v0 = *(const f32x4*)cp + acc[ai][bj][m][0] * g0, v1 = *(const f32x4*)(cp + 4) + acc[ai][bj][m][1] * g1;
                        u32x4 w; w.x = cvt_pk_bf16(v0[0], v0[1]); w.y = cvt_pk_bf16(v0[2], v0[3]); w.z = cvt_pk_bf16(v1[0], v1[1]); w.w = cvt_pk_bf16(v1[2], v1[3]);
                        *(u32x4*)(O + (size_t)row * ldc + col) = w; } } }
    }
};
struct EpiResF32 {
    static constexpr bool PERM = true, AFTER_DRAIN = false;
    const float* res; float* out; int ldc, npn;
    __device__ __forceinline__ void operator()(const f32x4 (&acc)[2][2][4][2], const Unit& u, int wr, int wc, int fr, int fq) const {
        const int row0 = u.pm * BM + wr * 64 + fr, col0 = (u.pn % npn) * BM + wc * 32 + 8 * fq;
#pragma unroll
        for (int ai = 0; ai < 2; ++ai)
#pragma unroll
            for (int m = 0; m < 4; ++m) { const size_t off = (size_t)(row0 + ai * HALF + m * 16) * ldc + col0;
#pragma unroll
                for (int bj = 0; bj < 2; ++bj) { f32x4 v0 = acc[ai][bj][m][0], v1 = acc[ai][bj][m][1];
                    if (res) { v0 += *(const f32x4*)(res + off + bj * HALF); v1 += *(const f32x4*)(res + off + bj * HALF + 4); }
                    *(f32x4*)(out + off + bj * HALF) = v0; *(f32x4*)(out + off + bj * HALF + 4) = v1; } }
    }
};
template <bool F8OUT> struct EpiSwiGLUT {
    static constexpr bool PERM = true, AFTER_DRAIN = false;
    bf16_t* O; int ldc, npn; const float* rs;
    __device__ __forceinline__ void operator()(const f32x4 (&acc)[2][2][4][2], const Unit& u, int wr, int wc, int fr, int fq) const {
        const int row0 = u.pm * BM + wr * 64 + fr, col0 = (u.pn % npn) * HALF + wc * 32 + 8 * fq;
#pragma unroll
        for (int ai = 0; ai < 2; ++ai)
#pragma unroll
            for (int m = 0; m < 4; ++m) { const int row = row0 + ai * HALF + m * 16; const float r = rs[row];
                float o[8];
#pragma unroll
                for (int n = 0; n < 2; ++n)
#pragma unroll
                    for (int j = 0; j < 4; ++j) { const float a1 = acc[ai][0][m][n][j] * r, a3 = acc[ai][1][m][n][j] * r; o[4 * n + j] = silu(a1) * a3; }
                if constexpr (F8OUT) {
                    unsigned w0 = 0u, w1 = 0u;
#pragma unroll
                    for (int j = 0; j < 8; ++j) o[j] = __builtin_amdgcn_fmed3f(o[j] * 8.0f, -440.f, 440.f);
                    w0 = __builtin_amdgcn_cvt_pk_fp8_f32(o[0], o[1], w0, false); w0 = __builtin_amdgcn_cvt_pk_fp8_f32(o[2], o[3], w0, true);
                    w1 = __builtin_amdgcn_cvt_pk_fp8_f32(o[4], o[5], w1, false); w1 = __builtin_amdgcn_cvt_pk_fp8_f32(o[6], o[7], w1, true);
                    typedef unsigned u32x2_ __attribute__((ext_vector_type(2)));
                    *(u32x2_*)((unsigned char*)O + (size_t)row * ldc + col0) = (u32x2_){w0, w1};
                } else {
                u32x4 w; w.x = cvt_pk_bf16(o[0], o[1]); w.y = cvt_pk_bf16(o[2], o[3]); w.z = cvt_pk_bf16(o[4], o[5]); w.w = cvt_pk_bf16(o[6], o[7]);
                *(u32x4*)(O + (size_t)row * ldc + col0) = w; } }
    }
};
typedef EpiSwiGLUT<false> EpiSwiGLU;
struct OneUnit { int pm, pn; bool has;
    __device__ __forceinline__ bool next(int i, Unit& u) const { if (i > 0 || !has) return false; u.pm = pm; u.pn = pn; return true; }
    __device__ __forceinline__ void a_ready(const Unit&) const {}
    __device__ __forceinline__ void done(const Unit&) const {}
};
struct MoeOrder {
    int G, c, nN; int t0, t1, t2, t3, t4, t5, t6, t7, t8;
    __device__ __forceinline__ bool next(int i, Unit& u) const {
        const long L = (long)i * G + c; if (L >= (long)t8 * nN) return false;
        int ts = t0, te = t1;
        if (L >= (long)t1 * nN) { ts = t1; te = t2; } if (L >= (long)t2 * nN) { ts = t2; te = t3; } if (L >= (long)t3 * nN) { ts = t3; te = t4; } if (L >= (long)t4 * nN) { ts = t4; te = t5; }
        if (L >= (long)t5 * nN) { ts = t5; te = t6; } if (L >= (long)t6 * nN) { ts = t6; te = t7; } if (L >= (long)t7 * nN) { ts = t7; te = t8; }
        int e = 0; e += (L >= (long)t1 * nN); e += (L >= (long)t2 * nN); e += (L >= (long)t3 * nN); e += (L >= (long)t4 * nN); e += (L >= (long)t5 * nN); e += (L >= (long)t6 * nN); e += (L >= (long)t7 * nN);
        const int Ll = (int)(L - (long)ts * nN), Te = te - ts;
        u.pm = ts + Ll % Te; u.pn = e * nN + Ll / Te; return true;
    }
    __device__ __forceinline__ void a_ready(const Unit&) const {}
    __device__ __forceinline__ void done(const Unit&) const {}
};
template <bool FP8> struct FragT;
template <> struct FragT<false> { bf16x8 k[2]; };
template <> struct FragT<true>  { i32x8 v; };
__device__ __forceinline__ void ld_frag(FragT<false>& f, const PG8_LAS unsigned char* p, int o0, int o1) { f.k[0] = *(const PG8_LAS bf16x8*)(p + o0); f.k[1] = *(const PG8_LAS bf16x8*)(p + o1); }
__device__ __forceinline__ void ld_frag(FragT<true>& f, const PG8_LAS unsigned char* p, int o0, int o1) { const u32x4 a = *(const PG8_LAS u32x4*)(p + o0), b = *(const PG8_LAS u32x4*)(p + o1);
    f.v = (i32x8){(int)a.x, (int)a.y, (int)a.z, (int)a.w, (int)b.x, (int)b.y, (int)b.z, (int)b.w}; }
__device__ __forceinline__ f32x4 mma_frag(const FragT<false>& b, const FragT<false>& a, f32x4 c, int, int) { c = __builtin_amdgcn_mfma_f32_16x16x32_bf16(b.k[0], a.k[0], c, 0, 0, 0); return __builtin_amdgcn_mfma_f32_16x16x32_bf16(b.k[1], a.k[1], c, 0, 0, 0); }
__device__ __forceinline__ f32x4 mma_frag(const FragT<true>& b, const FragT<true>& a, f32x4 c, int sb, int sa) {
    asm volatile("v_mfma_scale_f32_16x16x128_f8f6f4 %0, %1, %2, %0, %3, %4 op_sel_hi:[0,0,0]" : "+v"(c) : "v"(b.v), "v"(a.v), "v"(sb), "v"(sa)); return c; }
template <class Epi, class Sched, bool ALIGN_EPI = false, bool SP2 = false, bool FP8 = false>
__device__ __forceinline__ void gemm_phase(PG8_LAS unsigned char* lds, const Gemm g, const Sched& S, const Epi& E) {
    const int tid = g.tid, wid = __builtin_amdgcn_readfirstlane(tid >> 6), lane = tid & 63, wr = wid >> 2, wc = wid & 3, fr = lane & 15, fq = lane >> 4;
    const int K = g.K, nt = K / BK;
    unsigned voffA[2], voffB[2];
#pragma unroll
    for (int i = 0; i < 2; ++i) { int R, C; stage_rc(tid * 16 + i * 8192, R, C); const int Rb = Epi::PERM ? ((R & ~31) + perm32(R & 31)) : R;
        voffA[i] = (unsigned)(R * g.lda + C) * 2u; voffB[i] = (unsigned)(Rb * K + C) * 2u; }
    const size_t kstep = (size_t)(BK * 2);
    const size_t hstepB = (size_t)HALF * K * 2, hstepA = (size_t)HALF * g.lda * 2;
    const size_t tstepA = 2 * hstepA, tstepB = 2 * hstepB;
    const unsigned ldsw = (unsigned)wid * 1024u;
    const int aoff = FP8 ? lds_byte(wr * 64 + fr, fq * 16) : lds_byte(wr * 64 + fr, fq * 8), boff = FP8 ? lds_byte(wc * 32 + fr, fq * 16) : lds_byte(wc * 32 + fr, fq * 8);
    const int aoff1 = FP8 ? aoff + 16 : aoff + 1024, boff1 = FP8 ? boff + 16 : boff + 1024;
    int scA = g.scaleA, scB = g.scaleB; asm volatile("" : "+v"(scA), "+v"(scB));
#define PG8_SA(b, h) (((b) * 2 + (h)) * HTB)
#define PG8_SB(b, h) ((4 + (b) * 2 + (h)) * HTB)
#define PG8_STAGE(bufoff, gbase, voff) do { _Pragma("unroll") for (int _i = 0; _i < 2; ++_i) \
        __builtin_amdgcn_global_load_lds((const unsigned*)((const char*)(gbase) + (voff)[_i]), (PG8_LAS unsigned*)(lds + (bufoff) + ldsw + _i * 8192), 16, 0, 0); } while (0)
#define PG8_LDA(dst, b, h) do { _Pragma("unroll") for (int m = 0; m < 4; ++m) ld_frag(dst[m], lds + PG8_SA(b, h) + m * 2048, aoff, aoff1); } while (0)
#define PG8_LDB(dst, b, h) do { _Pragma("unroll") for (int n = 0; n < 2; ++n) ld_frag(dst[n], lds + PG8_SB(b, h) + n * 2048, boff, boff1); } while (0)
#define PG8_MMA(ai, bj, At, Bt) do { __builtin_amdgcn_s_setprio(1); _Pragma("unroll") for (int m = 0; m < 4; ++m) _Pragma("unroll") for (int n = 0; n < 2; ++n) \
        acc[ai][bj][m][n] = mma_frag(Bt[n], At[m], acc[ai][bj][m][n], scB, scA); __builtin_amdgcn_s_setprio(0); } while (0)
#define PG8_WAIT_V(n) asm volatile("s_waitcnt vmcnt(" #n ")" ::: "memory")
#define PG8_WAIT_L(n) asm volatile("s_waitcnt lgkmcnt(" #n ")" ::: "memory")
#define PG8_BAR __builtin_amdgcn_s_barrier()
#define PG8_SCHED __builtin_amdgcn_sched_barrier(0)
    Unit cur, nxt; int ui = 0;
    if (!S.next(0, cur)) return;
    f32x4 acc[2][2][4][2];
#pragma unroll
    for (int a = 0; a < 2; ++a)
#pragma unroll
        for (int b = 0; b < 2; ++b)
#pragma unroll
            for (int m = 0; m < 4; ++m)
#pragma unroll
                for (int n = 0; n < 2; ++n) acc[a][b][m][n] = (f32x4){0.f, 0.f, 0.f, 0.f};
    FragT<FP8> At[4], B0[2], B1[2];
    const char* cA = (const char*)g.A + (size_t)cur.pm * tstepA; const char* cB = (const char*)g.Bt + (size_t)cur.pn * tstepB;
    S.a_ready(cur);
    if constexpr (SP2) {
        PG8_STAGE(PG8_SB(0, 0), cB, voffB); PG8_STAGE(PG8_SB(0, 1), cB + hstepB, voffB); PG8_STAGE(PG8_SA(0, 0), cA, voffA); PG8_STAGE(PG8_SA(0, 1), cA + hstepA, voffA);
        if (wr == 1) PG8_BAR;
        PG8_WAIT_V(2); PG8_BAR;
        PG8_STAGE(PG8_SB(1, 0), cB + kstep, voffB); PG8_STAGE(PG8_SA(1, 0), cA + kstep, voffA); PG8_STAGE(PG8_SB(1, 1), cB + hstepB + kstep, voffB);
        PG8_WAIT_V(6); PG8_BAR;
    } else {
        PG8_STAGE(PG8_SB(0, 0), cB, voffB); PG8_STAGE(PG8_SA(0, 0), cA, voffA); PG8_STAGE(PG8_SB(0, 1), cB + hstepB, voffB); PG8_STAGE(PG8_SA(0, 1), cA + hstepA, voffA);
        if (wr == 1) PG8_BAR;
        PG8_WAIT_V(4); PG8_BAR;
        PG8_STAGE(PG8_SB(1, 0), cB + kstep, voffB); PG8_STAGE(PG8_SA(1, 0), cA + kstep, voffA); PG8_STAGE(PG8_SB(1, 1), cB + hstepB + kstep, voffB);
        PG8_WAIT_V(6); PG8_BAR;
    }
    for (;;) {
        const bool has_next = S.next(ui + 1, nxt);
        const char* nA = has_next ? (const char*)g.A + (size_t)nxt.pm * tstepA : cA; const char* nB = has_next ? (const char*)g.Bt + (size_t)nxt.pn * tstepB : cB;
        for (int t = 0; t < nt; t += 2) {
            const bool last = (t == nt - 2);
            const char* a1 = cA + (size_t)(t + 1) * kstep;
            const char* a2 = last ? nA : cA + (size_t)(t + 2) * kstep; const char* b2 = last ? nB : cB + (size_t)(t + 2) * kstep;
            const char* a3 = a2 + kstep; const char* b3 = b2 + kstep;
            if (last && has_next) S.a_ready(nxt);
            if constexpr (SP2) {
            PG8_LDB(B0, 0, 0); PG8_LDB(B1, 0, 1); PG8_SCHED; PG8_LDA(At, 0, 0); PG8_STAGE(PG8_SA(1, 1), a1 + hstepA, voffA);
            PG8_WAIT_V(8); PG8_WAIT_L(0); PG8_BAR; PG8_MMA(0, 0, At, B0); PG8_MMA(0, 1, At, B1); PG8_BAR; PG8_SCHED;
            PG8_LDA(At, 0, 1); PG8_STAGE(PG8_SB(0, 0), b2, voffB); PG8_STAGE(PG8_SB(0, 1), b2 + hstepB, voffB); PG8_STAGE(PG8_SA(0, 0), a2, voffA);
            PG8_WAIT_V(8); PG8_WAIT_L(0); PG8_BAR; PG8_MMA(1, 0, At, B0); PG8_MMA(1, 1, At, B1); PG8_BAR; PG8_SCHED;
            PG8_LDB(B0, 1, 0); PG8_LDB(B1, 1, 1); PG8_SCHED; PG8_LDA(At, 1, 0); PG8_STAGE(PG8_SA(0, 1), a2 + hstepA, voffA);
            PG8_WAIT_V(8); PG8_WAIT_L(0); PG8_BAR; PG8_MMA(0, 0, At, B0); PG8_MMA(0, 1, At, B1); PG8_BAR; PG8_SCHED;
            PG8_LDA(At, 1, 1); PG8_STAGE(PG8_SB(1, 0), b3, voffB); PG8_STAGE(PG8_SB(1, 1), b3 + hstepB, voffB); PG8_STAGE(PG8_SA(1, 0), a3, voffA);
            PG8_WAIT_V(8); PG8_WAIT_L(0); PG8_BAR; PG8_MMA(1, 0, At, B0); PG8_MMA(1, 1, At, B1); PG8_BAR; PG8_SCHED;
            } else {
            PG8_LDB(B0, 0, 0); PG8_SCHED; PG8_LDA(At, 0, 0); PG8_STAGE(PG8_SA(1, 1), a1 + hstepA, voffA);
            PG8_WAIT_L(8); PG8_BAR; PG8_WAIT_L(0); PG8_MMA(0, 0, At, B0); PG8_BAR; PG8_SCHED;
            PG8_LDB(B1, 0, 1); PG8_STAGE(PG8_SB(0, 0), b2, voffB);
            PG8_BAR; PG8_WAIT_L(0); PG8_MMA(0, 1, At, B1); PG8_BAR;
            PG8_LDA(At, 0, 1); PG8_STAGE(PG8_SA(0, 0), a2, voffA);
            PG8_BAR; PG8_WAIT_L(0); PG8_MMA(1, 0, At, B0); PG8_BAR; PG8_SCHED;
            PG8_STAGE(PG8_SB(0, 1), b2 + hstepB, voffB);
            PG8_WAIT_V(6); PG8_BAR; PG8_MMA(1, 1, At, B1); PG8_BAR;
            PG8_LDB(B0, 1, 0); PG8_SCHED; PG8_LDA(At, 1, 0); PG8_STAGE(PG8_SA(0, 1), a2 + hstepA, voffA);
            PG8_WAIT_L(8); PG8_BAR; PG8_WAIT_L(0); PG8_MMA(0, 0, At, B0); PG8_BAR; PG8_SCHED;
            PG8_LDB(B1, 1, 1); PG8_STAGE(PG8_SB(1, 0), b3, voffB);
            PG8_BAR; PG8_WAIT_L(0); PG8_MMA(0, 1, At, B1); PG8_BAR;
            PG8_LDA(At, 1, 1); PG8_STAGE(PG8_SA(1, 0), a3, voffA);
            PG8_BAR; PG8_WAIT_L(0); PG8_MMA(1, 0, At, B0); PG8_BAR; PG8_SCHED;
            PG8_STAGE(PG8_SB(1, 1), b3 + hstepB, voffB);
            PG8_WAIT_V(6); PG8_BAR; PG8_MMA(1, 1, At, B1); PG8_BAR;
            }
        }
        if constexpr (FP8) asm volatile("s_nop 15\n\ts_nop 15" : "+v"(acc[1][1][0][0]), "+v"(acc[1][1][0][1]), "+v"(acc[1][1][1][0]), "+v"(acc[1][1][1][1]), "+v"(acc[1][1][2][0]), "+v"(acc[1][1][2][1]), "+v"(acc[1][1][3][0]), "+v"(acc[1][1][3][1]) :: "memory");
        if constexpr (ALIGN_EPI) { if (wr == 0) PG8_BAR; }
        if constexpr (!Epi::AFTER_DRAIN) { E(acc, cur, wr, wc, fr, fq); S.done(cur); }
        if (!has_next) break;
#pragma unroll
        for (int a = 0; a < 2; ++a)
#pragma unroll
            for (int b = 0; b < 2; ++b)
#pragma unroll
                for (int m = 0; m < 4; ++m)
#pragma unroll
                    for (int n = 0; n < 2; ++n) acc[a][b][m][n] = (f32x4){0.f, 0.f, 0.f, 0.f};
        cur = nxt; cA = nA; cB = nB; ++ui;
        if constexpr (ALIGN_EPI) { if (wr == 1) PG8_BAR; }
    }
    PG8_WAIT_V(0);
    if constexpr (!ALIGN_EPI) { if (wr == 0) PG8_BAR; }
    PG8_BAR;
    if constexpr (Epi::AFTER_DRAIN) { E.fused(acc, cur, wr, wc, fr, fq, lds, wid, lane); S.done(cur); }
#undef PG8_SA
#undef PG8_SB
#undef PG8_STAGE
#undef PG8_LDA
#undef PG8_LDB
#undef PG8_MMA
#undef PG8_WAIT_V
#undef PG8_WAIT_L
#undef PG8_BAR
#undef PG8_SCHED
}
}

#define GAS __attribute__((address_space(1)))
#define LAS __attribute__((address_space(3)))
typedef unsigned short bf16;
typedef unsigned v4u __attribute__((ext_vector_type(4)));
typedef float f32x4 __attribute__((ext_vector_type(4)));
typedef short bf16x8 __attribute__((ext_vector_type(8)));
typedef GAS unsigned gu32;
typedef GAS unsigned long long gu64;
#define RLX_AGENT __ATOMIC_RELAXED, __HIP_MEMORY_SCOPE_AGENT
#define LDS_WAIT() asm volatile("s_waitcnt lgkmcnt(0)" ::: "memory")
#define VM_WAIT() asm volatile("s_waitcnt vmcnt(0)" ::: "memory")
__device__ __forceinline__ unsigned long long rt() { return __builtin_amdgcn_s_memrealtime(); }
__device__ __forceinline__ unsigned f2bf(float f) { unsigned u = __builtin_bit_cast(unsigned, f); return (u + 0x7fffu + ((u >> 16) & 1u)) >> 16; }
__device__ __forceinline__ unsigned pk2(float lo, float hi) { unsigned r; asm volatile("v_cvt_pk_bf16_f32 %0, %1, %2" : "=v"(r) : "v"(lo), "v"(hi)); return r; }

#define XB_TMO      128
#define XB_XCNT(j)  (256  + 64 * (j))
#define XB_XSUB(j)  (1280 + 64 * (j))
#define XB_XGEN(j)  (2304 + 64 * (j))
#define XB_TOP      3328
#define XB_TOPGEN   3392
#define XCD_BAR_WORDS 3456
#define XB_SPIN_CAP (1u << 18)

__device__ __forceinline__ unsigned xb_ld(unsigned* p)              { return __hip_atomic_load(p, __ATOMIC_RELAXED, __HIP_MEMORY_SCOPE_AGENT); }
__device__ __forceinline__ unsigned xb_add(unsigned* p, unsigned v) { return __hip_atomic_fetch_add(p, v, __ATOMIC_RELAXED, __HIP_MEMORY_SCOPE_AGENT); }
__device__ __forceinline__ unsigned xb_xcc_id() { return (unsigned)__builtin_amdgcn_s_getreg((3 << 11) | 20) & 0xFu; }
#define XB_SPIN(cond, bar) do { unsigned _sp = 0; while (cond) { __builtin_amdgcn_s_sleep(1); \
    if ((++_sp & 255u) == 0u) { if (xb_ld(&(bar)[XB_TMO])) break; if (_sp > XB_SPIN_CAP) { atomicAdd(&(bar)[XB_TMO], 1u); break; } } } } while (0)

struct XcdBarrier {
    unsigned* bar; unsigned x;
    volatile LAS unsigned* st;
};

__device__ __forceinline__ XcdBarrier xcd_barrier_post(unsigned* bar, volatile LAS unsigned* st) {
    XcdBarrier b; b.bar = bar; b.x = xb_xcc_id(); b.st = st;
    if (threadIdx.x == 0) (void)xb_add(&bar[XB_XCNT(b.x)], 1u);
    return b;
}
__device__ __forceinline__ void xcd_barrier_complete(unsigned* bar, unsigned x, unsigned& nloc, unsigned& nx) {
    const unsigned G = gridDim.x * gridDim.y * gridDim.z;
    unsigned sum, cnt, mine, sp = 0u;
    for (;;) {
        sum = 0u; cnt = 0u; mine = 0u;
#pragma unroll
        for (unsigned j = 0; j < 16; ++j) { const unsigned c = xb_ld(&bar[XB_XCNT(j)]); sum += c; cnt += (c > 0u) ? 1u : 0u; mine = (j == x) ? c : mine; }
        if (sum == G) break;
        __builtin_amdgcn_s_sleep(1);
        if ((++sp & 255u) == 0u) { if (xb_ld(&bar[XB_TMO])) break; if (sp > XB_SPIN_CAP) { atomicAdd(&bar[XB_TMO], 1u); break; } }
    }
    nloc = mine > 0u ? mine : 1u; nx = cnt > 0u ? cnt : 1u;
}

__device__ __forceinline__ void xcd_barrier(const XcdBarrier& b) {
    asm volatile("s_waitcnt vmcnt(0)" ::: "memory");
    __syncthreads();
    if (threadIdx.x == 0) {
        unsigned* bar = b.bar;
        __builtin_amdgcn_s_waitcnt(0);
        unsigned nloc = b.st[0], nx = b.st[1];
        if (nloc == 0u) { xcd_barrier_complete(bar, b.x, nloc, nx); b.st[0] = nloc; b.st[1] = nx; }
        const unsigned old = xb_add(&bar[XB_XSUB(b.x)], 1u);
        const unsigned gen = old / nloc;
        if (old + 1u == (gen + 1u) * nloc) {
            __builtin_amdgcn_fence(__ATOMIC_RELEASE, "agent");
            asm volatile("s_waitcnt vmcnt(0)" ::: "memory");
            const unsigned og = xb_add(&bar[XB_TOP], 1u);
            const unsigned tg = og / nx;
            if (og + 1u == (tg + 1u) * nx) xb_add(&bar[XB_TOPGEN], 1u);
            else XB_SPIN(xb_ld(&bar[XB_TOPGEN]) == tg, bar);
            __builtin_amdgcn_fence(__ATOMIC_ACQUIRE, "agent");
            xb_add(&bar[XB_XGEN(b.x)], 1u);
            asm volatile("s_waitcnt vmcnt(0)" ::: "memory");
        } else {
            XB_SPIN(xb_ld(&bar[XB_XGEN(b.x)]) == gen, bar);
            __builtin_amdgcn_fence(__ATOMIC_ACQUIRE, "agent");
            asm volatile("s_waitcnt vmcnt(0)" ::: "memory");
        }
    }
    __syncthreads();
}

constexpr int NWAVES = 8;
constexpr int BATCH = 8, T = 2048, D = 2048, M = BATCH * T;
constexpr int NPROJ = 10320, NPROJ_P = 10496;
constexpr int C_Q = 0, C_K = 1024, C_V = 1280, C_CQ = 1536, C_KID = 2048, C_WID = 2112, C_HQ = 2128, C_HF = 3152, C_HI = 4176, C_HG = 5200, C_GA = 6224, C_GH = 8272;
constexpr int FFD = 5632, FFE = 7168, NEXP = 8;
constexpr int MS = 34816;
constexpr float EPS = 1e-6f;
constexpr float ATT_SCALE = 0.08838834764831845f;
constexpr float IDX_WSCALE = 0.25f * 0.125f;
constexpr int NSEL = 256;

constexpr size_t MiB = 1u << 20;
constexpr size_t WS_CTL = 0, CTL_ZERO_BYTES = 1 * MiB;
constexpr size_t WS_WIN = 2 * MiB, WIN_SZ = 41 * MiB;
constexpr size_t WS_WIDX = 84 * MiB, WIDX_SZ = 1 * MiB;
constexpr size_t WS_WUA = 86 * MiB, WS_WUH = 94 * MiB, WU_SZ = 4 * MiB;
constexpr size_t WS_WO = 102 * MiB, WO_SZ = 8 * MiB;
constexpr size_t WS_W13D = 118 * MiB, WS_W2D = 162 * MiB;
constexpr size_t WS_W13M = 184 * MiB, WS_W2M = 632 * MiB;
constexpr size_t WS_XB = 856 * MiB;
constexpr size_t WS_PROJ = 920 * MiB;
constexpr size_t WS_QN = 1248 * MiB, WS_QIDX = 1280 * MiB, WS_KN = 1312 * MiB, WS_KIDX = 1320 * MiB, WS_WIDXV = 1322 * MiB, WS_MASK = 1323 * MiB;
constexpr size_t WS_RSTD1 = 1327 * MiB, WS_RSTDCQ = WS_RSTD1 + 65536;
constexpr size_t WS_MIX = 1328 * MiB;
constexpr size_t WS_TMP = 1392 * MiB;
constexpr size_t WS_MRG = 1520 * MiB;
constexpr size_t WS_H = 1584 * MiB;
constexpr size_t WS_ACTM = 920 * MiB;
constexpr size_t WS_Y = 1396 * MiB, WS_HS = 1396 * MiB;
constexpr size_t WS_TAB = 1712 * MiB;
constexpr size_t TAB_RSTD2 = 0, TAB_RSTDS = 1 * 65536, TAB_TOKE = 4 * 65536, TAB_TOKPOS = 6 * 65536, TAB_TOKP = 8 * 65536, TAB_TOKDEST = 10 * 65536;
constexpr size_t WS_ISCR = 408 * MiB;
constexpr size_t WS_HOI = 472 * MiB;
constexpr size_t WS_HSX = 536 * MiB;
constexpr size_t WS_HDEC = 604 * MiB;
constexpr size_t WS_HQH = 744 * MiB, WS_HUT = 776 * MiB;
static_assert(WS_W13M + 8ull * 2 * FFE * 2048 <= WS_ISCR && WS_HDEC + 2 * MiB <= WS_W2M && WS_W2M + 8ull * 2048 * FFE <= WS_HQH && WS_HUT + 64 * MiB <= WS_XB, "dedicated regions sit in the unused halves of the expert-weight slots");
constexpr size_t WS_HB = 1714 * MiB;
constexpr size_t WS_END = 1778 * MiB;
static_assert(WS_WIN + 2 * WIN_SZ <= WS_WIDX && WS_W2M + 8ull * 2048 * 7168 * 2 <= WS_XB && WS_PROJ + (size_t)M * NPROJ_P * 2 <= WS_QN && WS_ACTM + (size_t)MS * FFE * 2 <= WS_Y && WS_Y + (size_t)MS * 2048 * 4 <= WS_TAB && WS_H + (size_t)M * D * 4 <= WS_TAB && WS_MRG + (size_t)M * D * 2 <= WS_H && WS_TMP + (size_t)M * D * 4 <= WS_MRG && WS_MIX + (size_t)M * D * 2 <= WS_TMP && WS_RSTDCQ + 65536 <= WS_MIX && WS_XB + (size_t)M * D * 2 <= WS_PROJ && WS_TAB + 12 * 65536 <= WS_END, "ws map");
constexpr int CW_BAR = 4096;
constexpr int CW_ECNT = 16384;

constexpr int RING_OFF = 0, RING_BYTES = 131072;
constexpr int LDSCTL_OFF = 135168, MISC_OFF = LDSCTL_OFF + 320;
constexpr int LDS_BYTES = 147456;

__device__ const unsigned char BUCKET[129] = {0, 1, 2, 3, 4, 5, 6, 7, 8, 9, 10, 11, 12, 13, 14, 15, 16, 16, 16, 17, 17, 18, 18, 18, 19, 19, 19, 20, 20, 20, 20, 21, 21, 21, 21, 22, 22, 22, 22, 22, 23, 23, 23, 23, 23, 23, 24, 24, 24, 24, 24, 24, 25, 25, 25, 25, 25, 25, 25, 26, 26, 26, 26, 26, 26, 26, 26, 27, 27, 27, 27, 27, 27, 27, 27, 27, 27, 28, 28, 28, 28, 28, 28, 28, 28, 28, 28, 29, 29, 29, 29, 29, 29, 29, 29, 29, 29, 29, 29, 30, 30, 30, 30, 30, 30, 30, 30, 30, 30, 30, 30, 30, 30, 31, 31, 31, 31, 31, 31, 31, 31, 31, 31, 31, 31, 31, 31, 31, 31};

typedef unsigned v2u __attribute__((ext_vector_type(2)));
struct Args { const float* in[23]; float* out; unsigned char* ws; int ph_lo, ph_hi; };
typedef const __attribute__((address_space(4))) Args* KA;
__device__ __forceinline__ KA ka_get() { KA p = (KA)__builtin_amdgcn_kernarg_segment_ptr(); asm volatile("" : "+s"(p)); return p; }

struct Frame {
    LAS unsigned char* lds;
    int tid, lane, wave, G, bid;
};
__device__ __forceinline__ Frame make_frame(LAS unsigned char* lds, int wave_s) {
    Frame F; int ln; asm volatile("v_mbcnt_lo_u32_b32 %0, -1, 0\n\tv_mbcnt_hi_u32_b32 %0, -1, %0" : "=v"(ln));
    int w = wave_s, b = blockIdx.x, g = gridDim.x; asm volatile("" : "+s"(w), "+s"(b), "+s"(g));
    F.lds = lds; F.lane = ln; F.wave = w; F.tid = w * 64 + ln; F.G = g; F.bid = b; return F;
}
__device__ __forceinline__ bool in_range(int k, int lo, int hi) { asm volatile("" : "+s"(k)); return lo <= k && k < hi; }
template <int O> __device__ __forceinline__ float swz(float v) { return __builtin_bit_cast(float, __builtin_amdgcn_ds_swizzle(__builtin_bit_cast(int, v), (O << 10) | 0x1f)); }
__device__ __forceinline__ void swap32(unsigned a, unsigned& r0, unsigned& r1) { unsigned b = a; asm volatile("" : "+v"(b)); auto rr = __builtin_amdgcn_permlane32_swap(a, b, false, false); r0 = rr[0]; r1 = rr[1]; }
__device__ __forceinline__ float x32_sum(float v) { unsigned r0, r1; swap32(__builtin_bit_cast(unsigned, v), r0, r1); return __builtin_bit_cast(float, r0) + __builtin_bit_cast(float, r1); }
__device__ __forceinline__ float x32_max(float v) { unsigned r0, r1; swap32(__builtin_bit_cast(unsigned, v), r0, r1); return fmaxf(__builtin_bit_cast(float, r0), __builtin_bit_cast(float, r1)); }
__device__ __forceinline__ float wave_sum(float v) { v += swz<1>(v); v += swz<2>(v); v += swz<4>(v); v += swz<8>(v); v += swz<16>(v); return x32_sum(v); }
__device__ __forceinline__ float wave_max(float v) { v = fmaxf(v, swz<1>(v)); v = fmaxf(v, swz<2>(v)); v = fmaxf(v, swz<4>(v)); v = fmaxf(v, swz<8>(v)); v = fmaxf(v, swz<16>(v)); return x32_max(v); }
__device__ __forceinline__ float bf2f(bf16 v) { return __builtin_bit_cast(float, (unsigned)v << 16); }
__device__ __forceinline__ float blo(unsigned w) { return __builtin_bit_cast(float, w << 16); }
__device__ __forceinline__ float bhi(unsigned w) { return __builtin_bit_cast(float, w & 0xffff0000u); }
__device__ __forceinline__ float sigmf(float x) { return __builtin_amdgcn_rcpf(1.0f + __builtin_amdgcn_exp2f(-1.4426950408889634f * x)); }
__device__ __forceinline__ float siluf(float x) { return x * __builtin_amdgcn_rcpf(1.0f + __builtin_amdgcn_exp2f(-1.4426950408889634f * x)); }

struct ConvD { const float* src; bf16* dst; const float* gain; int K, N, Npad, nb; size_t sstride, dstride; int grp, gstride, goff; int f8; };
__device__ __forceinline__ void get_conv(int id, KA a, ConvD& d) {
    const int l = id >> 3, k = id & 7;
    bf16* ws16 = (bf16*)a->ws;
    d.gain = nullptr; d.nb = 1; d.sstride = 0; d.dstride = 0; d.grp = 30; d.gstride = 0; d.goff = 0; d.f8 = 0;
    if (k == 0) { d.src = a->in[4] + (size_t)l * 2048 * NPROJ; d.dst = (bf16*)(a->ws + WS_WIN + l * WIN_SZ); d.gain = a->in[2] + l * 2048; d.K = 2048; d.N = NPROJ; d.Npad = NPROJ_P; d.f8 = 1; }
    else if (k == 1) { d.src = a->in[8] + (size_t)l * 512 * 1024; d.dst = (bf16*)(a->ws + WS_WIDX + l * WIDX_SZ); d.gain = a->in[7] + l * 512; d.K = 512; d.N = 1024; d.Npad = 1024; }
    else if (k == 2) { d.src = a->in[13] + (size_t)l * 1024 * 2048; d.dst = (bf16*)(a->ws + WS_WUA + l * WU_SZ); d.K = 1024; d.N = 2048; d.Npad = 2048; }
    else if (k == 3) { d.src = a->in[14] + (size_t)l * 1024 * 2048; d.dst = (bf16*)(a->ws + WS_WUH + l * WU_SZ); d.K = 1024; d.N = 2048; d.Npad = 2048; }
    else if (k == 4) { d.src = a->in[15] + (size_t)l * 2048 * 2048; d.dst = (bf16*)(a->ws + WS_WO + l * WO_SZ); d.K = 2048; d.N = 2048; d.Npad = 2048; }
    else if (l == 0) {
        if (k == 5) { d.src = a->in[16]; d.dst = (bf16*)(a->ws + WS_W13D); d.gain = a->in[3]; d.K = 2048; d.N = FFD; d.Npad = FFD; d.grp = 7; d.gstride = 256; d.goff = 0; }
        else if (k == 6) { d.src = a->in[17]; d.dst = (bf16*)(a->ws + WS_W13D); d.gain = a->in[3]; d.K = 2048; d.N = FFD; d.Npad = FFD; d.grp = 7; d.gstride = 256; d.goff = 128; }
        else { d.src = a->in[18]; d.dst = (bf16*)(a->ws + WS_W2D); d.K = FFD; d.N = 2048; d.Npad = 2048; }
    } else {
        if (k == 5) { d.src = a->in[20]; d.dst = (bf16*)(a->ws + WS_W13M); d.gain = a->in[3] + 2048; d.K = 2048; d.N = FFE; d.Npad = FFE; d.nb = NEXP; d.sstride = (size_t)2048 * FFE; d.dstride = (size_t)2 * FFE * 2048; d.grp = 7; d.gstride = 256; d.goff = 0; d.f8 = 1; }
        else if (k == 6) { d.src = a->in[21]; d.dst = (bf16*)(a->ws + WS_W13M); d.gain = a->in[3] + 2048; d.K = 2048; d.N = FFE; d.Npad = FFE; d.nb = NEXP; d.sstride = (size_t)2048 * FFE; d.dstride = (size_t)2 * FFE * 2048; d.grp = 7; d.gstride = 256; d.goff = 128; d.f8 = 1; }
        else { d.src = a->in[22]; d.dst = (bf16*)(a->ws + WS_W2M); d.K = FFE; d.N = 2048; d.Npad = 2048; d.nb = NEXP; d.sstride = (size_t)FFE * 2048; d.dstride = (size_t)2048 * FFE; d.f8 = 1; }
    }
    (void)ws16;
}
__device__ __forceinline__ void conv_item(const ConvD& d, long item, LAS float* scr, int lane) {
    const int nblk = d.Npad / 64, kblk = d.K / 64; const int per = kblk * nblk, it32 = (int)item;
    const int e = it32 / per; const int r = it32 - e * per; const int kb = r / nblk, nbi = r - kb * nblk, k0 = 64 * kb, n0 = 64 * nbi;
    const float* src = d.src + (size_t)e * d.sstride; bf16* dst = d.dst + (size_t)e * d.dstride; unsigned char* dst8 = (unsigned char*)d.dst + (size_t)e * d.dstride;
    const int nn = (lane & 15) * 4, kq = lane >> 4;
    const int c = lane & 7;
    f32x4 g0 = {1.f, 1.f, 1.f, 1.f}, g1 = g0;
    if (d.gain) { g0 = *(const GAS f32x4*)(d.gain + k0 + 8 * c); g1 = *(const GAS f32x4*)(d.gain + k0 + 8 * c + 4); }
    f32x4 v[16];
    if (n0 + 64 <= d.N) {
#pragma unroll
        for (int i = 0; i < 16; ++i) { const int kk = 4 * i + kq; v[i] = *(const GAS f32x4*)(src + (size_t)(k0 + kk) * d.N + n0 + nn); }
    } else {
#pragma unroll
        for (int i = 0; i < 16; ++i) { const int kk = 4 * i + kq; v[i] = (n0 + nn < d.N) ? *(const GAS f32x4*)(src + (size_t)(k0 + kk) * d.N + n0 + nn) : (f32x4){0.f, 0.f, 0.f, 0.f}; }
    }
#pragma unroll
    for (int i = 0; i < 16; ++i) { const int kk = 4 * i + kq; LAS float* p = scr + kk * 65 + nn; p[0] = v[i][0]; p[1] = v[i][1]; p[2] = v[i][2]; p[3] = v[i][3]; }
    LDS_WAIT(); asm volatile("" ::: "memory");
    const float g[8] = {g0[0], g0[1], g0[2], g0[3], g1[0], g1[1], g1[2], g1[3]};
#pragma unroll
    for (int j = 0; j < 8; ++j) { const int n = (lane >> 3) + 8 * j; const LAS float* s = scr + (8 * c) * 65 + n;
        const int ng = n0 + n; const int row = (ng >> d.grp) * d.gstride + d.goff + (ng & ((1 << d.grp) - 1));
        if (d.f8) { unsigned w0 = 0u, w1 = 0u;
            w0 = __builtin_amdgcn_cvt_pk_fp8_f32(s[0 * 65] * g[0] * 64.f, s[1 * 65] * g[1] * 64.f, w0, false); w0 = __builtin_amdgcn_cvt_pk_fp8_f32(s[2 * 65] * g[2] * 64.f, s[3 * 65] * g[3] * 64.f, w0, true);
            w1 = __builtin_amdgcn_cvt_pk_fp8_f32(s[4 * 65] * g[4] * 64.f, s[5 * 65] * g[5] * 64.f, w1, false); w1 = __builtin_amdgcn_cvt_pk_fp8_f32(s[6 * 65] * g[6] * 64.f, s[7 * 65] * g[7] * 64.f, w1, true);
            *(GAS v2u*)(dst8 + (size_t)row * d.K + k0 + 8 * c) = (v2u){w0, w1}; }
        else { v4u o; o.x = pk2(s[0 * 65] * g[0], s[1 * 65] * g[1]); o.y = pk2(s[2 * 65] * g[2], s[3 * 65] * g[3]); o.z = pk2(s[4 * 65] * g[4], s[5 * 65] * g[5]); o.w = pk2(s[6 * 65] * g[6], s[7 * 65] * g[7]);
            *(GAS v4u*)(dst + (size_t)row * d.K + k0 + 8 * c) = o; } }
    LDS_WAIT(); asm volatile("" ::: "memory");
}
__device__ __forceinline__ void phase_conv(Frame& F, KA a, int id_lo, int id_hi, int vb, int vG) {
    LAS float* scr = (LAS float*)(F.lds + F.wave * 16640);
    const long gw = (long)vb * NWAVES + F.wave, NGW = (long)vG * NWAVES;
    long base = 0;
#pragma unroll 1
    for (int id = id_lo; id < id_hi; ++id) {
        ConvD d; get_conv(id, a, d);
        const long items = (long)d.nb * (d.K / 64) * (d.Npad / 64);
        long first = (gw - base % NGW + NGW) % NGW;
#pragma unroll 1
        for (long it = first; it < items; it += NGW) conv_item(d, it, scr, F.lane);
        base += items;
    }
}

template <bool F8> __device__ __forceinline__ void phase_norm_t(Frame& F, const float* src, bf16* dst, float* rstd) {
    const int gw = F.bid * NWAVES + F.wave, NGW = F.G * NWAVES;
    for (int row = gw; row < M; row += NGW) {
        const GAS f32x4* xr = (const GAS f32x4*)(src + (size_t)row * D) + F.lane;
        f32x4 v[8]; float s = 0.f;
#pragma unroll
        for (int j = 0; j < 8; ++j) { v[j] = xr[64 * j]; s += (v[j].x * v[j].x + v[j].y * v[j].y) + (v[j].z * v[j].z + v[j].w * v[j].w); }
        s = wave_sum(s);
        if constexpr (F8) { GAS unsigned* o4 = (GAS unsigned*)((unsigned char*)dst + (size_t)row * D) + F.lane;
#pragma unroll
            for (int j = 0; j < 8; ++j) { unsigned w = 0u; w = __builtin_amdgcn_cvt_pk_fp8_f32(v[j].x, v[j].y, w, false); w = __builtin_amdgcn_cvt_pk_fp8_f32(v[j].z, v[j].w, w, true); o4[64 * j] = w; } }
        else { GAS v2u* o8 = (GAS v2u*)(dst + (size_t)row * D) + F.lane;
#pragma unroll
            for (int j = 0; j < 8; ++j) { v2u w; w.x = pk2(v[j].x, v[j].y); w.y = pk2(v[j].z, v[j].w); o8[64 * j] = w; } }
        if (F.lane == 0) rstd[row] = 1.0f / sqrtf(s * (1.0f / D) + EPS);
    }
}

__device__ __forceinline__ void phase_post(Frame& F, KA a, int l) {
    const int gw = F.bid * NWAVES + F.wave, NGW = F.G * NWAVES, lane = F.lane;
    const bf16* proj = (const bf16*)(a->ws + WS_PROJ);
    bf16* qn = (bf16*)(a->ws + WS_QN); bf16* kn = (bf16*)(a->ws + WS_KN); bf16* kidx = (bf16*)(a->ws + WS_KIDX); float* widx = (float*)(a->ws + WS_WIDXV); float* rstdcq = (float*)(a->ws + WS_RSTDCQ);
    const float* qg = a->in[5] + l * 128; const float* kg = a->in[6] + l * 128; const float* lng = a->in[9] + l * 64; const float* lnb = a->in[10] + l * 64;
    for (int row = gw; row < M; row += NGW) {
        const bf16* pr = proj + (size_t)row * NPROJ_P;
        {
            const v4u w0 = *(const GAS v4u*)(pr + C_Q + 16 * lane), w1 = *(const GAS v4u*)(pr + C_Q + 16 * lane + 8);
            float x[16] = {blo(w0.x), bhi(w0.x), blo(w0.y), bhi(w0.y), blo(w0.z), bhi(w0.z), blo(w0.w), bhi(w0.w), blo(w1.x), bhi(w1.x), blo(w1.y), bhi(w1.y), blo(w1.z), bhi(w1.z), blo(w1.w), bhi(w1.w)};
            float ss = 0.f;
#pragma unroll
            for (int i = 0; i < 16; ++i) ss += x[i] * x[i];
            ss += swz<1>(ss); ss += swz<2>(ss); ss += swz<4>(ss);
            const float r = ATT_SCALE / sqrtf(ss * (1.0f / 128.0f) + EPS); const int d0 = (lane & 7) * 16;
            unsigned o[8];
#pragma unroll
            for (int i = 0; i < 8; ++i) o[i] = pk2(x[2 * i] * r * qg[d0 + 2 * i], x[2 * i + 1] * r * qg[d0 + 2 * i + 1]);
            *(GAS v4u*)(qn + (size_t)row * 1024 + 16 * lane) = (v4u){o[0], o[1], o[2], o[3]}; *(GAS v4u*)(qn + (size_t)row * 1024 + 16 * lane + 8) = (v4u){o[4], o[5], o[6], o[7]};
        }
        {
            const v2u w = *(const GAS v2u*)(pr + C_K + 4 * lane);
            const float x0 = blo(w.x), x1 = bhi(w.x), x2 = blo(w.y), x3 = bhi(w.y);
            float ss = x0 * x0 + x1 * x1 + x2 * x2 + x3 * x3;
            ss += swz<1>(ss); ss += swz<2>(ss); ss += swz<4>(ss); ss += swz<8>(ss); ss += swz<16>(ss);
            const float r = 1.0f / sqrtf(ss * (1.0f / 128.0f) + EPS); const int d0 = (lane & 31) * 4;
            v2u o; o.x = pk2(x0 * r * kg[d0], x1 * r * kg[d0 + 1]); o.y = pk2(x2 * r * kg[d0 + 2], x3 * r * kg[d0 + 3]);
            *(GAS v2u*)(kn + (size_t)row * 256 + 4 * lane) = o;
        }
        {
            const v4u w = *(const GAS v4u*)(pr + C_CQ + 8 * lane);
            const float x[8] = {blo(w.x), bhi(w.x), blo(w.y), bhi(w.y), blo(w.z), bhi(w.z), blo(w.w), bhi(w.w)};
            float ss = 0.f;
#pragma unroll
            for (int i = 0; i < 8; ++i) ss += x[i] * x[i];
            ss = wave_sum(ss);
            if (lane == 0) rstdcq[row] = 1.0f / sqrtf(ss * (1.0f / 512.0f) + EPS);
        }
        {
            const float x = bf2f(pr[C_KID + lane]);
            const float mu = wave_sum(x) * (1.0f / 64.0f); const float dd = x - mu; const float var = wave_sum(dd * dd) * (1.0f / 64.0f);
            const float y = dd / sqrtf(var + EPS) * lng[lane] + lnb[lane];
            kidx[(size_t)row * 64 + lane] = (bf16)f2bf(y);
        }
        if (lane < 16) widx[(size_t)row * 16 + lane] = bf2f(pr[C_WID + lane]) * IDX_WSCALE;
    }
}

__device__ __forceinline__ unsigned ordkey(float v) { const unsigned u = __builtin_bit_cast(unsigned, v); return (u & 0x80000000u) ? ~u : (u | 0x80000000u); }
typedef float f32x16 __attribute__((ext_vector_type(16)));
typedef float f32x2 __attribute__((ext_vector_type(2)));
__device__ __forceinline__ int wave_total6(int cl) { int c = 0;
#pragma unroll
    for (int b = 0; b < 6; ++b) c += __popcll(__ballot((cl >> b) & 1)) << b;
    return c; }
__device__ __forceinline__ void select_row(unsigned (&key)[32], int t, unsigned long long* mrow, int lane) {
    if (t + 1 <= NSEL) {
#pragma unroll
        for (int j = 0; j < 32; ++j) { const unsigned long long bs = __ballot(key[j] != 0u); if (lane == 0) mrow[j] = bs; }
    } else {
#pragma unroll
        for (int st = 0; st < 5; ++st) { const int j = 16 >> st; const unsigned m = st == 0 ? 0x0000FFFFu : st == 1 ? 0x00FF00FFu : st == 2 ? 0x0F0F0F0Fu : st == 3 ? 0x33333333u : 0x55555555u;
#pragma unroll
            for (int k = 0; k < 32; ++k) if (!(k & j)) { const unsigned x = ((key[k] >> j) ^ key[k + j]) & m; key[k] ^= x << j; key[k + j] ^= x; } }
        unsigned G = 0u, E = 0xffffffffu;
#pragma unroll
        for (int bit = 31; bit >= 0; --bit) {
            const unsigned m = E & key[bit];
            const bool take = wave_total6(__popc(G) + __popc(m)) >= NSEL;
            E = take ? m : (E & ~m); G = take ? G : (G | m);
        }
        const int need = NSEL - wave_total6(__popc(G)); int running = 0;
        const unsigned long long lt = (lane == 0) ? 0ull : (~0ull >> (64 - lane));
#pragma unroll
        for (int j = 0; j < 32; ++j) {
            const bool eq = (E >> j) & 1u; const unsigned long long be = __ballot(eq);
            const int rank = running + __popcll(be & lt);
            const bool sel = ((G >> j) & 1u) || (eq && rank < need);
            running += __popcll(be);
            const unsigned long long bs = __ballot(sel); if (lane == 0) mrow[j] = bs;
        }
    }
}
__device__ __forceinline__ void phase_index2(Frame& F, KA a) {
    LAS unsigned char* Ws = F.lds + 66048;
    LAS unsigned char* Qs = F.lds;
    const bf16* qidx = (const bf16*)(a->ws + WS_QIDX); const bf16* kidx = (const bf16*)(a->ws + WS_KIDX); const float* widx = (const float*)(a->ws + WS_WIDXV);
    unsigned long long* mask = (unsigned long long*)(a->ws + WS_MASK);
    float* scr = (float*)(a->ws + WS_ISCR) + (size_t)F.bid * 65536;
    const int tid = F.tid, lane = F.lane, r = lane & 31, hi = lane >> 5, wave = F.wave;
    for (int u = F.bid; u < 256; u += F.G) {
        const int b = u >> 5, ii = u & 31;
#pragma unroll 1
        for (int half = 0; half < 2; ++half) {
            const int qb = half ? 63 - ii : ii; const int row0 = b * T + 32 * qb;
#pragma unroll
            for (int c = 0; c < 8; ++c) { const int row = tid >> 4, ch = (tid & 15) + 16 * c;
                *(LAS v4u*)(Qs + row * 2064 + ch * 16) = *(const GAS v4u*)(qidx + (size_t)(row0 + row) * 1024 + ch * 8); }
            if (tid < 128) *(LAS f32x4*)(Ws + 16 * tid) = *(const GAS f32x4*)(widx + (size_t)row0 * 16 + 4 * tid);
            __syncthreads();
#pragma unroll 1
            for (int kb = wave; kb <= qb; kb += 8) {
                bf16x8 kf[4]; const bf16* kp = kidx + (size_t)(b * T + 32 * kb + r) * 64 + 8 * hi;
#pragma unroll
                for (int ks = 0; ks < 4; ++ks) kf[ks] = *(const GAS bf16x8*)(kp + 16 * ks);
                f32x16 sc;
#pragma unroll
                for (int i = 0; i < 16; ++i) sc[i] = 0.f;
                const LAS unsigned char* qrow = Qs + r * 2064 + hi * 16; const LAS float* wrow = (const LAS float*)(Ws + r * 64);
                bf16x8 qa[4], qb[4];
#pragma unroll
                for (int ks = 0; ks < 4; ++ks) qa[ks] = *(const LAS bf16x8*)(qrow + ks * 32);
#pragma unroll 1
                for (int h = 0; h < 16; h += 2) {
#pragma unroll
                    for (int ks = 0; ks < 4; ++ks) qb[ks] = *(const LAS bf16x8*)(qrow + (h + 1) * 128 + ks * 32);
                    const float wA = wrow[h], wB = wrow[h + 1];
                    f32x16 accA, accB;
#pragma unroll
                    for (int i = 0; i < 16; ++i) { accA[i] = 0.f; accB[i] = 0.f; }
                    __builtin_amdgcn_sched_barrier(0);
#pragma unroll
                    for (int ks = 0; ks < 4; ++ks) accA = __builtin_amdgcn_mfma_f32_32x32x16_bf16(kf[ks], qa[ks], accA, 0, 0, 0);
                    __builtin_amdgcn_sched_barrier(0);
                    if (h + 2 < 16) {
#pragma unroll
                        for (int ks = 0; ks < 4; ++ks) qa[ks] = *(const LAS bf16x8*)(qrow + (h + 2) * 128 + ks * 32); }
#pragma unroll
                    for (int ks = 0; ks < 4; ++ks) accB = __builtin_amdgcn_mfma_f32_32x32x16_bf16(kf[ks], qb[ks], accB, 0, 0, 0);
                    __builtin_amdgcn_sched_barrier(0);
#pragma unroll
                    for (int i = 0; i < 16; ++i) sc[i] = fmaf(wA, __builtin_amdgcn_fmed3f(accA[i], 0.f, 3.0e38f), sc[i]);
#pragma unroll
                    for (int i = 0; i < 16; ++i) sc[i] = fmaf(wB, __builtin_amdgcn_fmed3f(accB[i], 0.f, 3.0e38f), sc[i]);
                }
                LAS float* Tw = (LAS float*)(F.lds + 68096 + wave * 4224);
#pragma unroll
                for (int i = 0; i < 16; ++i) Tw[r * 33 + (i & 3) + 8 * (i >> 2) + 4 * hi] = sc[i];
                asm volatile("s_waitcnt lgkmcnt(0)" ::: "memory");
#pragma unroll
                for (int j = 0; j < 16; ++j) { const int q = 2 * j + hi; scr[(size_t)q * 2048 + 32 * kb + r] = Tw[q * 33 + r]; }
                asm volatile("s_waitcnt lgkmcnt(0)" ::: "memory");
            }
            __syncthreads();
#pragma unroll 1
            for (int pass = 0; pass < 2; ++pass) {
                const int q0 = 4 * wave + 2 * pass, ta = 32 * qb + q0, tb = ta + 1; const size_t rowa = (size_t)row0 + q0;
                unsigned ka[32], kb2[32];
#pragma unroll
                for (int j = 0; j < 32; ++j) { const int s = lane + 64 * j; float vx = 0.f, vy = 0.f;
                    if (s <= 32 * qb + 31) { vx = *(const GAS float*)(scr + (size_t)q0 * 2048 + s); vy = *(const GAS float*)(scr + (size_t)(q0 + 1) * 2048 + s); }
                    ka[j] = (s <= ta) ? ordkey(vx) : 0u; kb2[j] = (s <= tb) ? ordkey(vy) : 0u; }
                select_row(ka, ta, mask + rowa * 32, lane);
                select_row(kb2, tb, mask + (rowa + 1) * 32, lane);
            }
            __syncthreads();
        }
    }
}

namespace att {
using s16x4  = __attribute__((ext_vector_type(4))) short;
constexpr int KVBLK = 64; constexpr size_t SHM_V = 16384, SHM_K = 16384; constexpr int OFF_WS = 65536, OFF_BIAS = 67584;
constexpr float THR = 8.f, LOG2E = 1.4426950408889634f;
#define KSWZ(row, colB) ((row) * 256 + ((colB) ^ (((row) & 7) << 4)))
#define SBAR() __builtin_amdgcn_sched_barrier(0)
__device__ __forceinline__ int crow(int r, int hi) { return (r & 3) + 8 * (r >> 2) + 4 * hi; }
__device__ __forceinline__ unsigned cvtpk(float lo, float hi) { unsigned r; asm volatile("v_cvt_pk_bf16_f32 %0, %1, %2" : "=v"(r) : "v"(lo), "v"(hi)); return r; }
template <bool NEAR> __device__ __forceinline__ void mask_bias(f32x16& p0, f32x16& p1, unsigned w0, unsigned w1, int hi, int dbase, const LAS float* bt) {
    const unsigned s0 = w0 >> (4 * hi), s1 = w1 >> (4 * hi);
#pragma unroll
    for (int r = 0; r < 16; ++r) { const int bp = (r & 3) + 8 * (r >> 2);
        float a = p0[r], b = p1[r];
        if (NEAR) { int i0 = dbase - bp, i1 = dbase - bp - 32; i0 = i0 < 0 ? 0 : (i0 > 128 ? 128 : i0); i1 = i1 < 0 ? 0 : (i1 > 128 ? 128 : i1); a += bt[i0]; b += bt[i1]; }
        p0[r] = ((s0 >> bp) & 1u) ? a : -INFINITY; p1[r] = ((s1 >> bp) & 1u) ? b : -INFINITY; }
}
__device__ __forceinline__ void partialSM(f32x16& p0, f32x16& p1, float badd, float& m_reg, float& mn, float& alpha) {
  float pmax = p0[0];
#pragma unroll
  for (int r = 1; r < 16; ++r) pmax = __builtin_amdgcn_fmed3f(pmax, p0[r], INFINITY);
#pragma unroll
  for (int r = 0; r < 16; ++r) pmax = __builtin_amdgcn_fmed3f(pmax, p1[r], INFINITY);
  pmax += badd;
  pmax = x32_max(pmax);
  if (__builtin_expect(__all(pmax - m_reg <= THR), 1)) { mn = m_reg; alpha = 1.f; }
  else { mn = fmaxf(m_reg, pmax); alpha = __builtin_amdgcn_exp2f((m_reg - mn) * LOG2E); m_reg = mn; }
  const float mnC = (badd - mn) * LOG2E;
#pragma unroll
  for (int r = 0; r < 16; ++r) p0[r] = fmaf(p0[r], LOG2E, mnC);
#pragma unroll
  for (int r = 0; r < 16; ++r) p1[r] = fmaf(p1[r], LOG2E, mnC);
#pragma unroll
  for (int r = 0; r < 16; ++r) p0[r] = __builtin_amdgcn_exp2f(p0[r]);
}
__device__ __forceinline__ void finishSM(f32x16& p0, f32x16& p1, float alpha, float& l_reg, bf16x8& pa0, bf16x8& pa1, bf16x8& pa2, bf16x8& pa3) {
#pragma unroll
  for (int r = 0; r < 16; ++r) p1[r] = __builtin_amdgcn_exp2f(p1[r]);
  float ps = 0;
#pragma unroll
  for (int r = 0; r < 16; ++r) ps += p0[r];
#pragma unroll
  for (int r = 0; r < 16; ++r) ps += p1[r];
  ps = x32_sum(ps);
  l_reg = l_reg * alpha + ps;
#define PK4(P, BASE, OUT) do { unsigned a0 = cvtpk(P[BASE + 0], P[BASE + 1]), a1 = cvtpk(P[BASE + 2], P[BASE + 3]);   \
    unsigned b0 = cvtpk(P[BASE + 4], P[BASE + 5]), b1 = cvtpk(P[BASE + 6], P[BASE + 7]);                              \
    auto r0 = __builtin_amdgcn_permlane32_swap(a0, b0, false, false); auto r1 = __builtin_amdgcn_permlane32_swap(a1, b1, false, false); \
    v4u w = {r0[0], r1[0], r0[1], r1[1]}; OUT = __builtin_bit_cast(bf16x8, w); } while (0)
  PK4(p0, 0, pa0); PK4(p0, 8, pa1); PK4(p1, 0, pa2); PK4(p1, 8, pa3);
#undef PK4
}
__device__ __forceinline__ void qkt(f32x16& p0, f32x16& p1, const LAS char* Ks, const bf16x8* qr, int r32, int hi) {
#pragma unroll
  for (int r = 0; r < 16; ++r) { p0[r] = 0.f; p1[r] = 0.f; }
#pragma unroll
  for (int d0 = 0; d0 < 8; ++d0) { const int cb = (d0 * 16 + hi * 8) * 2;
    const bf16x8 b0 = *(const LAS bf16x8*)(Ks + KSWZ(r32, cb));
    const bf16x8 b1 = *(const LAS bf16x8*)(Ks + KSWZ(32 + r32, cb));
    p0 = __builtin_amdgcn_mfma_f32_32x32x16_bf16(b0, qr[d0], p0, 0, 0, 0);
    p1 = __builtin_amdgcn_mfma_f32_32x32x16_bf16(b1, qr[d0], p1, 0, 0, 0); }
}
__device__ __forceinline__ int v_st(int k, int c) { const int kk = (k & ~0xC) | ((k & 4) << 1) | ((k & 8) >> 1); return ((kk >> 3) * 4 + (c >> 5)) * 512 + ((kk & 7) * 32 + (c & 31)) * 2; }
__device__ __forceinline__ int v_rd_base(int lane) { return ((lane & 3) << 3) | (((lane >> 2) & 3) << 6) | (((lane >> 4) & 1) << 5) | (((lane >> 5) & 1) << 8); }
constexpr int v_rd_off(int d0, int ks, int half) { return d0 * 512 + ks * 4096 + half * 2048; }
template <int OFF> __device__ __forceinline__ s16x4 tr_read(int vb) { s16x4 r; asm volatile("ds_read_b64_tr_b16 %0, %1 offset:%2" : "=&v"(r) : "v"(vb), "i"(OFF) : "memory"); return r; }
template <int D0> __device__ __forceinline__ void pv_one(f32x16& od, int vb, bf16x8 pa0, bf16x8 pa1, bf16x8 pa2, bf16x8 pa3) {
  const s16x4 l0 = tr_read<v_rd_off(D0, 0, 0)>(vb), h0 = tr_read<v_rd_off(D0, 0, 1)>(vb), l1 = tr_read<v_rd_off(D0, 1, 0)>(vb), h1 = tr_read<v_rd_off(D0, 1, 1)>(vb);
  const s16x4 l2 = tr_read<v_rd_off(D0, 2, 0)>(vb), h2 = tr_read<v_rd_off(D0, 2, 1)>(vb), l3 = tr_read<v_rd_off(D0, 3, 0)>(vb), h3 = tr_read<v_rd_off(D0, 3, 1)>(vb);
  asm volatile("s_waitcnt lgkmcnt(0)" ::: "memory"); SBAR();
#define PK(L, H) (bf16x8){L[0], L[1], L[2], L[3], H[0], H[1], H[2], H[3]}
  od = __builtin_amdgcn_mfma_f32_32x32x16_bf16(pa0, PK(l0, h0), od, 0, 0, 0);
  od = __builtin_amdgcn_mfma_f32_32x32x16_bf16(pa1, PK(l1, h1), od, 0, 0, 0);
  od = __builtin_amdgcn_mfma_f32_32x32x16_bf16(pa2, PK(l2, h2), od, 0, 0, 0);
  od = __builtin_amdgcn_mfma_f32_32x32x16_bf16(pa3, PK(l3, h3), od, 0, 0, 0);
#undef PK
}
__device__ __forceinline__ void pv_d0(f32x16* o, int vb, bf16x8 pa0, bf16x8 pa1, bf16x8 pa2, bf16x8 pa3) {
  pv_one<0>(o[0], vb, pa0, pa1, pa2, pa3); pv_one<1>(o[1], vb, pa0, pa1, pa2, pa3); pv_one<2>(o[2], vb, pa0, pa1, pa2, pa3); pv_one<3>(o[3], vb, pa0, pa1, pa2, pa3);
}
__device__ __forceinline__ void attn_unit(const bf16* __restrict__ Qt, const bf16* __restrict__ Kh, const bf16* __restrict__ Vh, const unsigned* __restrict__ mrow, bf16* __restrict__ Ob,
                                          int kvh, int qt, const float* relb, LAS char* lds, int tid) {
  constexpr int LDKK = 256, LDKV = NPROJ_P;
  const int wid = __builtin_amdgcn_readfirstlane(tid >> 6), lane = tid & 63, r32 = lane & 31, hi = lane >> 5;
  LAS char* V_lds = lds; LAS char* K_lds = lds + 2 * SHM_V;
  LAS float* wsf = (LAS float*)(lds + OFF_WS) + wid * 64; LAS float* li_l = wsf; LAS float* al_l = wsf + 32;
  const int hq = kvh * 4 + (wid >> 1), tq0 = 64 * qt + 32 * (wid & 1), tq = tq0 + r32;
  const LAS float* bt = (const LAS float*)(lds + OFF_BIAS) + hq * 132;
  const float bfar = relb[31 * 8 + hq];
  float m_reg = -1e30f, l_reg = 0; f32x16 o[4]; bf16x8 qr[8];
#pragma unroll
  for (int d = 0; d < 4; ++d)
#pragma unroll
    for (int r = 0; r < 16; ++r) o[d][r] = 0.f;
  const bf16* Qw = Qt + (size_t)tq * 1024 + hq * 128 + hi * 8;
#pragma unroll
  for (int d0 = 0; d0 < 8; ++d0) qr[d0] = *(const GAS bf16x8*)(Qw + d0 * 16);
  const unsigned* mq = mrow + (size_t)tq * 64;
  const int sr = tid >> 4, sc = (tid & 15) * 8, vst0 = v_st(sr, sc), vst1 = v_st(32 + sr, sc);
  const int vb0 = (int)(size_t)V_lds + v_rd_base(lane);
  struct { bf16x8 vs0, vs1, ks0, ks1; } sr_[1];
#define SLOAD(i, k0) do { sr_[i].vs0 = *(const GAS bf16x8*)(&Vh[(size_t)((k0) + sr) * LDKV + sc]); sr_[i].vs1 = *(const GAS bf16x8*)(&Vh[(size_t)((k0) + 32 + sr) * LDKV + sc]); \
    sr_[i].ks0 = *(const GAS bf16x8*)(&Kh[(size_t)((k0) + sr) * LDKK + sc]); sr_[i].ks1 = *(const GAS bf16x8*)(&Kh[(size_t)((k0) + 32 + sr) * LDKK + sc]); } while (0)
#define SWRITE(b, i) do { *(LAS bf16x8*)(V_lds + (b) * SHM_V + vst0) = sr_[i].vs0;          \
    *(LAS bf16x8*)(V_lds + (b) * SHM_V + vst1) = sr_[i].vs1; const int kc = sc * 2;               \
    *(LAS bf16x8*)(K_lds + (b) * SHM_K + KSWZ(sr, kc)) = sr_[i].ks0;                       \
    *(LAS bf16x8*)(K_lds + (b) * SHM_K + KSWZ(32 + sr, kc)) = sr_[i].ks1; } while (0)
#define RESC(a) do { if (__any((a) < 1.f)) { if (hi == 0) al_l[r32] = (a); asm volatile("s_waitcnt lgkmcnt(0)" ::: "memory"); \
    _Pragma("unroll") for (int d = 0; d < 4; ++d) _Pragma("unroll") for (int r = 0; r < 16; ++r) o[d][r] *= al_l[crow(r, hi)]; } } while (0)
#define MASKB(P0, P1, j, BADD) do { const v2u mw_ = *(const GAS v2u*)(mq + 2 * (j)); \
    if ((j) + 3 <= qt) { mask_bias<false>(P0, P1, mw_.x, mw_.y, hi, 0, bt); BADD = bfar; } \
    else { mask_bias<true>(P0, P1, mw_.x, mw_.y, hi, tq - 64 * (j) - 4 * hi, bt); BADD = 0.f; } } while (0)
  f32x16 p0, p1; float mn, al, bd; bf16x8 pa0, pa1, pa2, pa3;
  const int NT = qt + 1;
  SLOAD(0, 0); asm volatile("s_waitcnt vmcnt(0)" ::: "memory"); SWRITE(0, 0); __syncthreads();
#pragma unroll 1
  for (int j = 0; j < NT; ++j) {
    const int bsel = j & 1;
    if (j + 1 < NT) SLOAD(0, (j + 1) * KVBLK);
    SBAR(); qkt(p0, p1, K_lds + bsel * SHM_K, qr, r32, hi);
    MASKB(p0, p1, j, bd); partialSM(p0, p1, bd, m_reg, mn, al);
    RESC(al);
    finishSM(p0, p1, al, l_reg, pa0, pa1, pa2, pa3); SBAR();
    pv_d0(o, vb0 + bsel * (int)SHM_V, pa0, pa1, pa2, pa3);
    if (j + 1 < NT) { asm volatile("s_waitcnt vmcnt(0)" ::: "memory"); SWRITE(bsel ^ 1, 0); }
    __syncthreads();
  }
  if (hi == 0) li_l[r32] = l_reg; asm volatile("s_waitcnt lgkmcnt(0)" ::: "memory");
  float rli[16];
#pragma unroll
  for (int r = 0; r < 16; ++r) rli[r] = __builtin_amdgcn_rcpf(li_l[crow(r, hi)]);
  bf16* Ow = Ob + (size_t)tq0 * 2048 + hq * 128;
#pragma unroll
  for (int r = 0; r < 16; ++r) { const int orow = crow(r, hi);
#pragma unroll
    for (int d0 = 0; d0 < 4; ++d0) Ow[(size_t)orow * 2048 + d0 * 32 + r32] = (bf16)f2bf(o[d0][r] * rli[r]); }
  __syncthreads();
#undef SLOAD
#undef SWRITE
#undef RESC
#undef MASKB
}
#undef KSWZ
#undef SBAR
}
__device__ __forceinline__ void phase_attn2(Frame& F, KA a) {
    const bf16* qn = (const bf16*)(a->ws + WS_QN); const bf16* kn = (const bf16*)(a->ws + WS_KN); const bf16* proj = (const bf16*)(a->ws + WS_PROJ);
    const unsigned* mask = (const unsigned*)(a->ws + WS_MASK); bf16* mix = (bf16*)(a->ws + WS_MIX); const float* relb = a->in[1];
    LAS float* btab = (LAS float*)(F.lds + att::OFF_BIAS);
    for (int i = F.tid; i < 8 * 129; i += NWAVES * 64) { const int h = i / 129, d = i - h * 129; btab[h * 132 + d] = relb[BUCKET[d] * 8 + h]; }
    __syncthreads();
    for (int u = F.bid; u < 256; u += F.G) {
        const int b = u >> 5, kvh = (u >> 4) & 1, ip = u & 15;
#pragma unroll 1
        for (int half = 0; half < 2; ++half) {
            const int qt = half ? ip : 31 - ip;
            att::attn_unit(qn + (size_t)b * T * 1024, kn + (size_t)b * T * 256 + kvh * 128, proj + (size_t)b * T * NPROJ_P + C_V + kvh * 128, mask + (size_t)b * T * 64, mix + (size_t)b * T * 2048,
                           kvh, qt, relb, (LAS char*)F.lds, F.tid);
        }
    }
}

__device__ __forceinline__ void phase_hgrn(Frame& F, KA a, int l) {
    LAS float* qs = (LAS float*)(F.lds); LAS float* fs = (LAS float*)(F.lds + 16384); LAS float* ks = (LAS float*)(F.lds + 32768); LAS float* vs = (LAS float*)(F.lds + 49152); LAS float* ob = (LAS float*)(F.lds + 65536);
    const bf16* proj = (const bf16*)(a->ws + WS_PROJ); bf16* mix = (bf16*)(a->ws + WS_MIX);
    const float* lbl = a->in[11]; const float* gn = a->in[12] + l * 128;
    const int tid = F.tid, j = tid >> 2, dsl = tid & 3, tt_s = tid >> 4, d8 = (tid & 15) * 8;
    for (int unit = F.bid; unit < BATCH * 8; unit += F.G) {
        const int b = unit >> 3, h = unit & 7;
        float lbv[8];
#pragma unroll
        for (int i = 0; i < 8; ++i) lbv[i] = (l == 0) ? 0.f : sigmf(lbl[1024 + h * 128 + d8 + i] - lbl[h * 128 + d8 + i]);
        float S[32];
#pragma unroll
        for (int i = 0; i < 32; ++i) S[i] = 0.f;
#pragma unroll 1
        for (int c = 0; c < T / 32; ++c) {
            {   const bf16* pr = proj + (size_t)(b * T + c * 32 + tt_s) * NPROJ_P + h * 128 + d8;
                const v4u wq = *(const GAS v4u*)(pr + C_HQ), wfv = *(const GAS v4u*)(pr + C_HF), wi = *(const GAS v4u*)(pr + C_HI);
                const float xq[8] = {blo(wq.x), bhi(wq.x), blo(wq.y), bhi(wq.y), blo(wq.z), bhi(wq.z), blo(wq.w), bhi(wq.w)};
                const float xf[8] = {blo(wfv.x), bhi(wfv.x), blo(wfv.y), bhi(wfv.y), blo(wfv.z), bhi(wfv.z), blo(wfv.w), bhi(wfv.w)};
                const float xi[8] = {blo(wi.x), bhi(wi.x), blo(wi.y), bhi(wi.y), blo(wi.z), bhi(wi.z), blo(wi.w), bhi(wi.w)};
                float q[8], f[8], k[8];
#pragma unroll
                for (int i = 0; i < 8; ++i) { q[i] = siluf(xq[i]) * ATT_SCALE; f[i] = lbv[i] + (1.0f - lbv[i]) * sigmf(xf[i]); k[i] = 1.0f - f[i]; }
                const int o = tt_s * 128 + d8;
                *(LAS f32x4*)(qs + o) = (f32x4){q[0], q[1], q[2], q[3]}; *(LAS f32x4*)(qs + o + 4) = (f32x4){q[4], q[5], q[6], q[7]};
                *(LAS f32x4*)(fs + o) = (f32x4){f[0], f[1], f[2], f[3]}; *(LAS f32x4*)(fs + o + 4) = (f32x4){f[4], f[5], f[6], f[7]};
                *(LAS f32x4*)(ks + o) = (f32x4){k[0], k[1], k[2], k[3]}; *(LAS f32x4*)(ks + o + 4) = (f32x4){k[4], k[5], k[6], k[7]};
                *(LAS f32x4*)(vs + o) = (f32x4){xi[0], xi[1], xi[2], xi[3]}; *(LAS f32x4*)(vs + o + 4) = (f32x4){xi[4], xi[5], xi[6], xi[7]};
            }
            __syncthreads();
#pragma unroll 1
            for (int tt = 0; tt < 32; ++tt) {
                const float v = vs[tt * 128 + j]; float o = 0.f;
                const LAS f32x4* f4 = (const LAS f32x4*)(fs + tt * 128 + dsl * 32); const LAS f32x4* k4 = (const LAS f32x4*)(ks + tt * 128 + dsl * 32); const LAS f32x4* q4 = (const LAS f32x4*)(qs + tt * 128 + dsl * 32);
#pragma unroll
                for (int i4 = 0; i4 < 8; ++i4) { const f32x4 ff = f4[i4], kk = k4[i4], qq = q4[i4];
                    S[4 * i4] = ff.x * S[4 * i4] + kk.x * v; o += qq.x * S[4 * i4];
                    S[4 * i4 + 1] = ff.y * S[4 * i4 + 1] + kk.y * v; o += qq.y * S[4 * i4 + 1];
                    S[4 * i4 + 2] = ff.z * S[4 * i4 + 2] + kk.z * v; o += qq.z * S[4 * i4 + 2];
                    S[4 * i4 + 3] = ff.w * S[4 * i4 + 3] + kk.w * v; o += qq.w * S[4 * i4 + 3]; }
                o += swz<1>(o); o += swz<2>(o);
                if (dsl == 0) ob[tt * 128 + j] = o;
            }
            __syncthreads();
            {   const size_t row = (size_t)(b * T + c * 32 + tt_s);
                const f32x4 o0 = *(const LAS f32x4*)(ob + tt_s * 128 + d8), o1 = *(const LAS f32x4*)(ob + tt_s * 128 + d8 + 4);
                float ss = (o0.x * o0.x + o0.y * o0.y) + (o0.z * o0.z + o0.w * o0.w) + (o1.x * o1.x + o1.y * o1.y) + (o1.z * o1.z + o1.w * o1.w);
                ss += swz<1>(ss); ss += swz<2>(ss); ss += swz<4>(ss); ss += swz<8>(ss);
                const float r = 1.0f / sqrtf(ss * (1.0f / 128.0f) + EPS);
                const v4u wg = *(const GAS v4u*)(proj + row * NPROJ_P + C_HG + h * 128 + d8);
                const float xg[8] = {blo(wg.x), bhi(wg.x), blo(wg.y), bhi(wg.y), blo(wg.z), bhi(wg.z), blo(wg.w), bhi(wg.w)};
                const float ov[8] = {o0.x, o0.y, o0.z, o0.w, o1.x, o1.y, o1.z, o1.w};
                unsigned pw[4];
#pragma unroll
                for (int i = 0; i < 4; ++i) pw[i] = pk2(ov[2 * i] * r * gn[d8 + 2 * i] * siluf(xg[2 * i]), ov[2 * i + 1] * r * gn[d8 + 2 * i + 1] * siluf(xg[2 * i + 1]));
                *(GAS v4u*)(mix + row * 2048 + 1024 + h * 128 + d8) = (v4u){pw[0], pw[1], pw[2], pw[3]};
            }
            __syncthreads();
        }
    }
}


namespace hg {
constexpr int LQ = 272, LT = 144;
constexpr int OFF_G = 0, OFF_TOT = 32768, OFF_BV = 34816, OFF_QH0 = 36864, OFF_QH1 = OFF_QH0 + 64 * LQ, OFF_KH = OFF_QH1 + 32 * LQ, OFF_KP = OFF_KH + 64 * LQ, OFF_K2T = OFF_KP + 64 * LQ, OFF_VT = OFF_K2T + 128 * LT, OFF_END = OFF_VT + 128 * LT;
static_assert(OFF_END <= LDSCTL_OFF, "hgrn LDS map");
__device__ __forceinline__ int crow(int r, int hi) { return (r & 3) + 8 * (r >> 2) + 4 * hi; }
__device__ __forceinline__ bf16x8 pack8(const f32x16& x, int s) { v4u w; w.x = pk2(x[8 * s], x[8 * s + 1]); w.y = pk2(x[8 * s + 2], x[8 * s + 3]); w.z = pk2(x[8 * s + 4], x[8 * s + 5]); w.w = pk2(x[8 * s + 6], x[8 * s + 7]); return __builtin_bit_cast(bf16x8, w); }
__device__ __forceinline__ f32x16 xblock(const LAS unsigned char* Kt, const LAS unsigned char* Qt, int r32, int hi) {
    f32x16 x;
#pragma unroll
    for (int i = 0; i < 16; ++i) x[i] = 0.f;
#pragma unroll
    for (int st = 0; st < 8; ++st) { const bf16x8 ka = *(const LAS bf16x8*)(Kt + r32 * LQ + (16 * st + 8 * hi) * 2), qb = *(const LAS bf16x8*)(Qt + r32 * LQ + (16 * st + 8 * hi) * 2);
        x = __builtin_amdgcn_mfma_f32_32x32x16_bf16(ka, qb, x, 0, 0, 0); }
    return x;
}
__device__ __forceinline__ void xtv(f32x16& od, const f32x16& x_, const LAS unsigned char* vt  , int hi) {
    f32x16 x = x_; asm volatile("s_nop 15\n\ts_nop 3" : "+v"(x));
#pragma unroll
    for (int st = 0; st < 2; ++st) { const v2u lo = *(const LAS v2u*)(vt + (16 * st + 4 * hi) * 2), hi2 = *(const LAS v2u*)(vt + (16 * st + 8 + 4 * hi) * 2);
        const v4u w = {lo.x, lo.y, hi2.x, hi2.y};
        od = __builtin_amdgcn_mfma_f32_32x32x16_bf16(pack8(x, st), __builtin_bit_cast(bf16x8, w), od, 0, 0, 0); }
}
}
__device__ __forceinline__ void phase_hgrn1(Frame& F, KA a, int l) {
    using namespace hg;
    LAS unsigned char* L = F.lds; LAS float* G = (LAS float*)(L + OFF_G); LAS float* TOT = (LAS float*)(L + OFF_TOT); LAS float* BV = (LAS float*)(L + OFF_BV);
    const bf16* proj = (const bf16*)(a->ws + WS_PROJ);
    float* OI = (float*)(a->ws + WS_HOI); bf16* UT = (bf16*)(a->ws + WS_HUT); bf16* QH = (bf16*)(a->ws + WS_HQH); float* DEC = (float*)(a->ws + WS_HDEC);
    const float* lbl = a->in[11];
    const int tid = F.tid, lane = F.lane, r32 = lane & 31, hi = lane >> 5, wave = F.wave;
    for (int u = F.bid; u < BATCH * 8 * 32; u += F.G) {
        const int c = u & 31, h = (u >> 5) & 7, b = u >> 8; const size_t row0 = (size_t)b * T + 64 * c;
        float qv[2][8], kv[2][8];
#pragma unroll
        for (int k = 0; k < 2; ++k) { const int slot = tid + 512 * k, t = slot >> 4, d8 = (slot & 15) * 8;
            const bf16* pr = proj + (row0 + t) * NPROJ_P + h * 128 + d8;
            const v4u wq = *(const GAS v4u*)(pr + C_HQ), wf = *(const GAS v4u*)(pr + C_HF), wi = *(const GAS v4u*)(pr + C_HI);
            const float xq[8] = {blo(wq.x), bhi(wq.x), blo(wq.y), bhi(wq.y), blo(wq.z), bhi(wq.z), blo(wq.w), bhi(wq.w)};
            const float xf[8] = {blo(wf.x), bhi(wf.x), blo(wf.y), bhi(wf.y), blo(wf.z), bhi(wf.z), blo(wf.w), bhi(wf.w)};
            float g[8];
#pragma unroll
            for (int i = 0; i < 8; ++i) { const float lb = (l == 0) ? 0.f : sigmf(lbl[1024 + h * 128 + d8 + i] - lbl[h * 128 + d8 + i]);
                const float f = lb + (1.0f - lb) * sigmf(xf[i]); qv[k][i] = siluf(xq[i]) * ATT_SCALE; kv[k][i] = 1.0f - f; g[i] = __logf(f); }
            *(LAS f32x4*)(G + t * 128 + d8) = (f32x4){g[0], g[1], g[2], g[3]}; *(LAS f32x4*)(G + t * 128 + d8 + 4) = (f32x4){g[4], g[5], g[6], g[7]};
            const unsigned vw[4] = {wi.x, wi.y, wi.z, wi.w};
#pragma unroll
            for (int i = 0; i < 8; ++i) *(LAS bf16*)(L + OFF_VT + (d8 + i) * LT + t * 2) = (bf16)((i & 1) ? (vw[i >> 1] >> 16) : (vw[i >> 1] & 0xffffu));
        }
        __syncthreads();
        { const int d = tid & 127, sb = tid >> 7; float run = 0.f;
#pragma unroll
            for (int i = 0; i < 16; ++i) { run += G[(16 * sb + i) * 128 + d]; G[(16 * sb + i) * 128 + d] = run; }
            TOT[sb * 128 + d] = run;
            __syncthreads();
            float off = 0.f;
#pragma unroll
            for (int q = 0; q < 3; ++q) off += (q < sb) ? TOT[q * 128 + d] : 0.f;
#pragma unroll
            for (int i = 0; i < 16; ++i) G[(16 * sb + i) * 128 + d] += off;
            if (sb == 0) { const float b1 = TOT[d] + TOT[128 + d], bl = b1 + TOT[256 + d] + TOT[384 + d]; BV[d] = b1; BV[128 + d] = bl;
                DEC[(size_t)u * 128 + d] = __expf(bl); }
        }
        __syncthreads();
#pragma unroll
        for (int k = 0; k < 2; ++k) { const int slot = tid + 512 * k, t = slot >> 4, d8 = (slot & 15) * 8; const int J = t >> 5;
            const f32x4 ba = *(const LAS f32x4*)(G + t * 128 + d8), bb = *(const LAS f32x4*)(G + t * 128 + d8 + 4);
            const f32x4 b1a = *(const LAS f32x4*)(BV + d8), b1b = *(const LAS f32x4*)(BV + d8 + 4), bla = *(const LAS f32x4*)(BV + 128 + d8), blb = *(const LAS f32x4*)(BV + 128 + d8 + 4);
            const float bt[8] = {ba.x, ba.y, ba.z, ba.w, bb.x, bb.y, bb.z, bb.w}, b1[8] = {b1a.x, b1a.y, b1a.z, b1a.w, b1b.x, b1b.y, b1b.z, b1b.w}, bl[8] = {bla.x, bla.y, bla.z, bla.w, blb.x, blb.y, blb.z, blb.w};
            float q0[8], q1[8], kh[8], kp[8], k2[8];
#pragma unroll
            for (int i = 0; i < 8; ++i) { const float bj = J ? b1[i] : 0.f, bj1 = J ? bl[i] : b1[i];
                q0[i] = qv[k][i] * __expf(bt[i]); q1[i] = qv[k][i] * __expf(bt[i] - b1[i]);
                kh[i] = kv[k][i] * __expf(bj1 - bt[i]); kp[i] = kv[k][i] * __expf(fminf(bj - bt[i], 80.f)); k2[i] = kv[k][i] * __expf(bl[i] - bt[i]); }
            const v4u w0 = {pk2(q0[0], q0[1]), pk2(q0[2], q0[3]), pk2(q0[4], q0[5]), pk2(q0[6], q0[7])};
            *(LAS v4u*)(L + OFF_QH0 + t * LQ + d8 * 2) = w0; *(GAS v4u*)(QH + (row0 + t) * 1024 + h * 128 + d8) = w0;
            if (J) *(LAS v4u*)(L + OFF_QH1 + (t - 32) * LQ + d8 * 2) = (v4u){pk2(q1[0], q1[1]), pk2(q1[2], q1[3]), pk2(q1[4], q1[5]), pk2(q1[6], q1[7])};
            *(LAS v4u*)(L + OFF_KH + t * LQ + d8 * 2) = (v4u){pk2(kh[0], kh[1]), pk2(kh[2], kh[3]), pk2(kh[4], kh[5]), pk2(kh[6], kh[7])};
            *(LAS v4u*)(L + OFF_KP + t * LQ + d8 * 2) = (v4u){pk2(kp[0], kp[1]), pk2(kp[2], kp[3]), pk2(kp[4], kp[5]), pk2(kp[6], kp[7])};
#pragma unroll
            for (int i = 0; i < 8; ++i) *(LAS bf16*)(L + OFF_K2T + (d8 + i) * LT + t * 2) = (bf16)f2bf(k2[i]);
        }
        __syncthreads();
        { const int I = wave >> 2, dvb = wave & 3;
            f32x16 od;
#pragma unroll
            for (int i = 0; i < 16; ++i) od[i] = 0.f;
            const LAS unsigned char* vrow = L + OFF_VT + (32 * dvb + r32) * LT;
            if (I == 0) {
                f32x16 x = xblock(L + OFF_KP, L + OFF_QH0, r32, hi);
#pragma unroll
                for (int i = 0; i < 16; ++i) x[i] = (crow(i, hi) <= r32) ? x[i] : 0.f;
                xtv(od, x, vrow, hi);
            } else {
                f32x16 x = xblock(L + OFF_KH, L + OFF_QH1, r32, hi);
                xtv(od, x, vrow, hi);
                x = xblock(L + OFF_KP + 32 * LQ, L + OFF_QH1, r32, hi);
#pragma unroll
                for (int i = 0; i < 16; ++i) x[i] = (crow(i, hi) <= r32) ? x[i] : 0.f;
                xtv(od, x, vrow + 64, hi);
            }
            float* op = OI + (row0 + 32 * I) * 1024 + h * 128 + 32 * dvb + r32;
#pragma unroll
            for (int i = 0; i < 16; ++i) op[(size_t)crow(i, hi) * 1024] = od[i];
#pragma unroll
            for (int e = 0; e < 2; ++e) { const int dvb2 = wave >> 1, dkb = 2 * (wave & 1) + e;
                f32x16 uacc;
#pragma unroll
                for (int i = 0; i < 16; ++i) uacc[i] = 0.f;
#pragma unroll
                for (int st = 0; st < 4; ++st) { const bf16x8 va = *(const LAS bf16x8*)(L + OFF_VT + (32 * dvb2 + r32) * LT + (16 * st + 8 * hi) * 2), kb = *(const LAS bf16x8*)(L + OFF_K2T + (32 * dkb + r32) * LT + (16 * st + 8 * hi) * 2);
                    uacc = __builtin_amdgcn_mfma_f32_32x32x16_bf16(va, kb, uacc, 0, 0, 0); }
                bf16* up = UT + (size_t)u * 16384 + (size_t)(32 * dvb2) * 128 + 32 * dkb + r32;
#pragma unroll
                for (int i = 0; i < 16; ++i) up[crow(i, hi) * 128] = (bf16)f2bf(uacc[i]);
            }
        }
        __syncthreads();
    }
}
__device__ __forceinline__ void phase_hgrn2(Frame& F, KA a, int l) {
    LAS unsigned char* L = F.lds; constexpr int LS = 272; LAS float* OB = (LAS float*)(L + 36864); LAS float* DECS = (LAS float*)(L + 69632); LAS unsigned char* QS = L + 70656;
    const bf16* proj = (const bf16*)(a->ws + WS_PROJ); bf16* mix = (bf16*)(a->ws + WS_MIX);
    const float* OI = (const float*)(a->ws + WS_HOI); const bf16* UT = (const bf16*)(a->ws + WS_HUT); const bf16* QH = (const bf16*)(a->ws + WS_HQH); const float* DEC = (const float*)(a->ws + WS_HDEC);
    const float* gn = a->in[12] + l * 128;
    const int tid = F.tid, lane = F.lane, r32 = lane & 31, hi = lane >> 5, wave = F.wave;
    const int dv = tid >> 2, dkq = tid & 3, I = wave >> 2, dvb = wave & 3, tn = tid >> 3, d16 = (tid & 7) * 16;
    for (int u = F.bid; u < BATCH * 8; u += F.G) {
        const int b = u >> 3, h = u & 7;
        float S[32];
#pragma unroll
        for (int i = 0; i < 32; ++i) S[i] = 0.f;
#pragma unroll
        for (int i = 0; i < 4; ++i) *(LAS v4u*)(L + dv * LS + (32 * dkq + 8 * i) * 2) = (v4u){0u, 0u, 0u, 0u};
        v4u qn0, qn1, g0, g1, uw[4]; f32x4 oi[4]; float dn = 0.f;
#define H2_ROWQ(c) (QH + ((size_t)b * T + 64 * (c) + tn) * 1024 + h * 128 + d16)
#define H2_LDQ(c) do { qn0 = *(const GAS v4u*)(H2_ROWQ(c)); qn1 = *(const GAS v4u*)(H2_ROWQ(c) + 8); if (tid < 128) dn = DEC[((size_t)u * 32 + (c)) * 128 + tid]; } while (0)
#define H2_STQ(c) do { *(LAS v4u*)(QS + ((c) & 1) * (64 * LS) + tn * LS + d16 * 2) = qn0; *(LAS v4u*)(QS + ((c) & 1) * (64 * LS) + tn * LS + d16 * 2 + 16) = qn1; if (tid < 128) DECS[((c) & 1) * 128 + tid] = dn; } while (0)
#define H2_LDN(c) do { const size_t row_ = (size_t)b * T + 64 * (c) + tn; \
            _Pragma("unroll") for (int i = 0; i < 4; ++i) oi[i] = *(const GAS f32x4*)(OI + row_ * 1024 + h * 128 + d16 + 4 * i); \
            g0 = *(const GAS v4u*)(proj + row_ * NPROJ_P + C_HG + h * 128 + d16); g1 = *(const GAS v4u*)(proj + row_ * NPROJ_P + C_HG + h * 128 + d16 + 8); } while (0)
#define H2_LDU(c) do { _Pragma("unroll") for (int i = 0; i < 4; ++i) uw[i] = *(const GAS v4u*)(UT + ((size_t)u * 32 + (c)) * 16384 + (size_t)dv * 128 + 32 * dkq + 8 * i); } while (0)
        H2_LDQ(0); H2_LDN(0); H2_LDU(0); H2_STQ(0);
#pragma unroll 1
        for (int c = 0; c < 32; ++c) {
            const size_t row0 = (size_t)b * T + 64 * c;
            if (c + 1 < 32) H2_LDQ(c + 1);
            __syncthreads();
            f32x16 acc;
#pragma unroll
            for (int i = 0; i < 16; ++i) acc[i] = 0.f;
            const LAS unsigned char* qs = QS + (c & 1) * (64 * LS) + (32 * I + r32) * LS + 16 * hi;
#pragma unroll
            for (int st = 0; st < 8; ++st) { const bf16x8 qa = *(const LAS bf16x8*)(qs + 32 * st), sb = *(const LAS bf16x8*)(L + (32 * dvb + r32) * LS + (16 * st + 8 * hi) * 2);
                acc = __builtin_amdgcn_mfma_f32_32x32x16_bf16(qa, sb, acc, 0, 0, 0); }
#pragma unroll
            for (int i = 0; i < 16; ++i) OB[(32 * I + hg::crow(i, hi)) * 128 + 32 * dvb + r32] = acc[i];
            __syncthreads();
            {
                const size_t row = row0 + tn; float ov[16]; float ss = 0.f;
#pragma unroll
                for (int i = 0; i < 4; ++i) { const f32x4 o4 = *(const LAS f32x4*)(OB + tn * 128 + d16 + 4 * i) + oi[i]; ov[4 * i] = o4.x; ov[4 * i + 1] = o4.y; ov[4 * i + 2] = o4.z; ov[4 * i + 3] = o4.w; ss += (o4.x * o4.x + o4.y * o4.y) + (o4.z * o4.z + o4.w * o4.w); }
                ss += swz<1>(ss); ss += swz<2>(ss); ss += swz<4>(ss);
                const float r = __builtin_amdgcn_rsqf(ss * (1.0f / 128.0f) + EPS);
                const float xg[16] = {blo(g0.x), bhi(g0.x), blo(g0.y), bhi(g0.y), blo(g0.z), bhi(g0.z), blo(g0.w), bhi(g0.w), blo(g1.x), bhi(g1.x), blo(g1.y), bhi(g1.y), blo(g1.z), bhi(g1.z), blo(g1.w), bhi(g1.w)};
                unsigned pw[8];
#pragma unroll
                for (int i = 0; i < 8; ++i) pw[i] = pk2(ov[2 * i] * r * gn[d16 + 2 * i] * siluf(xg[2 * i]), ov[2 * i + 1] * r * gn[d16 + 2 * i + 1] * siluf(xg[2 * i + 1]));
                *(GAS v4u*)(mix + row * 2048 + 1024 + h * 128 + d16) = (v4u){pw[0], pw[1], pw[2], pw[3]}; *(GAS v4u*)(mix + row * 2048 + 1024 + h * 128 + d16 + 8) = (v4u){pw[4], pw[5], pw[6], pw[7]};
            }
            if (c + 1 < 32) H2_LDN(c + 1);
            {
                const LAS float* dcs = DECS + (c & 1) * 128 + 32 * dkq;
#pragma unroll
                for (int i = 0; i < 4; ++i) { const unsigned ww[4] = {uw[i].x, uw[i].y, uw[i].z, uw[i].w};
                    const f32x4 d0 = *(const LAS f32x4*)(dcs + 8 * i), d1 = *(const LAS f32x4*)(dcs + 8 * i + 4); const float dcf[8] = {d0.x, d0.y, d0.z, d0.w, d1.x, d1.y, d1.z, d1.w};
#pragma unroll
                    for (int q = 0; q < 4; ++q) { S[8 * i + 2 * q] = dcf[2 * q] * S[8 * i + 2 * q] + blo(ww[q]); S[8 * i + 2 * q + 1] = dcf[2 * q + 1] * S[8 * i + 2 * q + 1] + bhi(ww[q]); }
                    *(LAS v4u*)(L + dv * LS + (32 * dkq + 8 * i) * 2) = (v4u){pk2(S[8 * i], S[8 * i + 1]), pk2(S[8 * i + 2], S[8 * i + 3]), pk2(S[8 * i + 4], S[8 * i + 5]), pk2(S[8 * i + 6], S[8 * i + 7])}; }
            }
            if (c + 1 < 32) { H2_LDU(c + 1); H2_STQ(c + 1); }
        }
#undef H2_ROWQ
#undef H2_LDQ
#undef H2_STQ
#undef H2_LDN
#undef H2_LDU
        __syncthreads();
    }
}

__device__ __forceinline__ void phase_norm_router(Frame& F, KA a, const float* src, bf16* dst) {
    LAS int* lcnt = (LAS int*)(F.lds); LAS int* lbase = (LAS int*)(F.lds + 64); LAS int* stash = (LAS int*)(F.lds + 128);
    float* rstd2 = (float*)(a->ws + WS_TAB + TAB_RSTD2); int* toke = (int*)(a->ws + WS_TAB + TAB_TOKE); int* tokpos = (int*)(a->ws + WS_TAB + TAB_TOKPOS); float* tokp = (float*)(a->ws + WS_TAB + TAB_TOKP);
    unsigned* gcnt = (unsigned*)(a->ws + WS_CTL) + CW_ECNT;
    const float* gain = a->in[3] + 2048; const float* wr = a->in[19];
    const int lane = F.lane;
    for (int chunk = F.bid; chunk < M / 64; chunk += F.G) {
        if (F.tid < 8) lcnt[F.tid] = 0;
        __syncthreads();
#pragma unroll 1
        for (int rr = 0; rr < 8; ++rr) {
            const int lrow = F.wave * 8 + rr; const size_t row = (size_t)chunk * 64 + lrow;
            const GAS f32x4* xr = (const GAS f32x4*)(src + row * D) + lane;
            f32x4 v[8]; float s = 0.f;
#pragma unroll
            for (int jj = 0; jj < 8; ++jj) { v[jj] = xr[64 * jj]; s += (v[jj].x * v[jj].x + v[jj].y * v[jj].y) + (v[jj].z * v[jj].z + v[jj].w * v[jj].w); }
            s = wave_sum(s); const float r = 1.0f / sqrtf(s * (1.0f / D) + EPS);
            GAS v2u* o8 = (GAS v2u*)(dst + row * D) + lane;
            float lg[8] = {0.f, 0.f, 0.f, 0.f, 0.f, 0.f, 0.f, 0.f};
#pragma unroll
            for (int jj = 0; jj < 8; ++jj) { v2u w; w.x = pk2(v[jj].x, v[jj].y); w.y = pk2(v[jj].z, v[jj].w); o8[64 * jj] = w;
                const int d0 = 4 * lane + 256 * jj; const f32x4 g4 = *(const GAS f32x4*)(gain + d0);
                const float xg[4] = {v[jj].x * g4.x, v[jj].y * g4.y, v[jj].z * g4.z, v[jj].w * g4.w};
#pragma unroll
                for (int q = 0; q < 4; ++q) { const f32x4 wa = *(const GAS f32x4*)(wr + (size_t)(d0 + q) * 8), wb = *(const GAS f32x4*)(wr + (size_t)(d0 + q) * 8 + 4);
                    lg[0] += xg[q] * wa.x; lg[1] += xg[q] * wa.y; lg[2] += xg[q] * wa.z; lg[3] += xg[q] * wa.w; lg[4] += xg[q] * wb.x; lg[5] += xg[q] * wb.y; lg[6] += xg[q] * wb.z; lg[7] += xg[q] * wb.w; } }
#pragma unroll
            for (int e = 0; e < 8; ++e) lg[e] = wave_sum(lg[e]) * r;
            int e0 = 0; float v0 = lg[0];
#pragma unroll
            for (int e = 1; e < 8; ++e) if (lg[e] > v0) { v0 = lg[e]; e0 = e; }
            int e1 = -1; float v1 = -INFINITY;
#pragma unroll
            for (int e = 0; e < 8; ++e) if (e != e0 && lg[e] > v1) { v1 = lg[e]; e1 = e; }
            const float p0 = 1.0f / (1.0f + __expf(v1 - v0)), p1 = 1.0f - p0;
            if (lane == 0) { rstd2[row] = r; const int lp0 = atomicAdd((int*)lcnt + e0, 1), lp1 = atomicAdd((int*)lcnt + e1, 1);
                stash[lrow * 4] = e0; stash[lrow * 4 + 1] = e1; stash[lrow * 4 + 2] = lp0; stash[lrow * 4 + 3] = lp1; tokp[row * 2] = p0; tokp[row * 2 + 1] = p1; }
        }
        __syncthreads();
        if (F.tid < 8) lbase[F.tid] = (int)__hip_atomic_fetch_add(gcnt + F.tid, (unsigned)lcnt[F.tid], __ATOMIC_RELAXED, __HIP_MEMORY_SCOPE_AGENT);
        __syncthreads();
        if (F.tid < 64) { const size_t row = (size_t)chunk * 64 + F.tid; const int e0 = stash[F.tid * 4], e1 = stash[F.tid * 4 + 1];
            toke[row * 2] = e0; toke[row * 2 + 1] = e1; tokpos[row * 2] = lbase[e0] + stash[F.tid * 4 + 2]; tokpos[row * 2 + 1] = lbase[e1] + stash[F.tid * 4 + 3]; }
        __syncthreads();
    }
}
struct ExpTab { int t[9]; };
__device__ __forceinline__ void load_exptab(KA a, int (&off)[9]) {
    const unsigned* gcnt = (const unsigned*)(a->ws + WS_CTL) + CW_ECNT;
    off[0] = 0;
#pragma unroll
    for (int e = 0; e < 8; ++e) { const unsigned c = __hip_atomic_load(gcnt + e, __ATOMIC_RELAXED, __HIP_MEMORY_SCOPE_AGENT); off[e + 1] = off[e] + (int)((c + 255u) >> 8); }
}
__device__ __forceinline__ void phase_gather(Frame& F, KA a) {
    int off[9]; load_exptab(a, off);
    const bf16* hb = (const bf16*)(a->ws + WS_HB); bf16* hs = (bf16*)(a->ws + WS_HSX);
    const float* rstd2 = (const float*)(a->ws + WS_TAB + TAB_RSTD2); float* rstds = (float*)(a->ws + WS_TAB + TAB_RSTDS);
    const int* toke = (const int*)(a->ws + WS_TAB + TAB_TOKE); const int* tokpos = (const int*)(a->ws + WS_TAB + TAB_TOKPOS); int* tokdest = (int*)(a->ws + WS_TAB + TAB_TOKDEST);
    const int gw = F.bid * NWAVES + F.wave, NGW = F.G * NWAVES;
    for (int pair = gw; pair < 2 * M; pair += NGW) {
        const int tok = pair >> 1; const int e = toke[pair], pos = tokpos[pair];
        int o = off[0];
#pragma unroll
        for (int q = 1; q < 8; ++q) o = (e == q) ? off[q] : o;
        const int dest = o * 256 + pos;
        const GAS v4u* s = (const GAS v4u*)(hb + (size_t)tok * D) + F.lane; GAS v2u* dd = (GAS v2u*)((unsigned char*)hs + (size_t)dest * D) + F.lane;
#pragma unroll
        for (int jj = 0; jj < 4; ++jj) { const v4u w = s[64 * jj]; unsigned w0 = 0u, w1 = 0u;
            w0 = __builtin_amdgcn_cvt_pk_fp8_f32(blo(w.x), bhi(w.x), w0, false); w0 = __builtin_amdgcn_cvt_pk_fp8_f32(blo(w.y), bhi(w.y), w0, true);
            w1 = __builtin_amdgcn_cvt_pk_fp8_f32(blo(w.z), bhi(w.z), w1, false); w1 = __builtin_amdgcn_cvt_pk_fp8_f32(blo(w.w), bhi(w.w), w1, true);
            dd[64 * jj] = (v2u){w0, w1}; }
        if (F.lane == 0) { rstds[dest] = rstd2[tok]; tokdest[pair] = dest; }
    }
}
__device__ __forceinline__ void phase_combine(Frame& F, KA a) {
    const float* y = (const float*)(a->ws + WS_Y); const int* tokdest = (const int*)(a->ws + WS_TAB + TAB_TOKDEST); const float* tokp = (const float*)(a->ws + WS_TAB + TAB_TOKP);
    const int gw = F.bid * NWAVES + F.wave, NGW = F.G * NWAVES;
    for (int row = gw; row < M; row += NGW) {
        const int d0 = tokdest[2 * row], d1 = tokdest[2 * row + 1]; const float p0 = tokp[2 * row], p1 = tokp[2 * row + 1];
        GAS f32x4* o = (GAS f32x4*)(a->out + (size_t)row * D) + F.lane; const GAS f32x4* y0 = (const GAS f32x4*)(y + (size_t)d0 * D) + F.lane; const GAS f32x4* y1 = (const GAS f32x4*)(y + (size_t)d1 * D) + F.lane;
#pragma unroll
        for (int jj = 0; jj < 8; ++jj) o[64 * jj] = o[64 * jj] + y0[64 * jj] * p0 + y1[64 * jj] * p1;
    }
}

#ifndef MK_ONE_LAUNCH
#define MK_ONE_LAUNCH 1
#endif
constexpr int PH_PER_LAYER = 16, NPHASE = 2 * PH_PER_LAYER;
constexpr int CONV_GG = 128;
__global__ void __launch_bounds__(NWAVES * 64, 2) mk_fwd(Args args) {
    extern __shared__ __attribute__((aligned(16))) unsigned char lds[];
    LAS unsigned char* const ldsb = (LAS unsigned char*)lds;
    const int wave_s = __builtin_amdgcn_readfirstlane(threadIdx.x >> 6);
    for (int u = threadIdx.x; u < (LDS_BYTES - LDSCTL_OFF) / 4; u += NWAVES * 64) ((LAS unsigned*)(ldsb + LDSCTL_OFF))[u] = 0u;
    __syncthreads();
    XcdBarrier bar; bar.bar = nullptr; bar.x = 0; bar.st = nullptr;
    if (MK_ONE_LAUNCH) { KA a = ka_get(); bar = xcd_barrier_post((unsigned*)(a->ws + WS_CTL) + CW_BAR, (volatile LAS unsigned*)(ldsb + MISC_OFF) + 8); }
    const int lo = args.ph_lo, hi = args.ph_hi;
#define IN(k) in_range((k), lo, hi)
#define SEAM(k) do { if (MK_ONE_LAUNCH && IN(k) && IN((k) + 1)) { XcdBarrier b2_ = bar; asm volatile("" : "+s"(b2_.bar)); xcd_barrier(b2_); } } while (0)
#pragma unroll 1
    for (int l = 0; l < 2; ++l) {
        const int pb = l * PH_PER_LAYER;
        if (IN(pb + 0)) { KA a = ka_get(); Frame F = make_frame(ldsb, wave_s); unsigned char* ws = a->ws; if (l == 0) phase_conv(F, a, 0, F.G == 256 ? 1 : 16, F.bid, F.G);
            phase_norm_t<true>(F, (l == 0) ? a->in[0] : (const float*)(ws + WS_H), (bf16*)(ws + WS_XB), (float*)(ws + WS_RSTD1)); }
        SEAM(pb + 0);
        if (IN(pb + 1)) { KA a = ka_get(); Frame F = make_frame(ldsb, wave_s); unsigned char* ws = a->ws;
            const bool split = (l == 0 && F.G == 256);
            const int Gv = split ? CONV_GG : F.G;
            if (F.bid < Gv) {
                pg8::Gemm g{(const bf16*)(ws + WS_XB), (const bf16*)(ws + WS_WIN + l * WIN_SZ), M, NPROJ_P, D / 2, D / 2, F.tid, 0x7f7f7f7f, 0x79797979};     pg8::StaticOrder S; S.init(M, F.G == 256 ? NPROJ_P - 256 : NPROJ_P, Gv, F.bid);
                pg8::EpiScaleBf16 E{(bf16*)(ws + WS_PROJ), NPROJ_P, (const float*)(ws + WS_RSTD1)};
                pg8::gemm_phase<pg8::EpiScaleBf16, pg8::StaticOrder, true, true, true>(F.lds + RING_OFF, g, S, E);
            } else phase_conv(F, a, 1, 16, F.bid - CONV_GG, F.G - CONV_GG);
        }
        SEAM(pb + 1);
        if (IN(pb + 2)) { KA a = ka_get(); Frame F = make_frame(ldsb, wave_s); phase_post(F, a, l); }
        SEAM(pb + 2);
        if (IN(pb + 3)) { KA a = ka_get(); Frame F = make_frame(ldsb, wave_s); unsigned char* ws = a->ws;
            pg8::Gemm g{(const bf16*)(ws + WS_PROJ) + C_CQ, (const bf16*)(ws + WS_WIDX + l * WIDX_SZ), M, 1024, 512, NPROJ_P, F.tid, 0, 0}; pg8::StaticOrder S; S.init(M, 1024, F.G, F.bid);
            pg8::EpiScaleBf16 E{(bf16*)(ws + WS_QIDX), 1024, (const float*)(ws + WS_RSTDCQ)};
            pg8::gemm_phase<pg8::EpiScaleBf16, pg8::StaticOrder, true, true>(F.lds + RING_OFF, g, S, E);
        }
        SEAM(pb + 3);
        if (IN(pb + 4)) { KA a = ka_get(); Frame F = make_frame(ldsb, wave_s); phase_index2(F, a); }
        SEAM(pb + 4);
        if (IN(pb + 5)) { KA a = ka_get(); Frame F = make_frame(ldsb, wave_s); phase_attn2(F, a); }
        SEAM(pb + 5);
        if (IN(pb + 6)) { KA a = ka_get(); Frame F = make_frame(ldsb, wave_s); phase_hgrn1(F, a, l); }
        SEAM(pb + 6);
        if (IN(pb + 7)) { KA a = ka_get(); Frame F = make_frame(ldsb, wave_s); unsigned char* ws = a->ws;
            const bool split = F.G >= 128;
            if (!split || F.bid < 64) phase_hgrn2(F, a, l);
            if (!split || F.bid >= 64) {
                pg8::Gemm g{(const bf16*)(ws + WS_MIX), (const bf16*)(ws + WS_WUA + l * WU_SZ), M, D, 1024, D, F.tid, 0, 0}; pg8::StaticOrder S; S.init(M, D, split ? F.G - 64 : F.G, split ? F.bid - 64 : F.bid);
                pg8::EpiGate<0> E{(float*)(ws + WS_TMP), nullptr, D, (const bf16*)(ws + WS_PROJ) + C_GA, NPROJ_P};
                pg8::gemm_phase<pg8::EpiGate<0>, pg8::StaticOrder, true, true>(F.lds + RING_OFF, g, S, E);
            }
            if (F.G == 256 && F.bid >= 192) {
                pg8::Gemm g{(const bf16*)(ws + WS_XB), (const bf16*)(ws + WS_WIN + l * WIN_SZ), M, NPROJ_P, D / 2, D / 2, F.tid, 0x7f7f7f7f, 0x79797979};     pg8::OneUnit S{F.bid - 192, NPROJ_P / 256 - 1, true};
                pg8::EpiScaleBf16 E{(bf16*)(ws + WS_PROJ), NPROJ_P, (const float*)(ws + WS_RSTD1)};
                pg8::gemm_phase<pg8::EpiScaleBf16, pg8::OneUnit, true, true, true>(F.lds + RING_OFF, g, S, E);
            }
        }
        SEAM(pb + 7);
        if (IN(pb + 9)) { KA a = ka_get(); Frame F = make_frame(ldsb, wave_s); unsigned char* ws = a->ws;
            pg8::Gemm g{(const bf16*)(ws + WS_MIX) + 1024, (const bf16*)(ws + WS_WUH + l * WU_SZ), M, D, 1024, D, F.tid, 0, 0}; pg8::StaticOrder S; S.init(M, D, F.G, F.bid);
            pg8::EpiGate<1> E{(float*)(ws + WS_TMP), (bf16*)(ws + WS_MRG), D, (const bf16*)(ws + WS_PROJ) + C_GH, NPROJ_P};
            pg8::gemm_phase<pg8::EpiGate<1>, pg8::StaticOrder, true, true>(F.lds + RING_OFF, g, S, E);
        }
        SEAM(pb + 9);
        if (IN(pb + 10)) { KA a = ka_get(); Frame F = make_frame(ldsb, wave_s); unsigned char* ws = a->ws;
            pg8::Gemm g{(const bf16*)(ws + WS_MRG), (const bf16*)(ws + WS_WO + l * WO_SZ), M, D, D, D, F.tid, 0, 0}; pg8::StaticOrder S; S.init(M, D, F.G, F.bid);
            pg8::EpiResF32 E{(l == 0) ? a->in[0] : (const float*)(ws + WS_H), (l == 0) ? (float*)(ws + WS_H) : a->out, D, 1 << 20};
            pg8::gemm_phase<pg8::EpiResF32, pg8::StaticOrder, true, true>(F.lds + RING_OFF, g, S, E);
        }
        SEAM(pb + 10);
        if (IN(pb + 11)) { KA a = ka_get(); Frame F = make_frame(ldsb, wave_s); unsigned char* ws = a->ws;
            if (l == 0) phase_norm_t<false>(F, (const float*)(ws + WS_H), (bf16*)(ws + WS_HB), (float*)(ws + WS_TAB + TAB_RSTD2)); else phase_norm_router(F, a, a->out, (bf16*)(ws + WS_HB)); }
        SEAM(pb + 11);
        if (l == 0) {
            if (IN(pb + 12)) { KA a = ka_get(); Frame F = make_frame(ldsb, wave_s); unsigned char* ws = a->ws;
                pg8::Gemm g{(const bf16*)(ws + WS_HB), (const bf16*)(ws + WS_W13D), M, 2 * FFD, D, D, F.tid, 0, 0}; pg8::StaticOrder S; S.init(M, 2 * FFD, F.G, F.bid);
                pg8::EpiSwiGLU E{(bf16*)(ws + WS_PROJ), FFD, 1 << 20, (const float*)(ws + WS_TAB + TAB_RSTD2)};
                pg8::gemm_phase<pg8::EpiSwiGLU, pg8::StaticOrder, true, true>(F.lds + RING_OFF, g, S, E);
            }
            SEAM(pb + 12);
            if (IN(pb + 13)) { KA a = ka_get(); Frame F = make_frame(ldsb, wave_s); unsigned char* ws = a->ws;
                pg8::Gemm g{(const bf16*)(ws + WS_PROJ), (const bf16*)(ws + WS_W2D), M, D, FFD, FFD, F.tid, 0, 0}; pg8::StaticOrder S; S.init(M, D, F.G, F.bid);
                pg8::EpiResF32 E{(const float*)(ws + WS_H), (float*)(ws + WS_H), D, 1 << 20};
                pg8::gemm_phase<pg8::EpiResF32, pg8::StaticOrder, true, true>(F.lds + RING_OFF, g, S, E);
            }
            SEAM(pb + 13);
        } else {
            if (IN(pb + 12)) { KA a = ka_get(); Frame F = make_frame(ldsb, wave_s); phase_gather(F, a); }
            SEAM(pb + 12);
            if (IN(pb + 13)) { KA a = ka_get(); Frame F = make_frame(ldsb, wave_s); unsigned char* ws = a->ws;
                int off[9]; load_exptab(a, off);
                pg8::Gemm g{(const bf16*)(ws + WS_HSX), (const bf16*)(ws + WS_W13M), MS, 2 * FFE, D / 2, D / 2, F.tid, 0x7f7f7f7f, 0x79797979};
                pg8::MoeOrder S{F.G, F.bid, 2 * FFE / 256, off[0], off[1], off[2], off[3], off[4], off[5], off[6], off[7], off[8]};
                pg8::EpiSwiGLUT<true> E{(bf16*)(ws + WS_ACTM), FFE, 2 * FFE / 256, (const float*)(ws + WS_TAB + TAB_RSTDS)};
                pg8::gemm_phase<pg8::EpiSwiGLUT<true>, pg8::MoeOrder, true, true, true>(F.lds + RING_OFF, g, S, E);
            }
            SEAM(pb + 13);
            if (IN(pb + 14)) { KA a = ka_get(); Frame F = make_frame(ldsb, wave_s); unsigned char* ws = a->ws;
                int off[9]; load_exptab(a, off);
                pg8::Gemm g{(const bf16*)(ws + WS_ACTM), (const bf16*)(ws + WS_W2M), MS, D, FFE / 2, FFE / 2, F.tid, 0x7c7c7c7c, 0x79797979};
                pg8::MoeOrder S{F.G, F.bid, D / 256, off[0], off[1], off[2], off[3], off[4], off[5], off[6], off[7], off[8]};
                pg8::EpiResF32 E{nullptr, (float*)(ws + WS_Y), D, D / 256};
                pg8::gemm_phase<pg8::EpiResF32, pg8::MoeOrder, true, true, true>(F.lds + RING_OFF, g, S, E);
            }
            SEAM(pb + 14);
            if (IN(pb + 15)) { KA a = ka_get(); Frame F = make_frame(ldsb, wave_s); phase_combine(F, a); }
        }
    }
#undef IN
#undef SEAM
}

extern "C" void kernel_launch(void* const* d_in, const int* in_sizes, int n_in, void* d_out, int out_size, void* d_ws, size_t ws_size, hipStream_t stream) {
    static int grid = 0;
    if (grid == 0) {
        if (n_in != 23 || out_size != M * D || ws_size < WS_END) { fprintf(stderr, "kernel_launch: unexpected shapes (n_in %d out %d ws %zu need %zu)\n", n_in, out_size, ws_size, (size_t)WS_END); grid = -1; return; }
        int dev = 0, cus = 0, per_cu = 0;
        if (hipGetDevice(&dev) != hipSuccess || hipDeviceGetAttribute(&cus, hipDeviceAttributeMultiprocessorCount, dev) != hipSuccess) { grid = -1; return; }
        if (hipFuncSetAttribute((const void*)mk_fwd, hipFuncAttributeMaxDynamicSharedMemorySize, LDS_BYTES) != hipSuccess) { fprintf(stderr, "kernel_launch: hipFuncSetAttribute failed\n"); grid = -1; return; }
        if (hipOccupancyMaxActiveBlocksPerMultiprocessor(&per_cu, (const void*)mk_fwd, NWAVES * 64, LDS_BYTES) != hipSuccess || per_cu < 1) fprintf(stderr, "kernel_launch: occupancy query says %d\n", per_cu);
        (void)hipGetLastError();
        grid = cus;
    }
    if (grid < 0) return;
    (void)hipMemsetAsync((char*)d_ws + WS_CTL, 0, CTL_ZERO_BYTES, stream);
    Args a{};
    for (int i = 0; i < 23; ++i) a.in[i] = (const float*)d_in[i];
    a.out = (float*)d_out; a.ws = (unsigned char*)d_ws;
#if MK_ONE_LAUNCH
    a.ph_lo = 0; a.ph_hi = NPHASE;
    hipLaunchKernelGGL(mk_fwd, dim3(grid), dim3(NWAVES * 64), LDS_BYTES, stream, a);
#else
    for (int p = 0; p < NPHASE; ++p) {
        if (p == 14 || p == 15) continue;
        a.ph_lo = p; a.ph_hi = p + 1;
        hipLaunchKernelGGL(mk_fwd, dim3(grid), dim3(NWAVES * 64), LDS_BYTES, stream, a);
    }
#endif
}
```

```cpp
#include <hip/hip_runtime.h>
#include <cstdio>
#include <cstdint>
namespace pg8 {
#define PG8_LAS __attribute__((address_space(3)))
typedef unsigned short bf16_t;
typedef short bf16x8 __attribute__((ext_vector_type(8)));
typedef float f32x4 __attribute__((ext_vector_type(4)));
typedef unsigned u32x4 __attribute__((ext_vector_type(4)));
typedef int i32x8 __attribute__((ext_vector_type(8)));
constexpr int BM = 256, BK = 64, HALF = 128, HTB = HALF * BK * 2  , STAGE_BYTES = 8 * HTB, NXCD = 8, WGM = 8;

__host__ __device__ __forceinline__ int lds_byte(int r, int c) { const int st = (r >> 4) * 2 + (c >> 5), rr = r & 15, cc = c & 31, ob = rr * 64 + cc * 2; return st * 1024 + (ob ^ (((ob >> 9) & 1) << 5)); }
__host__ __device__ __forceinline__ void stage_rc(int b, int& R, int& C) { const int st = b / 1024, sb = b % 1024, swz = sb ^ (((sb >> 9) & 1) << 5); R = (st >> 1) * 16 + swz / 64; C = (st & 1) * 32 + (swz % 64) / 2; }
__host__ __device__ __forceinline__ int perm32(int rho) { const int n = rho >> 4, i = rho & 15; return 8 * (i >> 2) + 4 * n + (i & 3); }

struct Unit { int pm, pn; };
struct Gemm { const bf16_t* A; const bf16_t* Bt; int M, N, K, lda, tid; int scaleA, scaleB; };

struct StaticOrder {
    int nM, nN, nwg, G, c;
    __host__ __device__ void init(int M, int N, int G_, int c_) { nM = M / BM; nN = N / BM; nwg = nM * nN; G = G_; c = c_; }
    __host__ __device__ bool next(int i, Unit& u) const {
        const long L = (long)i * G + c; if (L >= nwg) return false;
        int wgid = (int)L; { const int q = nwg / NXCD, r = nwg % NXCD, xcd = wgid % NXCD, off = wgid / NXCD; wgid = (xcd < r ? xcd * (q + 1) : r * (q + 1) + (xcd - r) * q) + off; }
        const int nig = WGM * nN, gid = wgid / nig, fm = gid * WGM, gsz = (nM - fm) < WGM ? (nM - fm) : WGM;
        u.pm = fm + ((wgid % nig) % gsz); u.pn = (wgid % nig) / gsz; return true;
    }
    __device__ __forceinline__ void a_ready(const Unit&) const {}
    __device__ __forceinline__ void done(const Unit&) const {}
};

__device__ __forceinline__ unsigned cvt_pk_bf16(float lo, float hi) { unsigned r; asm volatile("v_cvt_pk_bf16_f32 %0, %1, %2" : "=v"(r) : "v"(lo), "v"(hi)); return r; }
__device__ __forceinline__ float bflo(unsigned w) { return __builtin_bit_cast(float, w << 16); }
__device__ __forceinline__ float bfhi(unsigned w) { return __builtin_bit_cast(float, w & 0xffff0000u); }
__device__ __forceinline__ float sigm(float x) { return __builtin_amdgcn_rcpf(1.0f + __builtin_amdgcn_exp2f(-1.4426950408889634f * x)); }
__device__ __forceinline__ float silu(float x) { return x * __builtin_amdgcn_rcpf(1.0f + __builtin_amdgcn_exp2f(-1.4426950408889634f * x)); }

struct EpiScaleBf16 {
    static constexpr bool PERM = true, AFTER_DRAIN = false;
    bf16_t* O; int ldc; const float* rs;
    __device__ __forceinline__ void operator()(const f32x4 (&acc)[2][2][4][2], const Unit& u, int wr, int wc, int fr, int fq) const {
        const int row0 = u.pm * BM + wr * 64 + fr, col0 = u.pn * BM + wc * 32 + 8 * fq;
#pragma unroll
        for (int ai = 0; ai < 2; ++ai)
#pragma unroll
            for (int m = 0; m < 4; ++m) { const int row = row0 + ai * HALF + m * 16; const float s = rs[row]; bf16_t* rowp = O + (size_t)row * ldc + col0;
#pragma unroll
                for (int bj = 0; bj < 2; ++bj) { const f32x4 v0 = acc[ai][bj][m][0] * s, v1 = acc[ai][bj][m][1] * s;
                    u32x4 w; w.x = cvt_pk_bf16(v0[0], v0[1]); w.y = cvt_pk_bf16(v0[2], v0[3]); w.z = cvt_pk_bf16(v1[0], v1[1]); w.w = cvt_pk_bf16(v1[2], v1[3]);
                    *(u32x4*)(rowp + bj * HALF) = w; } }
    }
};
template <int MODE> struct EpiGate {
    static constexpr bool PERM = true, AFTER_DRAIN = false;
    float* C; bf16_t* O; int ldc; const bf16_t* G; int ldg;
    __device__ __forceinline__ void operator()(const f32x4 (&acc)[2][2][4][2], const Unit& u, int wr, int wc, int fr, int fq) const {
        const int row0 = u.pm * BM + wr * 64 + fr, col0 = u.pn * BM + wc * 32 + 8 * fq;
#pragma unroll
        for (int ai = 0; ai < 2; ++ai)
#pragma unroll
            for (int m = 0; m < 4; ++m) { const int row = row0 + ai * HALF + m * 16;
#pragma unroll
                for (int bj = 0; bj < 2; ++bj) { const int col = col0 + bj * HALF;
                    const u32x4 gw = *(const u32x4*)(G + (size_t)row * ldg + col);
                    f32x4 g0, g1; g0[0] = sigm(bflo(gw.x)); g0[1] = sigm(bfhi(gw.x)); g0[2] = sigm(bflo(gw.y)); g0[3] = sigm(bfhi(gw.y));
                    g1[0] = sigm(bflo(gw.z)); g1[1] = sigm(bfhi(gw.z)); g1[2] = sigm(bflo(gw.w)); g1[3] = sigm(bfhi(gw.w));
                    float* cp = C + (size_t)row * ldc + col;
                    if (MODE == 0) { *(f32x4*)cp = acc[ai][bj][m][0] * g0; *(f32x4*)(cp + 4) = acc[ai][bj][m][1] * g1; }
                    else { const f32x4 v0 = *(const f32x4*)cp + acc[ai][bj][m][0] * g0, v1 = *(const f32x4*)(cp + 4) + acc[ai][bj][m][1] * g1;
                        u32x4 w; w.x = cvt_pk_bf16(v0[0], v0[1]); w.y = cvt_pk_bf16(v0[2], v0[3]); w.z = cvt_pk_bf16(v1[0], v1[1]); w.w = cvt_pk_bf16(v1[2], v1[3]);
                        *(u32x4*)(O + (size_t)row * ldc + col) = w; } } }
    }
};
struct EpiResF32 {
    static constexpr bool PERM = true, AFTER_DRAIN = false;
    const float* res; float* out; int ldc, npn;
    __device__ __forceinline__ void operator()(const f32x4 (&acc)[2][2][4][2], const Unit& u, int wr, int wc, int fr, int fq) const {
        const int row0 = u.pm * BM + wr * 64 + fr, col0 = (u.pn % npn) * BM + wc * 32 + 8 * fq;
#pragma unroll
        for (int ai = 0; ai < 2; ++ai)
#pragma unroll
            for (int m = 0; m < 4; ++m) { const size_t off = (size_t)(row0 + ai * HALF + m * 16) * ldc + col0;
#pragma unroll
                for (int bj = 0; bj < 2; ++bj) { f32x4 v0 = acc[ai][bj][m][0], v1 = acc[ai][bj][m][1];
                    if (res) { v0 += *(const f32x4*)(res + off + bj * HALF); v1 += *(const f32x4*)(res + off + bj * HALF + 4); }
                    *(f32x4*)(out + off + bj * HALF) = v0; *(f32x4*)(out + off + bj * HALF + 4) = v1; } }
    }
};
template <bool F8OUT> struct EpiSwiGLUT {
    static constexpr bool PERM = true, AFTER_DRAIN = false;
    bf16_t* O; int ldc, npn; const float* rs;
    __device__ __forceinline__ void operator()(const f32x4 (&acc)[2][2][4][2], const Unit& u, int wr, int wc, int fr, int fq) const {
        const int row0 = u.pm * BM + wr * 64 + fr, col0 = (u.pn % npn) * HALF + wc * 32 + 8 * fq;
#pragma unroll
        for (int ai = 0; ai < 2; ++ai)
#pragma unroll
            for (int m = 0; m < 4; ++m) { const int row = row0 + ai * HALF + m * 16; const float r = rs[row];
                float o[8];
#pragma unroll
                for (int n = 0; n < 2; ++n)
#pragma unroll
                    for (int j = 0; j < 4; ++j) { const float a1 = acc[ai][0][m][n][j] * r, a3 = acc[ai][1][m][n][j] * r; o[4 * n + j] = silu(a1) * a3; }
                if constexpr (F8OUT) {
                    unsigned w0 = 0u, w1 = 0u;
#pragma unroll
                    for (int j = 0; j < 8; ++j) o[j] = __builtin_amdgcn_fmed3f(o[j] * 8.0f, -440.f, 440.f);
                    w0 = __builtin_amdgcn_cvt_pk_fp8_f32(o[0], o[1], w0, false); w0 = __builtin_amdgcn_cvt_pk_fp8_f32(o[2], o[3], w0, true);
                    w1 = __builtin_amdgcn_cvt_pk_fp8_f32(o[4], o[5], w1, false); w1 = __builtin_amdgcn_cvt_pk_fp8_f32(o[6], o[7], w1, true);
                    typedef unsigned u32x2_ __attribute__((ext_vector_type(2)));
                    *(u32x2_*)((unsigned char*)O + (size_t)row * ldc + col0) = (u32x2_){w0, w1};
                } else {
                u32x4 w; w.x = cvt_pk_bf16(o[0], o[1]); w.y = cvt_pk_bf16(o[2], o[3]); w.z = cvt_pk_bf16(o[4], o[5]); w.w = cvt_pk_bf16(o[6], o[7]);
                *(u32x4*)(O + (size_t)row * ldc + col0) = w; } }
    }
};
typedef EpiSwiGLUT<false> EpiSwiGLU;
struct OneUnit { int pm, pn; bool has;
    __device__ __forceinline__ bool next(int i, Unit& u) const { if (i > 0 || !has) return false; u.pm = pm; u.pn = pn; return true; }
    __device__ __forceinline__ void a_ready(const Unit&) const {}
    __device__ __forceinline__ void done(const Unit&) const {}
};
struct MoeOrder {
    int G, c, nN; int t0, t1, t2, t3, t4, t5, t6, t7, t8;
    __device__ __forceinline__ bool next(int i, Unit& u) const {
        const long L = (long)i * G + c; if (L >= (long)t8 * nN) return false;
        int ts = t0, te = t1;
        if (L >= (long)t1 * nN) { ts = t1; te = t2; } if (L >= (long)t2 * nN) { ts = t2; te = t3; } if (L >= (long)t3 * nN) { ts = t3; te = t4; } if (L >= (long)t4 * nN) { ts = t4; te = t5; }
        if (L >= (long)t5 * nN) { ts = t5; te = t6; } if (L >= (long)t6 * nN) { ts = t6; te = t7; } if (L >= (long)t7 * nN) { ts = t7; te = t8; }
        int e = 0; e += (L >= (long)t1 * nN); e += (L >= (long)t2 * nN); e += (L >= (long)t3 * nN); e += (L >= (long)t4 * nN); e += (L >= (long)t5 * nN); e += (L >= (long)t6 * nN); e += (L >= (long)t7 * nN);
        const int Ll = (int)(L - (long)ts * nN), Te = te - ts;
        u.pm = ts + Ll % Te; u.pn = e * nN + Ll / Te; return true;
    }
    __device__ __forceinline__ void a_ready(const Unit&) const {}
    __device__ __forceinline__ void done(const Unit&) const {}
};
template <bool FP8> struct FragT;
template <> struct FragT<false> { bf16x8 k[2]; };
template <> struct FragT<true>  { i32x8 v; };
__device__ __forceinline__ void ld_frag(FragT<false>& f, const PG8_LAS unsigned char* p, int o0, int o1) { f.k[0] = *(const PG8_LAS bf16x8*)(p + o0); f.k[1] = *(const PG8_LAS bf16x8*)(p + o1); }
__device__ __forceinline__ void ld_frag(FragT<true>& f, const PG8_LAS unsigned char* p, int o0, int o1) { const u32x4 a = *(const PG8_LAS u32x4*)(p + o0), b = *(const PG8_LAS u32x4*)(p + o1);
    f.v = (i32x8){(int)a.x, (int)a.y, (int)a.z, (int)a.w, (int)b.x, (int)b.y, (int)b.z, (int)b.w}; }
__device__ __forceinline__ f32x4 mma_frag(const FragT<false>& b, const FragT<false>& a, f32x4 c, int, int) { c = __builtin_amdgcn_mfma_f32_16x16x32_bf16(b.k[0], a.k[0], c, 0, 0, 0); return __builtin_amdgcn_mfma_f32_16x16x32_bf16(b.k[1], a.k[1], c, 0, 0, 0); }
__device__ __forceinline__ f32x4 mma_frag(const FragT<true>& b, const FragT<true>& a, f32x4 c, int sb, int sa) {
    asm volatile("v_mfma_scale_f32_16x16x128_f8f6f4 %0, %1, %2, %0, %3, %4 op_sel_hi:[0,0,0]" : "+v"(c) : "v"(b.v), "v"(a.v), "v"(sb), "v"(sa)); return c; }
template <class Epi, class Sched, bool ALIGN_EPI = false, bool SP2 = false, bool FP8 = false>
__device__ __forceinline__ void gemm_phase(PG8_LAS unsigned char* lds, const Gemm g, const Sched& S, const Epi& E) {
    const int tid = g.tid, wid = __builtin_amdgcn_readfirstlane(tid >> 6), lane = tid & 63, wr = wid >> 2, wc = wid & 3, fr = lane & 15, fq = lane >> 4;
    const int K = g.K, nt = K / BK;
    unsigned voffA[2], voffB[2];
#pragma unroll
    for (int i = 0; i < 2; ++i) { int R, C; stage_rc(tid * 16 + i * 8192, R, C); const int Rb = Epi::PERM ? ((R & ~31) + perm32(R & 31)) : R;
        voffA[i] = (unsigned)(R * g.lda + C) * 2u; voffB[i] = (unsigned)(Rb * K + C) * 2u; }
    const size_t kstep = (size_t)(BK * 2);
    const size_t hstepB = (size_t)HALF * K * 2, hstepA = (size_t)HALF * g.lda * 2;
    const size_t tstepA = 2 * hstepA, tstepB = 2 * hstepB;
    const unsigned ldsw = (unsigned)wid * 1024u;
    const int aoff = FP8 ? lds_byte(wr * 64 + fr, fq * 16) : lds_byte(wr * 64 + fr, fq * 8), boff = FP8 ? lds_byte(wc * 32 + fr, fq * 16) : lds_byte(wc * 32 + fr, fq * 8);
    const int aoff1 = FP8 ? aoff + 16 : aoff + 1024, boff1 = FP8 ? boff + 16 : boff + 1024;
    int scA = g.scaleA, scB = g.scaleB; asm volatile("" : "+v"(scA), "+v"(scB));
#define PG8_SA(b, h) (((b) * 2 + (h)) * HTB)
#define PG8_SB(b, h) ((4 + (b) * 2 + (h)) * HTB)
#define PG8_STAGE(bufoff, gbase, voff) do { _Pragma("unroll") for (int _i = 0; _i < 2; ++_i) \
        __builtin_amdgcn_global_load_lds((const unsigned*)((const char*)(gbase) + (voff)[_i]), (PG8_LAS unsigned*)(lds + (bufoff) + ldsw + _i * 8192), 16, 0, 0); } while (0)
#define PG8_LDA(dst, b, h) do { _Pragma("unroll") for (int m = 0; m < 4; ++m) ld_frag(dst[m], lds + PG8_SA(b, h) + m * 2048, aoff, aoff1); } while (0)
#define PG8_LDB(dst, b, h) do { _Pragma("unroll") for (int n = 0; n < 2; ++n) ld_frag(dst[n], lds + PG8_SB(b, h) + n * 2048, boff, boff1); } while (0)
#define PG8_MMA(ai, bj, At, Bt) do { __builtin_amdgcn_s_setprio(1); _Pragma("unroll") for (int m = 0; m < 4; ++m) _Pragma("unroll") for (int n = 0; n < 2; ++n) \
        acc[ai][bj][m][n] = mma_frag(Bt[n], At[m], acc[ai][bj][m][n], scB, scA); __builtin_amdgcn_s_setprio(0); } while (0)
#define PG8_WAIT_V(n) asm volatile("s_waitcnt vmcnt(" #n ")" ::: "memory")
#define PG8_WAIT_L(n) asm volatile("s_waitcnt lgkmcnt(" #n ")" ::: "memory")
#define PG8_BAR __builtin_amdgcn_s_barrier()
#define PG8_SCHED __builtin_amdgcn_sched_barrier(0)
    Unit cur, nxt; int ui = 0;
    if (!S.next(0, cur)) return;
    f32x4 acc[2][2][4][2];
#pragma unroll
    for (int a = 0; a < 2; ++a)
#pragma unroll
        for (int b = 0; b < 2; ++b)
#pragma unroll
            for (int m = 0; m < 4; ++m)
#pragma unroll
                for (int n = 0; n < 2; ++n) acc[a][b][m][n] = (f32x4){0.f, 0.f, 0.f, 0.f};
    FragT<FP8> At[4], B0[2], B1[2];
    const char* cA = (const char*)g.A + (size_t)cur.pm * tstepA; const char* cB = (const char*)g.Bt + (size_t)cur.pn * tstepB;
    S.a_ready(cur);
    if constexpr (SP2) {
        PG8_STAGE(PG8_SB(0, 0), cB, voffB); PG8_STAGE(PG8_SB(0, 1), cB + hstepB, voffB); PG8_STAGE(PG8_SA(0, 0), cA, voffA); PG8_STAGE(PG8_SA(0, 1), cA + hstepA, voffA);
        if (wr == 1) PG8_BAR;
        PG8_WAIT_V(2); PG8_BAR;
        PG8_STAGE(PG8_SB(1, 0), cB + kstep, voffB); PG8_STAGE(PG8_SA(1, 0), cA + kstep, voffA); PG8_STAGE(PG8_SB(1, 1), cB + hstepB + kstep, voffB);
        PG8_WAIT_V(6); PG8_BAR;
    } else {
        PG8_STAGE(PG8_SB(0, 0), cB, voffB); PG8_STAGE(PG8_SA(0, 0), cA, voffA); PG8_STAGE(PG8_SB(0, 1), cB + hstepB, voffB); PG8_STAGE(PG8_SA(0, 1), cA + hstepA, voffA);
        if (wr == 1) PG8_BAR;
        PG8_WAIT_V(4); PG8_BAR;
        PG8_STAGE(PG8_SB(1, 0), cB + kstep, voffB); PG8_STAGE(PG8_SA(1, 0), cA + kstep, voffA); PG8_STAGE(PG8_SB(1, 1), cB + hstepB + kstep, voffB);
        PG8_WAIT_V(6); PG8_BAR;
    }
    for (;;) {
        const bool has_next = S.next(ui + 1, nxt);
        const char* nA = has_next ? (const char*)g.A + (size_t)nxt.pm * tstepA : cA; const char* nB = has_next ? (const char*)g.Bt + (size_t)nxt.pn * tstepB : cB;
        for (int t = 0; t < nt; t += 2) {
            const bool last = (t == nt - 2);
            const char* a1 = cA + (size_t)(t + 1) * kstep;
            const char* a2 = last ? nA : cA + (size_t)(t + 2) * kstep; const char* b2 = last ? nB : cB + (size_t)(t + 2) * kstep;
            const char* a3 = a2 + kstep; const char* b3 = b2 + kstep;
            if (last && has_next) S.a_ready(nxt);
            if constexpr (SP2) {
            PG8_LDB(B0, 0, 0); PG8_LDB(B1, 0, 1); PG8_SCHED; PG8_LDA(At, 0, 0); PG8_STAGE(PG8_SA(1, 1), a1 + hstepA, voffA);
            PG8_WAIT_V(8); PG8_WAIT_L(0); PG8_BAR; PG8_MMA(0, 0, At, B0); PG8_MMA(0, 1, At, B1); PG8_BAR; PG8_SCHED;
            PG8_LDA(At, 0, 1); PG8_STAGE(PG8_SB(0, 0), b2, voffB); PG8_STAGE(PG8_SB(0, 1), b2 + hstepB, voffB); PG8_STAGE(PG8_SA(0, 0), a2, voffA);
            PG8_WAIT_V(8); PG8_WAIT_L(0); PG8_BAR; PG8_MMA(1, 0, At, B0); PG8_MMA(1, 1, At, B1); PG8_BAR; PG8_SCHED;
            PG8_LDB(B0, 1, 0); PG8_LDB(B1, 1, 1); PG8_SCHED; PG8_LDA(At, 1, 0); PG8_STAGE(PG8_SA(0, 1), a2 + hstepA, voffA);
            PG8_WAIT_V(8); PG8_WAIT_L(0); PG8_BAR; PG8_MMA(0, 0, At, B0); PG8_MMA(0, 1, At, B1); PG8_BAR; PG8_SCHED;
            PG8_LDA(At, 1, 1); PG8_STAGE(PG8_SB(1, 0), b3, voffB); PG8_STAGE(PG8_SB(1, 1), b3 + hstepB, voffB); PG8_STAGE(PG8_SA(1, 0), a3, voffA);
            PG8_WAIT_V(8); PG8_WAIT_L(0); PG8_BAR; PG8_MMA(1, 0, At, B0); PG8_MMA(1, 1, At, B1); PG8_BAR; PG8_SCHED;
            } else {
            PG8_LDB(B0, 0, 0); PG8_SCHED; PG8_LDA(At, 0, 0); PG8_STAGE(PG8_SA(1, 1), a1 + hstepA, voffA);
            PG8_WAIT_L(8); PG8_BAR; PG8_WAIT_L(0); PG8_MMA(0, 0, At, B0); PG8_BAR; PG8_SCHED;
            PG8_LDB(B1, 0, 1); PG8_STAGE(PG8_SB(0, 0), b2, voffB);
            PG8_BAR; PG8_WAIT_L(0); PG8_MMA(0, 1, At, B1); PG8_BAR;
            PG8_LDA(At, 0, 1); PG8_STAGE(PG8_SA(0, 0), a2, voffA);
            PG8_BAR; PG8_WAIT_L(0); PG8_MMA(1, 0, At, B0); PG8_BAR; PG8_SCHED;
            PG8_STAGE(PG8_SB(0, 1), b2 + hstepB, voffB);
            PG8_WAIT_V(6); PG8_BAR; PG8_MMA(1, 1, At, B1); PG8_BAR;
            PG8_LDB(B0, 1, 0); PG8_SCHED; PG8_LDA(At, 1, 0); PG8_STAGE(PG8_SA(0, 1), a2 + hstepA, voffA);
            PG8_WAIT_L(8); PG8_BAR; PG8_WAIT_L(0); PG8_MMA(0, 0, At, B0); PG8_BAR; PG8_SCHED;
            PG8_LDB(B1, 1, 1); PG8_STAGE(PG8_SB(1, 0), b3, voffB);
            PG8_BAR; PG8_WAIT_L(0); PG8_MMA(0, 1, At, B1); PG8_BAR;
            PG8_LDA(At, 1, 1); PG8_STAGE(PG8_SA(1, 0), a3, voffA);
            PG8_BAR; PG8_WAIT_L(0); PG8_MMA(1, 0, At, B0); PG8_BAR; PG8_SCHED;
            PG8_STAGE(PG8_SB(1, 1), b3 + hstepB, voffB);
            PG8_WAIT_V(6); PG8_BAR; PG8_MMA(1, 1, At, B1); PG8_BAR;
            }
        }
        if constexpr (FP8) asm volatile("s_nop 15\n\ts_nop 15" : "+v"(acc[1][1][0][0]), "+v"(acc[1][1][0][1]), "+v"(acc[1][1][1][0]), "+v"(acc[1][1][1][1]), "+v"(acc[1][1][2][0]), "+v"(acc[1][1][2][1]), "+v"(acc[1][1][3][0]), "+v"(acc[1][1][3][1]) :: "memory");
        if constexpr (ALIGN_EPI) { if (wr == 0) PG8_BAR; }
        if constexpr (!Epi::AFTER_DRAIN) { E(acc, cur, wr, wc, fr, fq); S.done(cur); }
        if (!has_next) break;
#pragma unroll
        for (int a = 0; a < 2; ++a)
#pragma unroll
            for (int b = 0; b < 2; ++b)
#pragma unroll
                for (int m = 0; m < 4; ++m)
#pragma unroll
                    for (int n = 0; n < 2; ++n) acc[a][b][m][n] = (f32x4){0.f, 0.f, 0.f, 0.f};
        cur = nxt; cA = nA; cB = nB; ++ui;
        if constexpr (ALIGN_EPI) { if (wr == 1) PG8_BAR; }
    }
    PG8_WAIT_V(0);
    if constexpr (!ALIGN_EPI) { if (wr == 0) PG8_BAR; }
    PG8_BAR;
    if constexpr (Epi::AFTER_DRAIN) { E.fused(acc, cur, wr, wc, fr, fq, lds, wid, lane); S.done(cur); }
#undef PG8_SA
#undef PG8_SB
#undef PG8_STAGE
#undef PG8_LDA
#undef PG8_LDB
#undef PG8_MMA
#undef PG8_WAIT_V
#undef PG8_WAIT_L
#undef PG8_BAR
#undef PG8_SCHED
}
}

#define GAS __attribute__((address_space(1)))
#define LAS __attribute__((address_space(3)))
typedef unsigned short bf16;
typedef unsigned v4u __attribute__((ext_vector_type(4)));
typedef float f32x4 __attribute__((ext_vector_type(4)));
typedef short bf16x8 __attribute__((ext_vector_type(8)));
typedef GAS unsigned gu32;
typedef GAS unsigned long long gu64;
#define RLX_AGENT __ATOMIC_RELAXED, __HIP_MEMORY_SCOPE_AGENT
#define LDS_WAIT() asm volatile("s_waitcnt lgkmcnt(0)" ::: "memory")
#define VM_WAIT() asm volatile("s_waitcnt vmcnt(0)" ::: "memory")
__device__ __forceinline__ unsigned long long rt() { return __builtin_amdgcn_s_memrealtime(); }
__device__ __forceinline__ unsigned f2bf(float f) { unsigned u = __builtin_bit_cast(unsigned, f); return (u + 0x7fffu + ((u >> 16) & 1u)) >> 16; }
__device__ __forceinline__ unsigned pk2(float lo, float hi) { unsigned r; asm volatile("v_cvt_pk_bf16_f32 %0, %1, %2" : "=v"(r) : "v"(lo), "v"(hi)); return r; }

#define XB_TMO      128
#define XB_XCNT(j)  (256  + 64 * (j))
#define XB_XSUB(j)  (1280 + 64 * (j))
#define XB_XGEN(j)  (2304 + 64 * (j))
#define XB_TOP      3328
#define XB_TOPGEN   3392
#define XCD_BAR_WORDS 3456
#define XB_SPIN_CAP (1u << 18)

__device__ __forceinline__ unsigned xb_ld(unsigned* p)              { return __hip_atomic_load(p, __ATOMIC_RELAXED, __HIP_MEMORY_SCOPE_AGENT); }
__device__ __forceinline__ unsigned xb_add(unsigned* p, unsigned v) { return __hip_atomic_fetch_add(p, v, __ATOMIC_RELAXED, __HIP_MEMORY_SCOPE_AGENT); }
__device__ __forceinline__ unsigned xb_xcc_id() { return (unsigned)__builtin_amdgcn_s_getreg((3 << 11) | 20) & 0xFu; }
#define XB_SPIN(cond, bar) do { unsigned _sp = 0; while (cond) { __builtin_amdgcn_s_sleep(1); \
    if ((++_sp & 255u) == 0u) { if (xb_ld(&(bar)[XB_TMO])) break; if (_sp > XB_SPIN_CAP) { atomicAdd(&(bar)[XB_TMO], 1u); break; } } } } while (0)

struct XcdBarrier {
    unsigned* bar; unsigned x;
    volatile LAS unsigned* st;
};

__device__ __forceinline__ XcdBarrier xcd_barrier_post(unsigned* bar, volatile LAS unsigned* st) {
    XcdBarrier b; b.bar = bar; b.x = xb_xcc_id(); b.st = st;
    if (threadIdx.x == 0) (void)xb_add(&bar[XB_XCNT(b.x)], 1u);
    return b;
}
__device__ __forceinline__ void xcd_barrier_complete(unsigned* bar, unsigned x, unsigned& nloc, unsigned& nx) {
    const unsigned G = gridDim.x * gridDim.y * gridDim.z;
    unsigned sum, cnt, mine, sp = 0u;
    for (;;) {
        sum = 0u; cnt = 0u; mine = 0u;
#pragma unroll
        for (unsigned j = 0; j < 16; ++j) { const unsigned c = xb_ld(&bar[XB_XCNT(j)]); sum += c; cnt += (c > 0u) ? 1u : 0u; mine = (j == x) ? c : mine; }
        if (sum == G) break;
        __builtin_amdgcn_s_sleep(1);
        if ((++sp & 255u) == 0u) { if (xb_ld(&bar[XB_TMO])) break; if (sp > XB_SPIN_CAP) { atomicAdd(&bar[XB_TMO], 1u); break; } }
    }
    nloc = mine > 0u ? mine : 1u; nx = cnt > 0u ? cnt : 1u;
}

__device__ __forceinline__ void xcd_barrier(const XcdBarrier& b) {
    asm volatile("s_waitcnt vmcnt(0)" ::: "memory");
    __syncthreads();
    if (threadIdx.x == 0) {
        unsigned* bar = b.bar;
        __builtin_amdgcn_s_waitcnt(0);
        unsigned nloc = b.st[0], nx = b.st[1];
        if (nloc == 0u) { xcd_barrier_complete(bar, b.x, nloc, nx); b.st[0] = nloc; b.st[1] = nx; }
        const unsigned old = xb_add(&bar[XB_XSUB(b.x)], 1u);
        const unsigned gen = old / nloc;
        if (old + 1u == (gen + 1u) * nloc) {
            __builtin_amdgcn_fence(__ATOMIC_RELEASE, "agent");
            asm volatile("s_waitcnt vmcnt(0)" ::: "memory");
            const unsigned og = xb_add(&bar[XB_TOP], 1u);
            const unsigned tg = og / nx;
            if (og + 1u == (tg + 1u) * nx) xb_add(&bar[XB_TOPGEN], 1u);
            else XB_SPIN(xb_ld(&bar[XB_TOPGEN]) == tg, bar);
            __builtin_amdgcn_fence(__ATOMIC_ACQUIRE, "agent");
            xb_add(&bar[XB_XGEN(b.x)], 1u);
            asm volatile("s_waitcnt vmcnt(0)" ::: "memory");
        } else {
            XB_SPIN(xb_ld(&bar[XB_XGEN(b.x)]) == gen, bar);
            __builtin_amdgcn_fence(__ATOMIC_ACQUIRE, "agent");
            asm volatile("s_waitcnt vmcnt(0)" ::: "memory");
        }
    }
    __syncthreads();
}

constexpr int NWAVES = 8;
constexpr int BATCH = 8, T = 2048, D = 2048, M = BATCH * T;
constexpr int NPROJ = 10320, NPROJ_P = 10496;
constexpr int C_Q = 0, C_K = 1024, C_V = 1280, C_CQ = 1536, C_KID = 2048, C_WID = 2112, C_HQ = 2128, C_HF = 3152, C_HI = 4176, C_HG = 5200, C_GA = 6224, C_GH = 8272;
constexpr int FFD = 5632, FFE = 7168, NEXP = 8;
constexpr int MS = 34816;
constexpr float EPS = 1e-6f;
constexpr float ATT_SCALE = 0.08838834764831845f;
constexpr float IDX_WSCALE = 0.25f * 0.125f;
constexpr int NSEL = 256;

constexpr size_t MiB = 1u << 20;
constexpr size_t WS_CTL = 0, CTL_ZERO_BYTES = 1 * MiB;
constexpr size_t WS_WIN = 2 * MiB, WIN_SZ = 41 * MiB;
constexpr size_t WS_WIDX = 84 * MiB, WIDX_SZ = 1 * MiB;
constexpr size_t WS_WUA = 86 * MiB, WS_WUH = 94 * MiB, WU_SZ = 4 * MiB;
constexpr size_t WS_WO = 102 * MiB, WO_SZ = 8 * MiB;
constexpr size_t WS_W13D = 118 * MiB, WS_W2D = 162 * MiB;
constexpr size_t WS_W13M = 184 * MiB, WS_W2M = 632 * MiB;
constexpr size_t WS_XB = 856 * MiB;
constexpr size_t WS_PROJ = 920 * MiB;
constexpr size_t WS_QN = 1248 * MiB, WS_QIDX = 1280 * MiB, WS_KN = 1312 * MiB, WS_KIDX = 1320 * MiB, WS_WIDXV = 1322 * MiB, WS_MASK = 1323 * MiB;
constexpr size_t WS_RSTD1 = 1327 * MiB, WS_RSTDCQ = WS_RSTD1 + 65536;
constexpr size_t WS_MIX = 1328 * MiB;
constexpr size_t WS_TMP = 1392 * MiB;
constexpr size_t WS_MRG = 1520 * MiB;
constexpr size_t WS_H = 1584 * MiB;
constexpr size_t WS_ACTM = 920 * MiB;
constexpr size_t WS_Y = 1396 * MiB, WS_HS = 1396 * MiB;
constexpr size_t WS_TAB = 1712 * MiB;
constexpr size_t TAB_RSTD2 = 0, TAB_RSTDS = 1 * 65536, TAB_TOKE = 4 * 65536, TAB_TOKPOS = 6 * 65536, TAB_TOKP = 8 * 65536, TAB_TOKDEST = 10 * 65536;
constexpr size_t WS_ISCR = 408 * MiB;
constexpr size_t WS_HOI = 472 * MiB;
constexpr size_t WS_HSX = 536 * MiB;
constexpr size_t WS_HDEC = 604 * MiB;
constexpr size_t WS_HQH = 744 * MiB, WS_HUT = 776 * MiB;
static_assert(WS_W13M + 8ull * 2 * FFE * 2048 <= WS_ISCR && WS_HDEC + 2 * MiB <= WS_W2M && WS_W2M + 8ull * 2048 * FFE <= WS_HQH && WS_HUT + 64 * MiB <= WS_XB, "dedicated regions sit in the unused halves of the expert-weight slots");
constexpr size_t WS_HB = 1714 * MiB;
constexpr size_t WS_END = 1778 * MiB;
static_assert(WS_WIN + 2 * WIN_SZ <= WS_WIDX && WS_W2M + 8ull * 2048 * 7168 * 2 <= WS_XB && WS_PROJ + (size_t)M * NPROJ_P * 2 <= WS_QN && WS_ACTM + (size_t)MS * FFE * 2 <= WS_Y && WS_Y + (size_t)MS * 2048 * 4 <= WS_TAB && WS_H + (size_t)M * D * 4 <= WS_TAB && WS_MRG + (size_t)M * D * 2 <= WS_H && WS_TMP + (size_t)M * D * 4 <= WS_MRG && WS_MIX + (size_t)M * D * 2 <= WS_TMP && WS_RSTDCQ + 65536 <= WS_MIX && WS_XB + (size_t)M * D * 2 <= WS_PROJ && WS_TAB + 12 * 65536 <= WS_END, "ws map");
constexpr int CW_BAR = 4096;
constexpr int CW_ECNT = 16384;

constexpr int RING_OFF = 0, RING_BYTES = 131072;
constexpr int LDSCTL_OFF = 135168, MISC_OFF = LDSCTL_OFF + 320;
constexpr int LDS_BYTES = 147456;

__device__ const unsigned char BUCKET[129] = {0, 1, 2, 3, 4, 5, 6, 7, 8, 9, 10, 11, 12, 13, 14, 15, 16, 16, 16, 17, 17, 18, 18, 18, 19, 19, 19, 20, 20, 20, 20, 21, 21, 21, 21, 22, 22, 22, 22, 22, 23, 23, 23, 23, 23, 23, 24, 24, 24, 24, 24, 24, 25, 25, 25, 25, 25, 25, 25, 26, 26, 26, 26, 26, 26, 26, 26, 27, 27, 27, 27, 27, 27, 27, 27, 27, 27, 28, 28, 28, 28, 28, 28, 28, 28, 28, 28, 29, 29, 29, 29, 29, 29, 29, 29, 29, 29, 29, 29, 30, 30, 30, 30, 30, 30, 30, 30, 30, 30, 30, 30, 30, 30, 31, 31, 31, 31, 31, 31, 31, 31, 31, 31, 31, 31, 31, 31, 31, 31};

typedef unsigned v2u __attribute__((ext_vector_type(2)));
struct Args { const float* in[23]; float* out; unsigned char* ws; int ph_lo, ph_hi; };
typedef const __attribute__((address_space(4))) Args* KA;
__device__ __forceinline__ KA ka_get() { KA p = (KA)__builtin_amdgcn_kernarg_segment_ptr(); asm volatile("" : "+s"(p)); return p; }

struct Frame {
    LAS unsigned char* lds;
    int tid, lane, wave, G, bid;
};
__device__ __forceinline__ Frame make_frame(LAS unsigned char* lds, int wave_s) {
    Frame F; int ln; asm volatile("v_mbcnt_lo_u32_b32 %0, -1, 0\n\tv_mbcnt_hi_u32_b32 %0, -1, %0" : "=v"(ln));
    int w = wave_s, b = blockIdx.x, g = gridDim.x; asm volatile("" : "+s"(w), "+s"(b), "+s"(g));
    F.lds = lds; F.lane = ln; F.wave = w; F.tid = w * 64 + ln; F.G = g; F.bid = b; return F;
}
__device__ __forceinline__ bool in_range(int k, int lo, int hi) { asm volatile("" : "+s"(k)); return lo <= k && k < hi; }
template <int O> __device__ __forceinline__ float swz(float v) { return __builtin_bit_cast(float, __builtin_amdgcn_ds_swizzle(__builtin_bit_cast(int, v), (O << 10) | 0x1f)); }
__device__ __forceinline__ void swap32(unsigned a, unsigned& r0, unsigned& r1) { unsigned b = a; asm volatile("" : "+v"(b)); auto rr = __builtin_amdgcn_permlane32_swap(a, b, false, false); r0 = rr[0]; r1 = rr[1]; }
__device__ __forceinline__ float x32_sum(float v) { unsigned r0, r1; swap32(__builtin_bit_cast(unsigned, v), r0, r1); return __builtin_bit_cast(float, r0) + __builtin_bit_cast(float, r1); }
__device__ __forceinline__ float x32_max(float v) { unsigned r0, r1; swap32(__builtin_bit_cast(unsigned, v), r0, r1); return fmaxf(__builtin_bit_cast(float, r0), __builtin_bit_cast(float, r1)); }
__device__ __forceinline__ float wave_sum(float v) { v += swz<1>(v); v += swz<2>(v); v += swz<4>(v); v += swz<8>(v); v += swz<16>(v); return x32_sum(v); }
__device__ __forceinline__ float wave_max(float v) { v = fmaxf(v, swz<1>(v)); v = fmaxf(v, swz<2>(v)); v = fmaxf(v, swz<4>(v)); v = fmaxf(v, swz<8>(v)); v = fmaxf(v, swz<16>(v)); return x32_max(v); }
__device__ __forceinline__ float bf2f(bf16 v) { return __builtin_bit_cast(float, (unsigned)v << 16); }
__device__ __forceinline__ float blo(unsigned w) { return __builtin_bit_cast(float, w << 16); }
__device__ __forceinline__ float bhi(unsigned w) { return __builtin_bit_cast(float, w & 0xffff0000u); }
__device__ __forceinline__ float sigmf(float x) { return __builtin_amdgcn_rcpf(1.0f + __builtin_amdgcn_exp2f(-1.4426950408889634f * x)); }
__device__ __forceinline__ float siluf(float x) { return x * __builtin_amdgcn_rcpf(1.0f + __builtin_amdgcn_exp2f(-1.4426950408889634f * x)); }

struct ConvD { const float* src; bf16* dst; const float* gain; int K, N, Npad, nb; size_t sstride, dstride; int grp, gstride, goff; int f8; };
__device__ __forceinline__ void get_conv(int id, KA a, ConvD& d) {
    const int l = id >> 3, k = id & 7;
    bf16* ws16 = (bf16*)a->ws;
    d.gain = nullptr; d.nb = 1; d.sstride = 0; d.dstride = 0; d.grp = 30; d.gstride = 0; d.goff = 0; d.f8 = 0;
    if (k == 0) { d.src = a->in[4] + (size_t)l * 2048 * NPROJ; d.dst = (bf16*)(a->ws + WS_WIN + l * WIN_SZ); d.gain = a->in[2] + l * 2048; d.K = 2048; d.N = NPROJ; d.Npad = NPROJ_P; d.f8 = 1; }
    else if (k == 1) { d.src = a->in[8] + (size_t)l * 512 * 1024; d.dst = (bf16*)(a->ws + WS_WIDX + l * WIDX_SZ); d.gain = a->in[7] + l * 512; d.K = 512; d.N = 1024; d.Npad = 1024; }
    else if (k == 2) { d.src = a->in[13] + (size_t)l * 1024 * 2048; d.dst = (bf16*)(a->ws + WS_WUA + l * WU_SZ); d.K = 1024; d.N = 2048; d.Npad = 2048; }
    else if (k == 3) { d.src = a->in[14] + (size_t)l * 1024 * 2048; d.dst = (bf16*)(a->ws + WS_WUH + l * WU_SZ); d.K = 1024; d.N = 2048; d.Npad = 2048; }
    else if (k == 4) { d.src = a->in[15] + (size_t)l * 2048 * 2048; d.dst = (bf16*)(a->ws + WS_WO + l * WO_SZ); d.K = 2048; d.N = 2048; d.Npad = 2048; }
    else if (l == 0) {
        if (k == 5) { d.src = a->in[16]; d.dst = (bf16*)(a->ws + WS_W13D); d.gain = a->in[3]; d.K = 2048; d.N = FFD; d.Npad = FFD; d.grp = 7; d.gstride = 256; d.goff = 0; }
        else if (k == 6) { d.src = a->in[17]; d.dst = (bf16*)(a->ws + WS_W13D); d.gain = a->in[3]; d.K = 2048; d.N = FFD; d.Npad = FFD; d.grp = 7; d.gstride = 256; d.goff = 128; }
        else { d.src = a->in[18]; d.dst = (bf16*)(a->ws + WS_W2D); d.K = FFD; d.N = 2048; d.Npad = 2048; }
    } else {
        if (k == 5) { d.src = a->in[20]; d.dst = (bf16*)(a->ws + WS_W13M); d.gain = a->in[3] + 2048; d.K = 2048; d.N = FFE; d.Npad = FFE; d.nb = NEXP; d.sstride = (size_t)2048 * FFE; d.dstride = (size_t)2 * FFE * 2048; d.grp = 7; d.gstride = 256; d.goff = 0; d.f8 = 1; }
        else if (k == 6) { d.src = a->in[21]; d.dst = (bf16*)(a->ws + WS_W13M); d.gain = a->in[3] + 2048; d.K = 2048; d.N = FFE; d.Npad = FFE; d.nb = NEXP; d.sstride = (size_t)2048 * FFE; d.dstride = (size_t)2 * FFE * 2048; d.grp = 7; d.gstride = 256; d.goff = 128; d.f8 = 1; }
        else { d.src = a->in[22]; d.dst = (bf16*)(a->ws + WS_W2M); d.K = FFE; d.N = 2048; d.Npad = 2048; d.nb = NEXP; d.sstride = (size_t)FFE * 2048; d.dstride = (size_t)2048 * FFE; d.f8 = 1; }
    }
    (void)ws16;
}
__device__ __forceinline__ void conv_item(const ConvD& d, long item, LAS float* scr, int lane) {
    const int nblk = d.Npad / 64, kblk = d.K / 64; const int per = kblk * nblk, it32 = (int)item;
    const int e = it32 / per; const int r = it32 - e * per; const int kb = r / nblk, nbi = r - kb * nblk, k0 = 64 * kb, n0 = 64 * nbi;
    const float* src = d.src + (size_t)e * d.sstride; bf16* dst = d.dst + (size_t)e * d.dstride; unsigned char* dst8 = (unsigned char*)d.dst + (size_t)e * d.dstride;
    const int nn = (lane & 15) * 4, kq = lane >> 4;
    const int c = lane & 7;
    f32x4 g0 = {1.f, 1.f, 1.f, 1.f}, g1 = g0;
    if (d.gain) { g0 = *(const GAS f32x4*)(d.gain + k0 + 8 * c); g1 = *(const GAS f32x4*)(d.gain + k0 + 8 * c + 4); }
    f32x4 v[16];
    if (n0 + 64 <= d.N) {
#pragma unroll
        for (int i = 0; i < 16; ++i) { const int kk = 4 * i + kq; v[i] = __builtin_nontemporal_load((const GAS f32x4*)(src + (size_t)(k0 + kk) * d.N + n0 + nn)); }
    } else {
#pragma unroll
        for (int i = 0; i < 16; ++i) { const int kk = 4 * i + kq; v[i] = (n0 + nn < d.N) ? *(const GAS f32x4*)(src + (size_t)(k0 + kk) * d.N + n0 + nn) : (f32x4){0.f, 0.f, 0.f, 0.f}; }
    }
#pragma unroll
    for (int i = 0; i < 16; ++i) { const int kk = 4 * i + kq; LAS float* p = scr + kk * 65 + nn; p[0] = v[i][0]; p[1] = v[i][1]; p[2] = v[i][2]; p[3] = v[i][3]; }
    LDS_WAIT(); asm volatile("" ::: "memory");
    const float g[8] = {g0[0], g0[1], g0[2], g0[3], g1[0], g1[1], g1[2], g1[3]};
#pragma unroll
    for (int j = 0; j < 8; ++j) { const int n = (lane >> 3) + 8 * j; const LAS float* s = scr + (8 * c) * 65 + n;
        const int ng = n0 + n; const int row = (ng >> d.grp) * d.gstride + d.goff + (ng & ((1 << d.grp) - 1));
        if (d.f8) { unsigned w0 = 0u, w1 = 0u;
            w0 = __builtin_amdgcn_cvt_pk_fp8_f32(s[0 * 65] * g[0] * 64.f, s[1 * 65] * g[1] * 64.f, w0, false); w0 = __builtin_amdgcn_cvt_pk_fp8_f32(s[2 * 65] * g[2] * 64.f, s[3 * 65] * g[3] * 64.f, w0, true);
            w1 = __builtin_amdgcn_cvt_pk_fp8_f32(s[4 * 65] * g[4] * 64.f, s[5 * 65] * g[5] * 64.f, w1, false); w1 = __builtin_amdgcn_cvt_pk_fp8_f32(s[6 * 65] * g[6] * 64.f, s[7 * 65] * g[7] * 64.f, w1, true);
            __builtin_nontemporal_store((v2u){w0, w1}, (GAS v2u*)(dst8 + (size_t)row * d.K + k0 + 8 * c)); }
        else { v4u o; o.x = pk2(s[0 * 65] * g[0], s[1 * 65] * g[1]); o.y = pk2(s[2 * 65] * g[2], s[3 * 65] * g[3]); o.z = pk2(s[4 * 65] * g[4], s[5 * 65] * g[5]); o.w = pk2(s[6 * 65] * g[6], s[7 * 65] * g[7]);
            __builtin_nontemporal_store(o, (GAS v4u*)(dst + (size_t)row * d.K + k0 + 8 * c)); } }
    LDS_WAIT(); asm volatile("" ::: "memory");
}
__device__ __forceinline__ void phase_conv(Frame& F, KA a, int id_lo, int id_hi, int vb, int vG) {
    LAS float* scr = (LAS float*)(F.lds + F.wave * 16640);
    const long gw = (long)vb * NWAVES + F.wave, NGW = (long)vG * NWAVES;
    long base = 0;
#pragma unroll 1
    for (int id = id_lo; id < id_hi; ++id) {
        ConvD d; get_conv(id, a, d);
        const long items = (long)d.nb * (d.K / 64) * (d.Npad / 64);
        long first = (gw - base % NGW + NGW) % NGW;
#pragma unroll 1
        for (long it = first; it < items; it += NGW) conv_item(d, it, scr, F.lane);
        base += items;
    }
}

template <bool F8> __device__ __forceinline__ void phase_norm_t(Frame& F, const float* src, bf16* dst, float* rstd) {
    const int gw = F.bid * NWAVES + F.wave, NGW = F.G * NWAVES;
    for (int row = gw; row < M; row += NGW) {
        const GAS f32x4* xr = (const GAS f32x4*)(src + (size_t)row * D) + F.lane;
        f32x4 v[8]; float s = 0.f;
#pragma unroll
        for (int j = 0; j < 8; ++j) { v[j] = xr[64 * j]; s += (v[j].x * v[j].x + v[j].y * v[j].y) + (v[j].z * v[j].z + v[j].w * v[j].w); }
        s = wave_sum(s);
        if constexpr (F8) { GAS unsigned* o4 = (GAS unsigned*)((unsigned char*)dst + (size_t)row * D) + F.lane;
#pragma unroll
            for (int j = 0; j < 8; ++j) { unsigned w = 0u; w = __builtin_amdgcn_cvt_pk_fp8_f32(v[j].x, v[j].y, w, false); w = __builtin_amdgcn_cvt_pk_fp8_f32(v[j].z, v[j].w, w, true); o4[64 * j] = w; } }
        else { GAS v2u* o8 = (GAS v2u*)(dst + (size_t)row * D) + F.lane;
#pragma unroll
            for (int j = 0; j < 8; ++j) { v2u w; w.x = pk2(v[j].x, v[j].y); w.y = pk2(v[j].z, v[j].w); o8[64 * j] = w; } }
        if (F.lane == 0) rstd[row] = 1.0f / sqrtf(s * (1.0f / D) + EPS);
    }
}

__device__ __forceinline__ void phase_post(Frame& F, KA a, int l) {
    const int gw = F.bid * NWAVES + F.wave, NGW = F.G * NWAVES, lane = F.lane;
    const bf16* proj = (const bf16*)(a->ws + WS_PROJ);
    bf16* qn = (bf16*)(a->ws + WS_QN); bf16* kn = (bf16*)(a->ws + WS_KN); bf16* kidx = (bf16*)(a->ws + WS_KIDX); float* widx = (float*)(a->ws + WS_WIDXV); float* rstdcq = (float*)(a->ws + WS_RSTDCQ);
    const float* qg = a->in[5] + l * 128; const float* kg = a->in[6] + l * 128; const float* lng = a->in[9] + l * 64; const float* lnb = a->in[10] + l * 64;
    for (int row = gw; row < M; row += NGW) {
        const bf16* pr = proj + (size_t)row * NPROJ_P;
        {
            const v4u w0 = *(const GAS v4u*)(pr + C_Q + 16 * lane), w1 = *(const GAS v4u*)(pr + C_Q + 16 * lane + 8);
            float x[16] = {blo(w0.x), bhi(w0.x), blo(w0.y), bhi(w0.y), blo(w0.z), bhi(w0.z), blo(w0.w), bhi(w0.w), blo(w1.x), bhi(w1.x), blo(w1.y), bhi(w1.y), blo(w1.z), bhi(w1.z), blo(w1.w), bhi(w1.w)};
            float ss = 0.f;
#pragma unroll
            for (int i = 0; i < 16; ++i) ss += x[i] * x[i];
            ss += swz<1>(ss); ss += swz<2>(ss); ss += swz<4>(ss);
            const float r = ATT_SCALE / sqrtf(ss * (1.0f / 128.0f) + EPS); const int d0 = (lane & 7) * 16;
            unsigned o[8];
#pragma unroll
            for (int i = 0; i < 8; ++i) o[i] = pk2(x[2 * i] * r * qg[d0 + 2 * i], x[2 * i + 1] * r * qg[d0 + 2 * i + 1]);
            *(GAS v4u*)(qn + (size_t)row * 1024 + 16 * lane) = (v4u){o[0], o[1], o[2], o[3]}; *(GAS v4u*)(qn + (size_t)row * 1024 + 16 * lane + 8) = (v4u){o[4], o[5], o[6], o[7]};
        }
        {
            const v2u w = *(const GAS v2u*)(pr + C_K + 4 * lane);
            const float x0 = blo(w.x), x1 = bhi(w.x), x2 = blo(w.y), x3 = bhi(w.y);
            float ss = x0 * x0 + x1 * x1 + x2 * x2 + x3 * x3;
            ss += swz<1>(ss); ss += swz<2>(ss); ss += swz<4>(ss); ss += swz<8>(ss); ss += swz<16>(ss);
            const float r = 1.0f / sqrtf(ss * (1.0f / 128.0f) + EPS); const int d0 = (lane & 31) * 4;
            v2u o; o.x = pk2(x0 * r * kg[d0], x1 * r * kg[d0 + 1]); o.y = pk2(x2 * r * kg[d0 + 2], x3 * r * kg[d0 + 3]);
            *(GAS v2u*)(kn + (size_t)row * 256 + 4 * lane) = o;
        }
        {
            const v4u w = *(const GAS v4u*)(pr + C_CQ + 8 * lane);
            const float x[8] = {blo(w.x), bhi(w.x), blo(w.y), bhi(w.y), blo(w.z), bhi(w.z), blo(w.w), bhi(w.w)};
            float ss = 0.f;
#pragma unroll
            for (int i = 0; i < 8; ++i) ss += x[i] * x[i];
            ss = wave_sum(ss);
            if (lane == 0) rstdcq[row] = 1.0f / sqrtf(ss * (1.0f / 512.0f) + EPS);
        }
        {
            const float x = bf2f(pr[C_KID + lane]);
            const float mu = wave_sum(x) * (1.0f / 64.0f); const float dd = x - mu; const float var = wave_sum(dd * dd) * (1.0f / 64.0f);
            const float y = dd / sqrtf(var + EPS) * lng[lane] + lnb[lane];
            kidx[(size_t)row * 64 + lane] = (bf16)f2bf(y);
        }
        if (lane < 16) widx[(size_t)row * 16 + lane] = bf2f(pr[C_WID + lane]) * IDX_WSCALE;
    }
}

__device__ __forceinline__ unsigned ordkey(float v) { const unsigned u = __builtin_bit_cast(unsigned, v); return (u & 0x80000000u) ? ~u : (u | 0x80000000u); }
typedef float f32x16 __attribute__((ext_vector_type(16)));
typedef float f32x2 __attribute__((ext_vector_type(2)));
__device__ __forceinline__ int wave_total6(int cl) { int c = 0;
#pragma unroll
    for (int b = 0; b < 6; ++b) c += __popcll(__ballot((cl >> b) & 1)) << b;
    return c; }
__device__ __forceinline__ void select_row(unsigned (&key)[32], int t, unsigned long long* mrow, int lane) {
    if (t + 1 <= NSEL) {
#pragma unroll
        for (int j = 0; j < 32; ++j) { const unsigned long long bs = __ballot(key[j] != 0u); if (lane == 0) mrow[j] = bs; }
    } else {
#pragma unroll
        for (int st = 0; st < 5; ++st) { const int j = 16 >> st; const unsigned m = st == 0 ? 0x0000FFFFu : st == 1 ? 0x00FF00FFu : st == 2 ? 0x0F0F0F0Fu : st == 3 ? 0x33333333u : 0x55555555u;
#pragma unroll
            for (int k = 0; k < 32; ++k) if (!(k & j)) { const unsigned x = ((key[k] >> j) ^ key[k + j]) & m; key[k] ^= x << j; key[k + j] ^= x; } }
        unsigned G = 0u, E = 0xffffffffu;
#pragma unroll
        for (int bit = 31; bit >= 0; --bit) {
            const unsigned m = E & key[bit];
            const bool take = wave_total6(__popc(G) + __popc(m)) >= NSEL;
            E = take ? m : (E & ~m); G = take ? G : (G | m);
        }
        const int need = NSEL - wave_total6(__popc(G)); int running = 0;
        const unsigned long long lt = (lane == 0) ? 0ull : (~0ull >> (64 - lane));
#pragma unroll
        for (int j = 0; j < 32; ++j) {
            const bool eq = (E >> j) & 1u; const unsigned long long be = __ballot(eq);
            const int rank = running + __popcll(be & lt);
            const bool sel = ((G >> j) & 1u) || (eq && rank < need);
            running += __popcll(be);
            const unsigned long long bs = __ballot(sel); if (lane == 0) mrow[j] = bs;
        }
    }
}
__device__ __forceinline__ void phase_index2(Frame& F, KA a) {
    LAS unsigned char* Ws = F.lds + 66048;
    LAS unsigned char* Qs = F.lds;
    const bf16* qidx = (const bf16*)(a->ws + WS_QIDX); const bf16* kidx = (const bf16*)(a->ws + WS_KIDX); const float* widx = (const float*)(a->ws + WS_WIDXV);
    unsigned long long* mask = (unsigned long long*)(a->ws + WS_MASK);
    float* scr = (float*)(a->ws + WS_ISCR) + (size_t)F.bid * 65536;
    const int tid = F.tid, lane = F.lane, r = lane & 31, hi = lane >> 5, wave = F.wave;
    for (int u = F.bid; u < 256; u += F.G) {
        const int b = u >> 5, ii = u & 31;
#pragma unroll 1
        for (int half = 0; half < 2; ++half) {
            const int qb = half ? 63 - ii : ii; const int row0 = b * T + 32 * qb;
#pragma unroll
            for (int c = 0; c < 8; ++c) { const int row = tid >> 4, ch = (tid & 15) + 16 * c;
                *(LAS v4u*)(Qs + row * 2064 + ch * 16) = *(const GAS v4u*)(qidx + (size_t)(row0 + row) * 1024 + ch * 8); }
            if (tid < 128) *(LAS f32x4*)(Ws + 16 * tid) = *(const GAS f32x4*)(widx + (size_t)row0 * 16 + 4 * tid);
            __syncthreads();
#pragma unroll 1
            for (int kb = wave; kb <= qb; kb += 8) {
                bf16x8 kf[4]; const bf16* kp = kidx + (size_t)(b * T + 32 * kb + r) * 64 + 8 * hi;
#pragma unroll
                for (int ks = 0; ks < 4; ++ks) kf[ks] = *(const GAS bf16x8*)(kp + 16 * ks);
                f32x16 sc;
#pragma unroll
                for (int i = 0; i < 16; ++i) sc[i] = 0.f;
                const LAS unsigned char* qrow = Qs + r * 2064 + hi * 16; const LAS float* wrow = (const LAS float*)(Ws + r * 64);
                bf16x8 qa[4], qb[4];
#pragma unroll
                for (int ks = 0; ks < 4; ++ks) qa[ks] = *(const LAS bf16x8*)(qrow + ks * 32);
#pragma unroll 1
                for (int h = 0; h < 16; h += 2) {
#pragma unroll
                    for (int ks = 0; ks < 4; ++ks) qb[ks] = *(const LAS bf16x8*)(qrow + (h + 1) * 128 + ks * 32);
                    const float wA = wrow[h], wB = wrow[h + 1];
                    f32x16 accA, accB;
#pragma unroll
                    for (int i = 0; i < 16; ++i) { accA[i] = 0.f; accB[i] = 0.f; }
                    __builtin_amdgcn_sched_barrier(0);
#pragma unroll
                    for (int ks = 0; ks < 4; ++ks) accA = __builtin_amdgcn_mfma_f32_32x32x16_bf16(kf[ks], qa[ks], accA, 0, 0, 0);
                    __builtin_amdgcn_sched_barrier(0);
                    if (h + 2 < 16) {
#pragma unroll
                        for (int ks = 0; ks < 4; ++ks) qa[ks] = *(const LAS bf16x8*)(qrow + (h + 2) * 128 + ks * 32); }
#pragma unroll
                    for (int ks = 0; ks < 4; ++ks) accB = __builtin_amdgcn_mfma_f32_32x32x16_bf16(kf[ks], qb[ks], accB, 0, 0, 0);
                    __builtin_amdgcn_sched_barrier(0);
#pragma unroll
                    for (int i = 0; i < 16; ++i) sc[i] = fmaf(wA, __builtin_amdgcn_fmed3f(accA[i], 0.f, 3.0e38f), sc[i]);
#pragma unroll
                    for (int i = 0; i < 16; ++i) sc[i] = fmaf(wB, __builtin_amdgcn_fmed3f(accB[i], 0.f, 3.0e38f), sc[i]);
                }
                LAS float* Tw = (LAS float*)(F.lds + 68096 + wave * 4224);
#pragma unroll
                for (int i = 0; i < 16; ++i) Tw[r * 33 + (i & 3) + 8 * (i >> 2) + 4 * hi] = sc[i];
                asm volatile("s_waitcnt lgkmcnt(0)" ::: "memory");
#pragma unroll
                for (int j = 0; j < 16; ++j) { const int q = 2 * j + hi; scr[(size_t)q * 2048 + 32 * kb + r] = Tw[q * 33 + r]; }
                asm volatile("s_waitcnt lgkmcnt(0)" ::: "memory");
            }
            __syncthreads();
#pragma unroll 1
            for (int pass = 0; pass < 2; ++pass) {
                const int q0 = 4 * wave + 2 * pass, ta = 32 * qb + q0, tb = ta + 1; const size_t rowa = (size_t)row0 + q0;
                unsigned ka[32], kb2[32];
#pragma unroll
                for (int j = 0; j < 32; ++j) { const int s = lane + 64 * j; float vx = 0.f, vy = 0.f;
                    if (s <= 32 * qb + 31) { vx = *(const GAS float*)(scr + (size_t)q0 * 2048 + s); vy = *(const GAS float*)(scr + (size_t)(q0 + 1) * 2048 + s); }
                    ka[j] = (s <= ta) ? ordkey(vx) : 0u; kb2[j] = (s <= tb) ? ordkey(vy) : 0u; }
                select_row(ka, ta, mask + rowa * 32, lane);
                select_row(kb2, tb, mask + (rowa + 1) * 32, lane);
            }
            __syncthreads();
        }
    }
}

namespace att {
using s16x4  = __attribute__((ext_vector_type(4))) short;
constexpr int KVBLK = 64; constexpr size_t SHM_V = 16384, SHM_K = 16384; constexpr int OFF_WS = 65536, OFF_BIAS = 67584;
constexpr float THR = 8.f, LOG2E = 1.4426950408889634f;
#define KSWZ(row, colB) ((row) * 256 + ((colB) ^ (((row) & 7) << 4)))
#define SBAR() __builtin_amdgcn_sched_barrier(0)
__device__ __forceinline__ int crow(int r, int hi) { return (r & 3) + 8 * (r >> 2) + 4 * hi; }
__device__ __forceinline__ unsigned cvtpk(float lo, float hi) { unsigned r; asm volatile("v_cvt_pk_bf16_f32 %0, %1, %2" : "=v"(r) : "v"(lo), "v"(hi)); return r; }
template <bool NEAR> __device__ __forceinline__ void mask_bias(f32x16& p0, f32x16& p1, unsigned w0, unsigned w1, int hi, int dbase, const LAS float* bt) {
    const unsigned s0 = w0 >> (4 * hi), s1 = w1 >> (4 * hi);
#pragma unroll
    for (int r = 0; r < 16; ++r) { const int bp = (r & 3) + 8 * (r >> 2);
        float a = p0[r], b = p1[r];
        if (NEAR) { int i0 = dbase - bp, i1 = dbase - bp - 32; i0 = i0 < 0 ? 0 : (i0 > 128 ? 128 : i0); i1 = i1 < 0 ? 0 : (i1 > 128 ? 128 : i1); a += bt[i0]; b += bt[i1]; }
        p0[r] = ((s0 >> bp) & 1u) ? a : -INFINITY; p1[r] = ((s1 >> bp) & 1u) ? b : -INFINITY; }
}
__device__ __forceinline__ void partialSM(f32x16& p0, f32x16& p1, float badd, float& m_reg, float& mn, float& alpha) {
  float pmax = p0[0];
#pragma unroll
  for (int r = 1; r < 16; ++r) pmax = __builtin_amdgcn_fmed3f(pmax, p0[r], INFINITY);
#pragma unroll
  for (int r = 0; r < 16; ++r) pmax = __builtin_amdgcn_fmed3f(pmax, p1[r], INFINITY);
  pmax += badd;
  pmax = x32_max(pmax);
  if (__builtin_expect(__all(pmax - m_reg <= THR), 1)) { mn = m_reg; alpha = 1.f; }
  else { mn = fmaxf(m_reg, pmax); alpha = __builtin_amdgcn_exp2f((m_reg - mn) * LOG2E); m_reg = mn; }
  const float mnC = (badd - mn) * LOG2E;
#pragma unroll
  for (int r = 0; r < 16; ++r) p0[r] = fmaf(p0[r], LOG2E, mnC);
#pragma unroll
  for (int r = 0; r < 16; ++r) p1[r] = fmaf(p1[r], LOG2E, mnC);
#pragma unroll
  for (int r = 0; r < 16; ++r) p0[r] = __builtin_amdgcn_exp2f(p0[r]);
}
__device__ __forceinline__ void finishSM(f32x16& p0, f32x16& p1, float alpha, float& l_reg, bf16x8& pa0, bf16x8& pa1, bf16x8& pa2, bf16x8& pa3) {
#pragma unroll
  for (int r = 0; r < 16; ++r) p1[r] = __builtin_amdgcn_exp2f(p1[r]);
  float ps = 0;
#pragma unroll
  for (int r = 0; r < 16; ++r) ps += p0[r];
#pragma unroll
  for (int r = 0; r < 16; ++r) ps += p1[r];
  ps = x32_sum(ps);
  l_reg = l_reg * alpha + ps;
#define PK4(P, BASE, OUT) do { unsigned a0 = cvtpk(P[BASE + 0], P[BASE + 1]), a1 = cvtpk(P[BASE + 2], P[BASE + 3]);   \
    unsigned b0 = cvtpk(P[BASE + 4], P[BASE + 5]), b1 = cvtpk(P[BASE + 6], P[BASE + 7]);                              \
    auto r0 = __builtin_amdgcn_permlane32_swap(a0, b0, false, false); auto r1 = __builtin_amdgcn_permlane32_swap(a1, b1, false, false); \
    v4u w = {r0[0], r1[0], r0[1], r1[1]}; OUT = __builtin_bit_cast(bf16x8, w); } while (0)
  PK4(p0, 0, pa0); PK4(p0, 8, pa1); PK4(p1, 0, pa2); PK4(p1, 8, pa3);
#undef PK4
}
__device__ __forceinline__ void qkt(f32x16& p0, f32x16& p1, const LAS char* Ks, const bf16x8* qr, int r32, int hi) {
#pragma unroll
  for (int r = 0; r < 16; ++r) { p0[r] = 0.f; p1[r] = 0.f; }
#pragma unroll
  for (int d0 = 0; d0 < 8; ++d0) { const int cb = (d0 * 16 + hi * 8) * 2;
    const bf16x8 b0 = *(const LAS bf16x8*)(Ks + KSWZ(r32, cb));
    const bf16x8 b1 = *(const LAS bf16x8*)(Ks + KSWZ(32 + r32, cb));
    p0 = __builtin_amdgcn_mfma_f32_32x32x16_bf16(b0, qr[d0], p0, 0, 0, 0);
    p1 = __builtin_amdgcn_mfma_f32_32x32x16_bf16(b1, qr[d0], p1, 0, 0, 0); }
}
__device__ __forceinline__ int v_st(int k, int c) { const int kk = (k & ~0xC) | ((k & 4) << 1) | ((k & 8) >> 1); return ((kk >> 3) * 4 + (c >> 5)) * 512 + ((kk & 7) * 32 + (c & 31)) * 2; }
__device__ __forceinline__ int v_rd_base(int lane) { return ((lane & 3) << 3) | (((lane >> 2) & 3) << 6) | (((lane >> 4) & 1) << 5) | (((lane >> 5) & 1) << 8); }
constexpr int v_rd_off(int d0, int ks, int half) { return d0 * 512 + ks * 4096 + half * 2048; }
template <int OFF> __device__ __forceinline__ s16x4 tr_read(int vb) { s16x4 r; asm volatile("ds_read_b64_tr_b16 %0, %1 offset:%2" : "=&v"(r) : "v"(vb), "i"(OFF) : "memory"); return r; }
template <int D0> __device__ __forceinline__ void pv_one(f32x16& od, int vb, bf16x8 pa0, bf16x8 pa1, bf16x8 pa2, bf16x8 pa3) {
  const s16x4 l0 = tr_read<v_rd_off(D0, 0, 0)>(vb), h0 = tr_read<v_rd_off(D0, 0, 1)>(vb), l1 = tr_read<v_rd_off(D0, 1, 0)>(vb), h1 = tr_read<v_rd_off(D0, 1, 1)>(vb);
  const s16x4 l2 = tr_read<v_rd_off(D0, 2, 0)>(vb), h2 = tr_read<v_rd_off(D0, 2, 1)>(vb), l3 = tr_read<v_rd_off(D0, 3, 0)>(vb), h3 = tr_read<v_rd_off(D0, 3, 1)>(vb);
  asm volatile("s_waitcnt lgkmcnt(0)" ::: "memory"); SBAR();
#define PK(L, H) (bf16x8){L[0], L[1], L[2], L[3], H[0], H[1], H[2], H[3]}
  od = __builtin_amdgcn_mfma_f32_32x32x16_bf16(pa0, PK(l0, h0), od, 0, 0, 0);
  od = __builtin_amdgcn_mfma_f32_32x32x16_bf16(pa1, PK(l1, h1), od, 0, 0, 0);
  od = __builtin_amdgcn_mfma_f32_32x32x16_bf16(pa2, PK(l2, h2), od, 0, 0, 0);
  od = __builtin_amdgcn_mfma_f32_32x32x16_bf16(pa3, PK(l3, h3), od, 0, 0, 0);
#undef PK
}
__device__ __forceinline__ void pv_d0(f32x16* o, int vb, bf16x8 pa0, bf16x8 pa1, bf16x8 pa2, bf16x8 pa3) {
  pv_one<0>(o[0], vb, pa0, pa1, pa2, pa3); pv_one<1>(o[1], vb, pa0, pa1, pa2, pa3); pv_one<2>(o[2], vb, pa0, pa1, pa2, pa3); pv_one<3>(o[3], vb, pa0, pa1, pa2, pa3);
}
__device__ __forceinline__ void attn_unit(const bf16* __restrict__ Qt, const bf16* __restrict__ Kh, const bf16* __restrict__ Vh, const unsigned* __restrict__ mrow, bf16* __restrict__ Ob,
                                          int kvh, int qt, const float* relb, LAS char* lds, int tid) {
  constexpr int LDKK = 256, LDKV = NPROJ_P;
  const int wid = __builtin_amdgcn_readfirstlane(tid >> 6), lane = tid & 63, r32 = lane & 31, hi = lane >> 5;
  LAS char* V_lds = lds; LAS char* K_lds = lds + 2 * SHM_V;
  LAS float* wsf = (LAS float*)(lds + OFF_WS) + wid * 64; LAS float* li_l = wsf; LAS float* al_l = wsf + 32;
  const int hq = kvh * 4 + (wid >> 1), tq0 = 64 * qt + 32 * (wid & 1), tq = tq0 + r32;
  const LAS float* bt = (const LAS float*)(lds + OFF_BIAS) + hq * 132;
  const float bfar = relb[31 * 8 + hq];
  float m_reg = -1e30f, l_reg = 0; f32x16 o[4]; bf16x8 qr[8];
#pragma unroll
  for (int d = 0; d < 4; ++d)
#pragma unroll
    for (int r = 0; r < 16; ++r) o[d][r] = 0.f;
  const bf16* Qw = Qt + (size_t)tq * 1024 + hq * 128 + hi * 8;
#pragma unroll
  for (int d0 = 0; d0 < 8; ++d0) qr[d0] = *(const GAS bf16x8*)(Qw + d0 * 16);
  const unsigned* mq = mrow + (size_t)tq * 64;
  const int sr = tid >> 4, sc = (tid & 15) * 8, vst0 = v_st(sr, sc), vst1 = v_st(32 + sr, sc);
  const int vb0 = (int)(size_t)V_lds + v_rd_base(lane);
  struct { bf16x8 vs0, vs1, ks0, ks1; } sr_[1];
#define SLOAD(i, k0) do { sr_[i].vs0 = *(const GAS bf16x8*)(&Vh[(size_t)((k0) + sr) * LDKV + sc]); sr_[i].vs1 = *(const GAS bf16x8*)(&Vh[(size_t)((k0) + 32 + sr) * LDKV + sc]); \
    sr_[i].ks0 = *(const GAS bf16x8*)(&Kh[(size_t)((k0) + sr) * LDKK + sc]); sr_[i].ks1 = *(const GAS bf16x8*)(&Kh[(size_t)((k0) + 32 + sr) * LDKK + sc]); } while (0)
#define SWRITE(b, i) do { *(LAS bf16x8*)(V_lds + (b) * SHM_V + vst0) = sr_[i].vs0;          \
    *(LAS bf16x8*)(V_lds + (b) * SHM_V + vst1) = sr_[i].vs1; const int kc = sc * 2;               \
    *(LAS bf16x8*)(K_lds + (b) * SHM_K + KSWZ(sr, kc)) = sr_[i].ks0;                       \
    *(LAS bf16x8*)(K_lds + (b) * SHM_K + KSWZ(32 + sr, kc)) = sr_[i].ks1; } while (0)
#define RESC(a) do { if (__any((a) < 1.f)) { if (hi == 0) al_l[r32] = (a); asm volatile("s_waitcnt lgkmcnt(0)" ::: "memory"); \
    _Pragma("unroll") for (int d = 0; d < 4; ++d) _Pragma("unroll") for (int r = 0; r < 16; ++r) o[d][r] *= al_l[crow(r, hi)]; } } while (0)
#define MASKB(P0, P1, j, BADD) do { const v2u mw_ = *(const GAS v2u*)(mq + 2 * (j)); \
    if ((j) + 3 <= qt) { mask_bias<false>(P0, P1, mw_.x, mw_.y, hi, 0, bt); BADD = bfar; } \
    else { mask_bias<true>(P0, P1, mw_.x, mw_.y, hi, tq - 64 * (j) - 4 * hi, bt); BADD = 0.f; } } while (0)
  f32x16 p0, p1; float mn, al, bd; bf16x8 pa0, pa1, pa2, pa3;
  const int NT = qt + 1;
  SLOAD(0, 0); asm volatile("s_waitcnt vmcnt(0)" ::: "memory"); SWRITE(0, 0); __syncthreads();
#pragma unroll 1
  for (int j = 0; j < NT; ++j) {
    const int bsel = j & 1;
    if (j + 1 < NT) SLOAD(0, (j + 1) * KVBLK);
    SBAR(); qkt(p0, p1, K_lds + bsel * SHM_K, qr, r32, hi);
    MASKB(p0, p1, j, bd); partialSM(p0, p1, bd, m_reg, mn, al);
    RESC(al);
    finishSM(p0, p1, al, l_reg, pa0, pa1, pa2, pa3); SBAR();
    pv_d0(o, vb0 + bsel * (int)SHM_V, pa0, pa1, pa2, pa3);
    if (j + 1 < NT) { asm volatile("s_waitcnt vmcnt(0)" ::: "memory"); SWRITE(bsel ^ 1, 0); }
    __syncthreads();
  }
  if (hi == 0) li_l[r32] = l_reg; asm volatile("s_waitcnt lgkmcnt(0)" ::: "memory");
  float rli[16];
#pragma unroll
  for (int r = 0; r < 16; ++r) rli[r] = __builtin_amdgcn_rcpf(li_l[crow(r, hi)]);
  bf16* Ow = Ob + (size_t)tq0 * 2048 + hq * 128;
#pragma unroll
  for (int r = 0; r < 16; ++r) { const int orow = crow(r, hi);
#pragma unroll
    for (int d0 = 0; d0 < 4; ++d0) Ow[(size_t)orow * 2048 + d0 * 32 + r32] = (bf16)f2bf(o[d0][r] * rli[r]); }
  __syncthreads();
#undef SLOAD
#undef SWRITE
#undef RESC
#undef MASKB
}
#undef KSWZ
#undef SBAR
}
__device__ __forceinline__ void phase_attn2(Frame& F, KA a) {
    const bf16* qn = (const bf16*)(a->ws + WS_QN); const bf16* kn = (const bf16*)(a->ws + WS_KN); const bf16* proj = (const bf16*)(a->ws + WS_PROJ);
    const unsigned* mask = (const unsigned*)(a->ws + WS_MASK); bf16* mix = (bf16*)(a->ws + WS_MIX); const float* relb = a->in[1];
    LAS float* btab = (LAS float*)(F.lds + att::OFF_BIAS);
    for (int i = F.tid; i < 8 * 129; i += NWAVES * 64) { const int h = i / 129, d = i - h * 129; btab[h * 132 + d] = relb[BUCKET[d] * 8 + h]; }
    __syncthreads();
    for (int u = F.bid; u < 256; u += F.G) {
        const int b = u >> 5, kvh = (u >> 4) & 1, ip = u & 15;
#pragma unroll 1
        for (int half = 0; half < 2; ++half) {
            const int qt = half ? ip : 31 - ip;
            att::attn_unit(qn + (size_t)b * T * 1024, kn + (size_t)b * T * 256 + kvh * 128, proj + (size_t)b * T * NPROJ_P + C_V + kvh * 128, mask + (size_t)b * T * 64, mix + (size_t)b * T * 2048,
                           kvh, qt, relb, (LAS char*)F.lds, F.tid);
        }
    }
}

__device__ __forceinline__ void phase_hgrn(Frame& F, KA a, int l) {
    LAS float* qs = (LAS float*)(F.lds); LAS float* fs = (LAS float*)(F.lds + 16384); LAS float* ks = (LAS float*)(F.lds + 32768); LAS float* vs = (LAS float*)(F.lds + 49152); LAS float* ob = (LAS float*)(F.lds + 65536);
    const bf16* proj = (const bf16*)(a->ws + WS_PROJ); bf16* mix = (bf16*)(a->ws + WS_MIX);
    const float* lbl = a->in[11]; const float* gn = a->in[12] + l * 128;
    const int tid = F.tid, j = tid >> 2, dsl = tid & 3, tt_s = tid >> 4, d8 = (tid & 15) * 8;
    for (int unit = F.bid; unit < BATCH * 8; unit += F.G) {
        const int b = unit >> 3, h = unit & 7;
        float lbv[8];
#pragma unroll
        for (int i = 0; i < 8; ++i) lbv[i] = (l == 0) ? 0.f : sigmf(lbl[1024 + h * 128 + d8 + i] - lbl[h * 128 + d8 + i]);
        float S[32];
#pragma unroll
        for (int i = 0; i < 32; ++i) S[i] = 0.f;
#pragma unroll 1
        for (int c = 0; c < T / 32; ++c) {
            {   const bf16* pr = proj + (size_t)(b * T + c * 32 + tt_s) * NPROJ_P + h * 128 + d8;
                const v4u wq = *(const GAS v4u*)(pr + C_HQ), wfv = *(const GAS v4u*)(pr + C_HF), wi = *(const GAS v4u*)(pr + C_HI);
                const float xq[8] = {blo(wq.x), bhi(wq.x), blo(wq.y), bhi(wq.y), blo(wq.z), bhi(wq.z), blo(wq.w), bhi(wq.w)};
                const float xf[8] = {blo(wfv.x), bhi(wfv.x), blo(wfv.y), bhi(wfv.y), blo(wfv.z), bhi(wfv.z), blo(wfv.w), bhi(wfv.w)};
                const float xi[8] = {blo(wi.x), bhi(wi.x), blo(wi.y), bhi(wi.y), blo(wi.z), bhi(wi.z), blo(wi.w), bhi(wi.w)};
                float q[8], f[8], k[8];
#pragma unroll
                for (int i = 0; i < 8; ++i) { q[i] = siluf(xq[i]) * ATT_SCALE; f[i] = lbv[i] + (1.0f - lbv[i]) * sigmf(xf[i]); k[i] = 1.0f - f[i]; }
                const int o = tt_s * 128 + d8;
                *(LAS f32x4*)(qs + o) = (f32x4){q[0], q[1], q[2], q[3]}; *(LAS f32x4*)(qs + o + 4) = (f32x4){q[4], q[5], q[6], q[7]};
                *(LAS f32x4*)(fs + o) = (f32x4){f[0], f[1], f[2], f[3]}; *(LAS f32x4*)(fs + o + 4) = (f32x4){f[4], f[5], f[6], f[7]};
                *(LAS f32x4*)(ks + o) = (f32x4){k[0], k[1], k[2], k[3]}; *(LAS f32x4*)(ks + o + 4) = (f32x4){k[4], k[5], k[6], k[7]};
                *(LAS f32x4*)(vs + o) = (f32x4){xi[0], xi[1], xi[2], xi[3]}; *(LAS f32x4*)(vs + o + 4) = (f32x4){xi[4], xi[5], xi[6], xi[7]};
            }
            __syncthreads();
#pragma unroll 1
            for (int tt = 0; tt < 32; ++tt) {
                const float v = vs[tt * 128 + j]; float o = 0.f;
                const LAS f32x4* f4 = (const LAS f32x4*)(fs + tt * 128 + dsl * 32); const LAS f32x4* k4 = (const LAS f32x4*)(ks + tt * 128 + dsl * 32); const LAS f32x4* q4 = (const LAS f32x4*)(qs + tt * 128 + dsl * 32);
#pragma unroll
                for (int i4 = 0; i4 < 8; ++i4) { const f32x4 ff = f4[i4], kk = k4[i4], qq = q4[i4];
                    S[4 * i4] = ff.x * S[4 * i4] + kk.x * v; o += qq.x * S[4 * i4];
                    S[4 * i4 + 1] = ff.y * S[4 * i4 + 1] + kk.y * v; o += qq.y * S[4 * i4 + 1];
                    S[4 * i4 + 2] = ff.z * S[4 * i4 + 2] + kk.z * v; o += qq.z * S[4 * i4 + 2];
                    S[4 * i4 + 3] = ff.w * S[4 * i4 + 3] + kk.w * v; o += qq.w * S[4 * i4 + 3]; }
                o += swz<1>(o); o += swz<2>(o);
                if (dsl == 0) ob[tt * 128 + j] = o;
            }
            __syncthreads();
            {   const size_t row = (size_t)(b * T + c * 32 + tt_s);
                const f32x4 o0 = *(const LAS f32x4*)(ob + tt_s * 128 + d8), o1 = *(const LAS f32x4*)(ob + tt_s * 128 + d8 + 4);
                float ss = (o0.x * o0.x + o0.y * o0.y) + (o0.z * o0.z + o0.w * o0.w) + (o1.x * o1.x + o1.y * o1.y) + (o1.z * o1.z + o1.w * o1.w);
                ss += swz<1>(ss); ss += swz<2>(ss); ss += swz<4>(ss); ss += swz<8>(ss);
                const float r = 1.0f / sqrtf(ss * (1.0f / 128.0f) + EPS);
                const v4u wg = *(const GAS v4u*)(proj + row * NPROJ_P + C_HG + h * 128 + d8);
                const float xg[8] = {blo(wg.x), bhi(wg.x), blo(wg.y), bhi(wg.y), blo(wg.z), bhi(wg.z), blo(wg.w), bhi(wg.w)};
                const float ov[8] = {o0.x, o0.y, o0.z, o0.w, o1.x, o1.y, o1.z, o1.w};
                unsigned pw[4];
#pragma unroll
                for (int i = 0; i < 4; ++i) pw[i] = pk2(ov[2 * i] * r * gn[d8 + 2 * i] * siluf(xg[2 * i]), ov[2 * i + 1] * r * gn[d8 + 2 * i + 1] * siluf(xg[2 * i + 1]));
                *(GAS v4u*)(mix + row * 2048 + 1024 + h * 128 + d8) = (v4u){pw[0], pw[1], pw[2], pw[3]};
            }
            __syncthreads();
        }
    }
}


namespace hg {
constexpr int LQ = 272, LT = 144;
constexpr int OFF_G = 0, OFF_TOT = 32768, OFF_BV = 34816, OFF_QH0 = 36864, OFF_QH1 = OFF_QH0 + 64 * LQ, OFF_KH = OFF_QH1 + 32 * LQ, OFF_KP = OFF_KH + 64 * LQ, OFF_K2T = OFF_KP + 64 * LQ, OFF_VT = OFF_K2T + 128 * LT, OFF_END = OFF_VT + 128 * LT;
static_assert(OFF_END <= LDSCTL_OFF, "hgrn LDS map");
__device__ __forceinline__ int crow(int r, int hi) { return (r & 3) + 8 * (r >> 2) + 4 * hi; }
__device__ __forceinline__ bf16x8 pack8(const f32x16& x, int s) { v4u w; w.x = pk2(x[8 * s], x[8 * s + 1]); w.y = pk2(x[8 * s + 2], x[8 * s + 3]); w.z = pk2(x[8 * s + 4], x[8 * s + 5]); w.w = pk2(x[8 * s + 6], x[8 * s + 7]); return __builtin_bit_cast(bf16x8, w); }
__device__ __forceinline__ f32x16 xblock(const LAS unsigned char* Kt, const LAS unsigned char* Qt, int r32, int hi) {
    f32x16 x;
#pragma unroll
    for (int i = 0; i < 16; ++i) x[i] = 0.f;
#pragma unroll
    for (int st = 0; st < 8; ++st) { const bf16x8 ka = *(const LAS bf16x8*)(Kt + r32 * LQ + (16 * st + 8 * hi) * 2), qb = *(const LAS bf16x8*)(Qt + r32 * LQ + (16 * st + 8 * hi) * 2);
        x = __builtin_amdgcn_mfma_f32_32x32x16_bf16(ka, qb, x, 0, 0, 0); }
    return x;
}
__device__ __forceinline__ void xtv(f32x16& od, const f32x16& x_, const LAS unsigned char* vt  , int hi) {
    f32x16 x = x_; asm volatile("s_nop 15\n\ts_nop 3" : "+v"(x));
#pragma unroll
    for (int st = 0; st < 2; ++st) { const v2u lo = *(const LAS v2u*)(vt + (16 * st + 4 * hi) * 2), hi2 = *(const LAS v2u*)(vt + (16 * st + 8 + 4 * hi) * 2);
        const v4u w = {lo.x, lo.y, hi2.x, hi2.y};
        od = __builtin_amdgcn_mfma_f32_32x32x16_bf16(pack8(x, st), __builtin_bit_cast(bf16x8, w), od, 0, 0, 0); }
}
}
__device__ __forceinline__ void phase_hgrn1(Frame& F, KA a, int l) {
    using namespace hg;
    LAS unsigned char* L = F.lds; LAS float* G = (LAS float*)(L + OFF_G); LAS float* TOT = (LAS float*)(L + OFF_TOT); LAS float* BV = (LAS float*)(L + OFF_BV);
    const bf16* proj = (const bf16*)(a->ws + WS_PROJ);
    float* OI = (float*)(a->ws + WS_HOI); bf16* UT = (bf16*)(a->ws + WS_HUT); bf16* QH = (bf16*)(a->ws + WS_HQH); float* DEC = (float*)(a->ws + WS_HDEC);
    const float* lbl = a->in[11];
    const int tid = F.tid, lane = F.lane, r32 = lane & 31, hi = lane >> 5, wave = F.wave;
    for (int u = F.bid; u < BATCH * 8 * 32; u += F.G) {
        const int c = u & 31, h = (u >> 5) & 7, b = u >> 8; const size_t row0 = (size_t)b * T + 64 * c;
        float qv[2][8], kv[2][8];
#pragma unroll
        for (int k = 0; k < 2; ++k) { const int slot = tid + 512 * k, t = slot >> 4, d8 = (slot & 15) * 8;
            const bf16* pr = proj + (row0 + t) * NPROJ_P + h * 128 + d8;
            const v4u wq = *(const GAS v4u*)(pr + C_HQ), wf = *(const GAS v4u*)(pr + C_HF), wi = *(const GAS v4u*)(pr + C_HI);
            const float xq[8] = {blo(wq.x), bhi(wq.x), blo(wq.y), bhi(wq.y), blo(wq.z), bhi(wq.z), blo(wq.w), bhi(wq.w)};
            const float xf[8] = {blo(wf.x), bhi(wf.x), blo(wf.y), bhi(wf.y), blo(wf.z), bhi(wf.z), blo(wf.w), bhi(wf.w)};
            float g[8];
#pragma unroll
            for (int i = 0; i < 8; ++i) { const float lb = (l == 0) ? 0.f : sigmf(lbl[1024 + h * 128 + d8 + i] - lbl[h * 128 + d8 + i]);
                const float f = lb + (1.0f - lb) * sigmf(xf[i]); qv[k][i] = siluf(xq[i]) * ATT_SCALE; kv[k][i] = 1.0f - f; g[i] = __logf(f); }
            *(LAS f32x4*)(G + t * 128 + d8) = (f32x4){g[0], g[1], g[2], g[3]}; *(LAS f32x4*)(G + t * 128 + d8 + 4) = (f32x4){g[4], g[5], g[6], g[7]};
            const unsigned vw[4] = {wi.x, wi.y, wi.z, wi.w};
#pragma unroll
            for (int i = 0; i < 8; ++i) *(LAS bf16*)(L + OFF_VT + (d8 + i) * LT + t * 2) = (bf16)((i & 1) ? (vw[i >> 1] >> 16) : (vw[i >> 1] & 0xffffu));
        }
        __syncthreads();
        { const int d = tid & 127, sb = tid >> 7; float run = 0.f;
#pragma unroll
            for (int i = 0; i < 16; ++i) { run += G[(16 * sb + i) * 128 + d]; G[(16 * sb + i) * 128 + d] = run; }
            TOT[sb * 128 + d] = run;
            __syncthreads();
            float off = 0.f;
#pragma unroll
            for (int q = 0; q < 3; ++q) off += (q < sb) ? TOT[q * 128 + d] : 0.f;
#pragma unroll
            for (int i = 0; i < 16; ++i) G[(16 * sb + i) * 128 + d] += off;
            if (sb == 0) { const float b1 = TOT[d] + TOT[128 + d], bl = b1 + TOT[256 + d] + TOT[384 + d]; BV[d] = b1; BV[128 + d] = bl;
                DEC[(size_t)u * 128 + d] = __expf(bl); }
        }
        __syncthreads();
#pragma unroll
        for (int k = 0; k < 2; ++k) { const int slot = tid + 512 * k, t = slot >> 4, d8 = (slot & 15) * 8; const int J = t >> 5;
            const f32x4 ba = *(const LAS f32x4*)(G + t * 128 + d8), bb = *(const LAS f32x4*)(G + t * 128 + d8 + 4);
            const f32x4 b1a = *(const LAS f32x4*)(BV + d8), b1b = *(const LAS f32x4*)(BV + d8 + 4), bla = *(const LAS f32x4*)(BV + 128 + d8), blb = *(const LAS f32x4*)(BV + 128 + d8 + 4);
            const float bt[8] = {ba.x, ba.y, ba.z, ba.w, bb.x, bb.y, bb.z, bb.w}, b1[8] = {b1a.x, b1a.y, b1a.z, b1a.w, b1b.x, b1b.y, b1b.z, b1b.w}, bl[8] = {bla.x, bla.y, bla.z, bla.w, blb.x, blb.y, blb.z, blb.w};
            float q0[8], q1[8], kh[8], kp[8], k2[8];
#pragma unroll
            for (int i = 0; i < 8; ++i) { const float bj = J ? b1[i] : 0.f, bj1 = J ? bl[i] : b1[i];
                q0[i] = qv[k][i] * __expf(bt[i]); q1[i] = qv[k][i] * __expf(bt[i] - b1[i]);
                kh[i] = kv[k][i] * __expf(bj1 - bt[i]); kp[i] = kv[k][i] * __expf(fminf(bj - bt[i], 80.f)); k2[i] = kv[k][i] * __expf(bl[i] - bt[i]); }
            const v4u w0 = {pk2(q0[0], q0[1]), pk2(q0[2], q0[3]), pk2(q0[4], q0[5]), pk2(q0[6], q0[7])};
            *(LAS v4u*)(L + OFF_QH0 + t * LQ + d8 * 2) = w0; *(GAS v4u*)(QH + (row0 + t) * 1024 + h * 128 + d8) = w0;
            if (J) *(LAS v4u*)(L + OFF_QH1 + (t - 32) * LQ + d8 * 2) = (v4u){pk2(q1[0], q1[1]), pk2(q1[2], q1[3]), pk2(q1[4], q1[5]), pk2(q1[6], q1[7])};
            *(LAS v4u*)(L + OFF_KH + t * LQ + d8 * 2) = (v4u){pk2(kh[0], kh[1]), pk2(kh[2], kh[3]), pk2(kh[4], kh[5]), pk2(kh[6], kh[7])};
            *(LAS v4u*)(L + OFF_KP + t * LQ + d8 * 2) = (v4u){pk2(kp[0], kp[1]), pk2(kp[2], kp[3]), pk2(kp[4], kp[5]), pk2(kp[6], kp[7])};
#pragma unroll
            for (int i = 0; i < 8; ++i) *(LAS bf16*)(L + OFF_K2T + (d8 + i) * LT + t * 2) = (bf16)f2bf(k2[i]);
        }
        __syncthreads();
        { const int I = wave >> 2, dvb = wave & 3;
            f32x16 od;
#pragma unroll
            for (int i = 0; i < 16; ++i) od[i] = 0.f;
            const LAS unsigned char* vrow = L + OFF_VT + (32 * dvb + r32) * LT;
            if (I == 0) {
                f32x16 x = xblock(L + OFF_KP, L + OFF_QH0, r32, hi);
#pragma unroll
                for (int i = 0; i < 16; ++i) x[i] = (crow(i, hi) <= r32) ? x[i] : 0.f;
                xtv(od, x, vrow, hi);
            } else {
                f32x16 x = xblock(L + OFF_KH, L + OFF_QH1, r32, hi);
                xtv(od, x, vrow, hi);
                x = xblock(L + OFF_KP + 32 * LQ, L + OFF_QH1, r32, hi);
#pragma unroll
                for (int i = 0; i < 16; ++i) x[i] = (crow(i, hi) <= r32) ? x[i] : 0.f;
                xtv(od, x, vrow + 64, hi);
            }
            float* op = OI + (row0 + 32 * I) * 1024 + h * 128 + 32 * dvb + r32;
#pragma unroll
            for (int i = 0; i < 16; ++i) op[(size_t)crow(i, hi) * 1024] = od[i];
#pragma unroll
            for (int e = 0; e < 2; ++e) { const int dvb2 = wave >> 1, dkb = 2 * (wave & 1) + e;
                f32x16 uacc;
#pragma unroll
                for (int i = 0; i < 16; ++i) uacc[i] = 0.f;
#pragma unroll
                for (int st = 0; st < 4; ++st) { const bf16x8 va = *(const LAS bf16x8*)(L + OFF_VT + (32 * dvb2 + r32) * LT + (16 * st + 8 * hi) * 2), kb = *(const LAS bf16x8*)(L + OFF_K2T + (32 * dkb + r32) * LT + (16 * st + 8 * hi) * 2);
                    uacc = __builtin_amdgcn_mfma_f32_32x32x16_bf16(va, kb, uacc, 0, 0, 0); }
                bf16* up = UT + (size_t)u * 16384 + (size_t)(32 * dvb2) * 128 + 32 * dkb + r32;
#pragma unroll
                for (int i = 0; i < 16; ++i) up[crow(i, hi) * 128] = (bf16)f2bf(uacc[i]);
            }
        }
        __syncthreads();
    }
}
__device__ __forceinline__ void phase_hgrn2(Frame& F, KA a, int l) {
    LAS unsigned char* L = F.lds; constexpr int LS = 272; LAS float* OB = (LAS float*)(L + 36864); LAS float* DECS = (LAS float*)(L + 69632); LAS unsigned char* QS = L + 70656;
    const bf16* proj = (const bf16*)(a->ws + WS_PROJ); bf16* mix = (bf16*)(a->ws + WS_MIX);
    const float* OI = (const float*)(a->ws + WS_HOI); const bf16* UT = (const bf16*)(a->ws + WS_HUT); const bf16* QH = (const bf16*)(a->ws + WS_HQH); const float* DEC = (const float*)(a->ws + WS_HDEC);
    const float* gn = a->in[12] + l * 128;
    const int tid = F.tid, lane = F.lane, r32 = lane & 31, hi = lane >> 5, wave = F.wave;
    const int dv = tid >> 2, dkq = tid & 3, I = wave >> 2, dvb = wave & 3, tn = tid >> 3, d16 = (tid & 7) * 16;
    for (int u = F.bid; u < BATCH * 8; u += F.G) {
        const int b = u >> 3, h = u & 7;
        float S[32];
#pragma unroll
        for (int i = 0; i < 32; ++i) S[i] = 0.f;
#pragma unroll
        for (int i = 0; i < 4; ++i) *(LAS v4u*)(L + dv * LS + (32 * dkq + 8 * i) * 2) = (v4u){0u, 0u, 0u, 0u};
        v4u qn0, qn1, g0, g1, uw[4]; f32x4 oi[4]; float dn = 0.f;
#define H2_ROWQ(c) (QH + ((size_t)b * T + 64 * (c) + tn) * 1024 + h * 128 + d16)
#define H2_LDQ(c) do { qn0 = *(const GAS v4u*)(H2_ROWQ(c)); qn1 = *(const GAS v4u*)(H2_ROWQ(c) + 8); if (tid < 128) dn = DEC[((size_t)u * 32 + (c)) * 128 + tid]; } while (0)
#define H2_STQ(c) do { *(LAS v4u*)(QS + ((c) & 1) * (64 * LS) + tn * LS + d16 * 2) = qn0; *(LAS v4u*)(QS + ((c) & 1) * (64 * LS) + tn * LS + d16 * 2 + 16) = qn1; if (tid < 128) DECS[((c) & 1) * 128 + tid] = dn; } while (0)
#define H2_LDN(c) do { const size_t row_ = (size_t)b * T + 64 * (c) + tn; \
            _Pragma("unroll") for (int i = 0; i < 4; ++i) oi[i] = *(const GAS f32x4*)(OI + row_ * 1024 + h * 128 + d16 + 4 * i); \
            g0 = *(const GAS v4u*)(proj + row_ * NPROJ_P + C_HG + h * 128 + d16); g1 = *(const GAS v4u*)(proj + row_ * NPROJ_P + C_HG + h * 128 + d16 + 8); } while (0)
#define H2_LDU(c) do { _Pragma("unroll") for (int i = 0; i < 4; ++i) uw[i] = *(const GAS v4u*)(UT + ((size_t)u * 32 + (c)) * 16384 + (size_t)dv * 128 + 32 * dkq + 8 * i); } while (0)
        H2_LDQ(0); H2_LDN(0); H2_LDU(0); H2_STQ(0);
#pragma unroll 1
        for (int c = 0; c < 32; ++c) {
            const size_t row0 = (size_t)b * T + 64 * c;
            if (c + 1 < 32) H2_LDQ(c + 1);
            __syncthreads();
            f32x16 acc;
#pragma unroll
            for (int i = 0; i < 16; ++i) acc[i] = 0.f;
            const LAS unsigned char* qs = QS + (c & 1) * (64 * LS) + (32 * I + r32) * LS + 16 * hi;
#pragma unroll
            for (int st = 0; st < 8; ++st) { const bf16x8 qa = *(const LAS bf16x8*)(qs + 32 * st), sb = *(const LAS bf16x8*)(L + (32 * dvb + r32) * LS + (16 * st + 8 * hi) * 2);
                acc = __builtin_amdgcn_mfma_f32_32x32x16_bf16(qa, sb, acc, 0, 0, 0); }
#pragma unroll
            for (int i = 0; i < 16; ++i) OB[(32 * I + hg::crow(i, hi)) * 128 + 32 * dvb + r32] = acc[i];
            __syncthreads();
            {
                const size_t row = row0 + tn; float ov[16]; float ss = 0.f;
#pragma unroll
                for (int i = 0; i < 4; ++i) { const f32x4 o4 = *(const LAS f32x4*)(OB + tn * 128 + d16 + 4 * i) + oi[i]; ov[4 * i] = o4.x; ov[4 * i + 1] = o4.y; ov[4 * i + 2] = o4.z; ov[4 * i + 3] = o4.w; ss += (o4.x * o4.x + o4.y * o4.y) + (o4.z * o4.z + o4.w * o4.w); }
                ss += swz<1>(ss); ss += swz<2>(ss); ss += swz<4>(ss);
                const float r = __builtin_amdgcn_rsqf(ss * (1.0f / 128.0f) + EPS);
                const float xg[16] = {blo(g0.x), bhi(g0.x), blo(g0.y), bhi(g0.y), blo(g0.z), bhi(g0.z), blo(g0.w), bhi(g0.w), blo(g1.x), bhi(g1.x), blo(g1.y), bhi(g1.y), blo(g1.z), bhi(g1.z), blo(g1.w), bhi(g1.w)};
                unsigned pw[8];
#pragma unroll
                for (int i = 0; i < 8; ++i) pw[i] = pk2(ov[2 * i] * r * gn[d16 + 2 * i] * siluf(xg[2 * i]), ov[2 * i + 1] * r * gn[d16 + 2 * i + 1] * siluf(xg[2 * i + 1]));
                *(GAS v4u*)(mix + row * 2048 + 1024 + h * 128 + d16) = (v4u){pw[0], pw[1], pw[2], pw[3]}; *(GAS v4u*)(mix + row * 2048 + 1024 + h * 128 + d16 + 8) = (v4u){pw[4], pw[5], pw[6], pw[7]};
            }
            if (c + 1 < 32) H2_LDN(c + 1);
            {
                const LAS float* dcs = DECS + (c & 1) * 128 + 32 * dkq;
#pragma unroll
                for (int i = 0; i < 4; ++i) { const unsigned ww[4] = {uw[i].x, uw[i].y, uw[i].z, uw[i].w};
                    const f32x4 d0 = *(const LAS f32x4*)(dcs + 8 * i), d1 = *(const LAS f32x4*)(dcs + 8 * i + 4); const float dcf[8] = {d0.x, d0.y, d0.z, d0.w, d1.x, d1.y, d1.z, d1.w};
#pragma unroll
                    for (int q = 0; q < 4; ++q) { S[8 * i + 2 * q] = dcf[2 * q] * S[8 * i + 2 * q] + blo(ww[q]); S[8 * i + 2 * q + 1] = dcf[2 * q + 1] * S[8 * i + 2 * q + 1] + bhi(ww[q]); }
                    *(LAS v4u*)(L + dv * LS + (32 * dkq + 8 * i) * 2) = (v4u){pk2(S[8 * i], S[8 * i + 1]), pk2(S[8 * i + 2], S[8 * i + 3]), pk2(S[8 * i + 4], S[8 * i + 5]), pk2(S[8 * i + 6], S[8 * i + 7])}; }
            }
            if (c + 1 < 32) { H2_LDU(c + 1); H2_STQ(c + 1); }
        }
#undef H2_ROWQ
#undef H2_LDQ
#undef H2_STQ
#undef H2_LDN
#undef H2_LDU
        __syncthreads();
    }
}

__device__ __forceinline__ void phase_norm_router(Frame& F, KA a, const float* src, bf16* dst) {
    LAS int* lcnt = (LAS int*)(F.lds); LAS int* lbase = (LAS int*)(F.lds + 64); LAS int* stash = (LAS int*)(F.lds + 128);
    float* rstd2 = (float*)(a->ws + WS_TAB + TAB_RSTD2); int* toke = (int*)(a->ws + WS_TAB + TAB_TOKE); int* tokpos = (int*)(a->ws + WS_TAB + TAB_TOKPOS); float* tokp = (float*)(a->ws + WS_TAB + TAB_TOKP);
    unsigned* gcnt = (unsigned*)(a->ws + WS_CTL) + CW_ECNT;
    const float* gain = a->in[3] + 2048; const float* wr = a->in[19];
    const int lane = F.lane;
    for (int chunk = F.bid; chunk < M / 64; chunk += F.G) {
        if (F.tid < 8) lcnt[F.tid] = 0;
        __syncthreads();
#pragma unroll 1
        for (int rr = 0; rr < 8; ++rr) {
            const int lrow = F.wave * 8 + rr; const size_t row = (size_t)chunk * 64 + lrow;
            const GAS f32x4* xr = (const GAS f32x4*)(src + row * D) + lane;
            f32x4 v[8]; float s = 0.f;
#pragma unroll
            for (int jj = 0; jj < 8; ++jj) { v[jj] = xr[64 * jj]; s += (v[jj].x * v[jj].x + v[jj].y * v[jj].y) + (v[jj].z * v[jj].z + v[jj].w * v[jj].w); }
            s = wave_sum(s); const float r = 1.0f / sqrtf(s * (1.0f / D) + EPS);
            GAS v2u* o8 = (GAS v2u*)(dst + row * D) + lane;
            float lg[8] = {0.f, 0.f, 0.f, 0.f, 0.f, 0.f, 0.f, 0.f};
#pragma unroll
            for (int jj = 0; jj < 8; ++jj) { v2u w; w.x = pk2(v[jj].x, v[jj].y); w.y = pk2(v[jj].z, v[jj].w); o8[64 * jj] = w;
                const int d0 = 4 * lane + 256 * jj; const f32x4 g4 = *(const GAS f32x4*)(gain + d0);
                const float xg[4] = {v[jj].x * g4.x, v[jj].y * g4.y, v[jj].z * g4.z, v[jj].w * g4.w};
#pragma unroll
                for (int q = 0; q < 4; ++q) { const f32x4 wa = *(const GAS f32x4*)(wr + (size_t)(d0 + q) * 8), wb = *(const GAS f32x4*)(wr + (size_t)(d0 + q) * 8 + 4);
                    lg[0] += xg[q] * wa.x; lg[1] += xg[q] * wa.y; lg[2] += xg[q] * wa.z; lg[3] += xg[q] * wa.w; lg[4] += xg[q] * wb.x; lg[5] += xg[q] * wb.y; lg[6] += xg[q] * wb.z; lg[7] += xg[q] * wb.w; } }
#pragma unroll
            for (int e = 0; e < 8; ++e) lg[e] = wave_sum(lg[e]) * r;
            int e0 = 0; float v0 = lg[0];
#pragma unroll
            for (int e = 1; e < 8; ++e) if (lg[e] > v0) { v0 = lg[e]; e0 = e; }
            int e1 = -1; float v1 = -INFINITY;
#pragma unroll
            for (int e = 0; e < 8; ++e) if (e != e0 && lg[e] > v1) { v1 = lg[e]; e1 = e; }
            const float p0 = 1.0f / (1.0f + __expf(v1 - v0)), p1 = 1.0f - p0;
            if (lane == 0) { rstd2[row] = r; const int lp0 = atomicAdd((int*)lcnt + e0, 1), lp1 = atomicAdd((int*)lcnt + e1, 1);
                stash[lrow * 4] = e0; stash[lrow * 4 + 1] = e1; stash[lrow * 4 + 2] = lp0; stash[lrow * 4 + 3] = lp1; tokp[row * 2] = p0; tokp[row * 2 + 1] = p1; }
        }
        __syncthreads();
        if (F.tid < 8) lbase[F.tid] = (int)__hip_atomic_fetch_add(gcnt + F.tid, (unsigned)lcnt[F.tid], __ATOMIC_RELAXED, __HIP_MEMORY_SCOPE_AGENT);
        __syncthreads();
        if (F.tid < 64) { const size_t row = (size_t)chunk * 64 + F.tid; const int e0 = stash[F.tid * 4], e1 = stash[F.tid * 4 + 1];
            toke[row * 2] = e0; toke[row * 2 + 1] = e1; tokpos[row * 2] = lbase[e0] + stash[F.tid * 4 + 2]; tokpos[row * 2 + 1] = lbase[e1] + stash[F.tid * 4 + 3]; }
        __syncthreads();
    }
}
struct ExpTab { int t[9]; };
__device__ __forceinline__ void load_exptab(KA a, int (&off)[9]) {
    const unsigned* gcnt = (const unsigned*)(a->ws + WS_CTL) + CW_ECNT;
    off[0] = 0;
#pragma unroll
    for (int e = 0; e < 8; ++e) { const unsigned c = __hip_atomic_load(gcnt + e, __ATOMIC_RELAXED, __HIP_MEMORY_SCOPE_AGENT); off[e + 1] = off[e] + (int)((c + 255u) >> 8); }
}
__device__ __forceinline__ void phase_gather(Frame& F, KA a) {
    int off[9]; load_exptab(a, off);
    const bf16* hb = (const bf16*)(a->ws + WS_HB); bf16* hs = (bf16*)(a->ws + WS_HSX);
    const float* rstd2 = (const float*)(a->ws + WS_TAB + TAB_RSTD2); float* rstds = (float*)(a->ws + WS_TAB + TAB_RSTDS);
    const int* toke = (const int*)(a->ws + WS_TAB + TAB_TOKE); const int* tokpos = (const int*)(a->ws + WS_TAB + TAB_TOKPOS); int* tokdest = (int*)(a->ws + WS_TAB + TAB_TOKDEST);
    const int gw = F.bid * NWAVES + F.wave, NGW = F.G * NWAVES;
    for (int pair = gw; pair < 2 * M; pair += NGW) {
        const int tok = pair >> 1; const int e = toke[pair], pos = tokpos[pair];
        int o = off[0];
#pragma unroll
        for (int q = 1; q < 8; ++q) o = (e == q) ? off[q] : o;
        const int dest = o * 256 + pos;
        const GAS v4u* s = (const GAS v4u*)(hb + (size_t)tok * D) + F.lane; GAS v2u* dd = (GAS v2u*)((unsigned char*)hs + (size_t)dest * D) + F.lane;
#pragma unroll
        for (int jj = 0; jj < 4; ++jj) { const v4u w = s[64 * jj]; unsigned w0 = 0u, w1 = 0u;
            w0 = __builtin_amdgcn_cvt_pk_fp8_f32(blo(w.x), bhi(w.x), w0, false); w0 = __builtin_amdgcn_cvt_pk_fp8_f32(blo(w.y), bhi(w.y), w0, true);
            w1 = __builtin_amdgcn_cvt_pk_fp8_f32(blo(w.z), bhi(w.z), w1, false); w1 = __builtin_amdgcn_cvt_pk_fp8_f32(blo(w.w), bhi(w.w), w1, true);
            dd[64 * jj] = (v2u){w0, w1}; }
        if (F.lane == 0) { rstds[dest] = rstd2[tok]; tokdest[pair] = dest; }
    }
}
__device__ __forceinline__ void phase_combine(Frame& F, KA a) {
    const float* y = (const float*)(a->ws + WS_Y); const int* tokdest = (const int*)(a->ws + WS_TAB + TAB_TOKDEST); const float* tokp = (const float*)(a->ws + WS_TAB + TAB_TOKP);
    const int gw = F.bid * NWAVES + F.wave, NGW = F.G * NWAVES;
    for (int row = gw; row < M; row += NGW) {
        const int d0 = tokdest[2 * row], d1 = tokdest[2 * row + 1]; const float p0 = tokp[2 * row], p1 = tokp[2 * row + 1];
        GAS f32x4* o = (GAS f32x4*)(a->out + (size_t)row * D) + F.lane; const GAS f32x4* y0 = (const GAS f32x4*)(y + (size_t)d0 * D) + F.lane; const GAS f32x4* y1 = (const GAS f32x4*)(y + (size_t)d1 * D) + F.lane;
#pragma unroll
        for (int jj = 0; jj < 8; ++jj) o[64 * jj] = o[64 * jj] + y0[64 * jj] * p0 + y1[64 * jj] * p1;
    }
}

#ifndef MK_ONE_LAUNCH
#define MK_ONE_LAUNCH 1
#endif
constexpr int PH_PER_LAYER = 16, NPHASE = 2 * PH_PER_LAYER;
constexpr int CONV_GG = 128;
__global__ void __launch_bounds__(NWAVES * 64, 2) mk_fwd(Args args) {
    extern __shared__ __attribute__((aligned(16))) unsigned char lds[];
    LAS unsigned char* const ldsb = (LAS unsigned char*)lds;
    const int wave_s = __builtin_amdgcn_readfirstlane(threadIdx.x >> 6);
    for (int u = threadIdx.x; u < (LDS_BYTES - LDSCTL_OFF) / 4; u += NWAVES * 64) ((LAS unsigned*)(ldsb + LDSCTL_OFF))[u] = 0u;
    __syncthreads();
    XcdBarrier bar; bar.bar = nullptr; bar.x = 0; bar.st = nullptr;
    if (MK_ONE_LAUNCH) { KA a = ka_get(); bar = xcd_barrier_post((unsigned*)(a->ws + WS_CTL) + CW_BAR, (volatile LAS unsigned*)(ldsb + MISC_OFF) + 8); }
    const int lo = args.ph_lo, hi = args.ph_hi;
#define IN(k) in_range((k), lo, hi)
#define SEAM(k) do { if (MK_ONE_LAUNCH && IN(k) && IN((k) + 1)) { XcdBarrier b2_ = bar; asm volatile("" : "+s"(b2_.bar)); xcd_barrier(b2_); } } while (0)
#pragma unroll 1
    for (int l = 0; l < 2; ++l) {
        const int pb = l * PH_PER_LAYER;
        if (IN(pb + 0)) { KA a = ka_get(); Frame F = make_frame(ldsb, wave_s); unsigned char* ws = a->ws; if (l == 0) phase_conv(F, a, 0, F.G == 256 ? 1 : 16, F.bid, F.G);
            phase_norm_t<true>(F, (l == 0) ? a->in[0] : (const float*)(ws + WS_H), (bf16*)(ws + WS_XB), (float*)(ws + WS_RSTD1)); }
        SEAM(pb + 0);
        if (IN(pb + 1)) { KA a = ka_get(); Frame F = make_frame(ldsb, wave_s); unsigned char* ws = a->ws;
            const bool split = (l == 0 && F.G == 256);
            const int Gv = split ? CONV_GG : F.G;
            if (F.bid < Gv) {
                pg8::Gemm g{(const bf16*)(ws + WS_XB), (const bf16*)(ws + WS_WIN + l * WIN_SZ), M, NPROJ_P, D / 2, D / 2, F.tid, 0x7f7f7f7f, 0x79797979};     pg8::StaticOrder S; S.init(M, F.G == 256 ? NPROJ_P - 256 : NPROJ_P, Gv, F.bid);
                pg8::EpiScaleBf16 E{(bf16*)(ws + WS_PROJ), NPROJ_P, (const float*)(ws + WS_RSTD1)};
                pg8::gemm_phase<pg8::EpiScaleBf16, pg8::StaticOrder, true, true, true>(F.lds + RING_OFF, g, S, E);
            } else phase_conv(F, a, 1, 16, F.bid - CONV_GG, F.G - CONV_GG);
        }
        SEAM(pb + 1);
        if (IN(pb + 2)) { KA a = ka_get(); Frame F = make_frame(ldsb, wave_s); phase_post(F, a, l); }
        SEAM(pb + 2);
        if (IN(pb + 3)) { KA a = ka_get(); Frame F = make_frame(ldsb, wave_s); unsigned char* ws = a->ws;
            pg8::Gemm g{(const bf16*)(ws + WS_PROJ) + C_CQ, (const bf16*)(ws + WS_WIDX + l * WIDX_SZ), M, 1024, 512, NPROJ_P, F.tid, 0, 0}; pg8::StaticOrder S; S.init(M, 1024, F.G, F.bid);
            pg8::EpiScaleBf16 E{(bf16*)(ws + WS_QIDX), 1024, (const float*)(ws + WS_RSTDCQ)};
            pg8::gemm_phase<pg8::EpiScaleBf16, pg8::StaticOrder, true, true>(F.lds + RING_OFF, g, S, E);
        }
        SEAM(pb + 3);
        if (IN(pb + 4)) { KA a = ka_get(); Frame F = make_frame(ldsb, wave_s); phase_index2(F, a); }
        SEAM(pb + 4);
        if (IN(pb + 5)) { KA a = ka_get(); Frame F = make_frame(ldsb, wave_s); phase_attn2(F, a); }
        SEAM(pb + 5);
        if (IN(pb + 6)) { KA a = ka_get(); Frame F = make_frame(ldsb, wave_s); phase_hgrn1(F, a, l); }
        SEAM(pb + 6);
        if (IN(pb + 7)) { KA a = ka_get(); Frame F = make_frame(ldsb, wave_s); unsigned char* ws = a->ws;
            const bool split = F.G >= 128;
            if (!split || F.bid < 64) phase_hgrn2(F, a, l);
            if (!split || F.bid >= 64) {
                pg8::Gemm g{(const bf16*)(ws + WS_MIX), (const bf16*)(ws + WS_WUA + l * WU_SZ), M, D, 1024, D, F.tid, 0, 0}; pg8::StaticOrder S; S.init(M, D, split ? F.G - 64 : F.G, split ? F.bid - 64 : F.bid);
                pg8::EpiGate<0> E{(float*)(ws + WS_TMP), nullptr, D, (const bf16*)(ws + WS_PROJ) + C_GA, NPROJ_P};
                pg8::gemm_phase<pg8::EpiGate<0>, pg8::StaticOrder, true, true>(F.lds + RING_OFF, g, S, E);
            }
            if (F.G == 256 && F.bid >= 192) {
                pg8::Gemm g{(const bf16*)(ws + WS_XB), (const bf16*)(ws + WS_WIN + l * WIN_SZ), M, NPROJ_P, D / 2, D / 2, F.tid, 0x7f7f7f7f, 0x79797979};     pg8::OneUnit S{F.bid - 192, NPROJ_P / 256 - 1, true};
                pg8::EpiScaleBf16 E{(bf16*)(ws + WS_PROJ), NPROJ_P, (const float*)(ws + WS_RSTD1)};
                pg8::gemm_phase<pg8::EpiScaleBf16, pg8::OneUnit, true, true, true>(F.lds + RING_OFF, g, S, E);
            }
        }
        SEAM(pb + 7);
        if (IN(pb + 9)) { KA a = ka_get(); Frame F = make_frame(ldsb, wave_s); unsigned char* ws = a->ws;
            pg8::Gemm g{(const bf16*)(ws + WS_MIX) + 1024, (const bf16*)(ws + WS_WUH + l * WU_SZ), M, D, 1024, D, F.tid, 0, 0}; pg8::StaticOrder S; S.init(M, D, F.G, F.bid);
            pg8::EpiGate<1> E{(float*)(ws + WS_TMP), (bf16*)(ws + WS_MRG), D, (const bf16*)(ws + WS_PROJ) + C_GH, NPROJ_P};
            pg8::gemm_phase<pg8::EpiGate<1>, pg8::StaticOrder, true, true>(F.lds + RING_OFF, g, S, E);
        }
        SEAM(pb + 9);
        if (IN(pb + 10)) { KA a = ka_get(); Frame F = make_frame(ldsb, wave_s); unsigned char* ws = a->ws;
            pg8::Gemm g{(const bf16*)(ws + WS_MRG), (const bf16*)(ws + WS_WO + l * WO_SZ), M, D, D, D, F.tid, 0, 0}; pg8::StaticOrder S; S.init(M, D, F.G, F.bid);
            pg8::EpiResF32 E{(l == 0) ? a->in[0] : (const float*)(ws + WS_H), (l == 0) ? (float*)(ws + WS_H) : a->out, D, 1 << 20};
            pg8::gemm_phase<pg8::EpiResF32, pg8::StaticOrder, true, true>(F.lds + RING_OFF, g, S, E);
        }
        SEAM(pb + 10);
        if (IN(pb + 11)) { KA a = ka_get(); Frame F = make_frame(ldsb, wave_s); unsigned char* ws = a->ws;
            if (l == 0) phase_norm_t<false>(F, (const float*)(ws + WS_H), (bf16*)(ws + WS_HB), (float*)(ws + WS_TAB + TAB_RSTD2)); else phase_norm_router(F, a, a->out, (bf16*)(ws + WS_HB)); }
        SEAM(pb + 11);
        if (l == 0) {
            if (IN(pb + 12)) { KA a = ka_get(); Frame F = make_frame(ldsb, wave_s); unsigned char* ws = a->ws;
                pg8::Gemm g{(const bf16*)(ws + WS_HB), (const bf16*)(ws + WS_W13D), M, 2 * FFD, D, D, F.tid, 0, 0}; pg8::StaticOrder S; S.init(M, 2 * FFD, F.G, F.bid);
                pg8::EpiSwiGLU E{(bf16*)(ws + WS_PROJ), FFD, 1 << 20, (const float*)(ws + WS_TAB + TAB_RSTD2)};
                pg8::gemm_phase<pg8::EpiSwiGLU, pg8::StaticOrder, true, true>(F.lds + RING_OFF, g, S, E);
            }
            SEAM(pb + 12);
            if (IN(pb + 13)) { KA a = ka_get(); Frame F = make_frame(ldsb, wave_s); unsigned char* ws = a->ws;
                pg8::Gemm g{(const bf16*)(ws + WS_PROJ), (const bf16*)(ws + WS_W2D), M, D, FFD, FFD, F.tid, 0, 0}; pg8::StaticOrder S; S.init(M, D, F.G, F.bid);
                pg8::EpiResF32 E{(const float*)(ws + WS_H), (float*)(ws + WS_H), D, 1 << 20};
                pg8::gemm_phase<pg8::EpiResF32, pg8::StaticOrder, true, true>(F.lds + RING_OFF, g, S, E);
            }
            SEAM(pb + 13);
        } else {
            if (IN(pb + 12)) { KA a = ka_get(); Frame F = make_frame(ldsb, wave_s); phase_gather(F, a); }
            SEAM(pb + 12);
            if (IN(pb + 13)) { KA a = ka_get(); Frame F = make_frame(ldsb, wave_s); unsigned char* ws = a->ws;
                int off[9]; load_exptab(a, off);
                pg8::Gemm g{(const bf16*)(ws + WS_HSX), (const bf16*)(ws + WS_W13M), MS, 2 * FFE, D / 2, D / 2, F.tid, 0x7f7f7f7f, 0x79797979};
                pg8::MoeOrder S{F.G, F.bid, 2 * FFE / 256, off[0], off[1], off[2], off[3], off[4], off[5], off[6], off[7], off[8]};
                pg8::EpiSwiGLUT<true> E{(bf16*)(ws + WS_ACTM), FFE, 2 * FFE / 256, (const float*)(ws + WS_TAB + TAB_RSTDS)};
                pg8::gemm_phase<pg8::EpiSwiGLUT<true>, pg8::MoeOrder, true, true, true>(F.lds + RING_OFF, g, S, E);
            }
            SEAM(pb + 13);
            if (IN(pb + 14)) { KA a = ka_get(); Frame F = make_frame(ldsb, wave_s); unsigned char* ws = a->ws;
                int off[9]; load_exptab(a, off);
                pg8::Gemm g{(const bf16*)(ws + WS_ACTM), (const bf16*)(ws + WS_W2M), MS, D, FFE / 2, FFE / 2, F.tid, 0x7c7c7c7c, 0x79797979};
                pg8::MoeOrder S{F.G, F.bid, D / 256, off[0], off[1], off[2], off[3], off[4], off[5], off[6], off[7], off[8]};
                pg8::EpiResF32 E{nullptr, (float*)(ws + WS_Y), D, D / 256};
                pg8::gemm_phase<pg8::EpiResF32, pg8::MoeOrder, true, true, true>(F.lds + RING_OFF, g, S, E);
            }
            SEAM(pb + 14);
            if (IN(pb + 15)) { KA a = ka_get(); Frame F = make_frame(ldsb, wave_s); phase_combine(F, a); }
        }
    }
#undef IN
#undef SEAM
}

extern "C" void kernel_launch(void* const* d_in, const int* in_sizes, int n_in, void* d_out, int out_size, void* d_ws, size_t ws_size, hipStream_t stream) {
    static int grid = 0;
    if (grid == 0) {
        if (n_in != 23 || out_size != M * D || ws_size < WS_END) { fprintf(stderr, "kernel_launch: unexpected shapes (n_in %d out %d ws %zu need %zu)\n", n_in, out_size, ws_size, (size_t)WS_END); grid = -1; return; }
        int dev = 0, cus = 0, per_cu = 0;
        if (hipGetDevice(&dev) != hipSuccess || hipDeviceGetAttribute(&cus, hipDeviceAttributeMultiprocessorCount, dev) != hipSuccess) { grid = -1; return; }
        if (hipFuncSetAttribute((const void*)mk_fwd, hipFuncAttributeMaxDynamicSharedMemorySize, LDS_BYTES) != hipSuccess) { fprintf(stderr, "kernel_launch: hipFuncSetAttribute failed\n"); grid = -1; return; }
        if (hipOccupancyMaxActiveBlocksPerMultiprocessor(&per_cu, (const void*)mk_fwd, NWAVES * 64, LDS_BYTES) != hipSuccess || per_cu < 1) fprintf(stderr, "kernel_launch: occupancy query says %d\n", per_cu);
        (void)hipGetLastError();
        grid = cus;
    }
    if (grid < 0) return;
    (void)hipMemsetAsync((char*)d_ws + WS_CTL, 0, CTL_ZERO_BYTES, stream);
    Args a{};
    for (int i = 0; i < 23; ++i) a.in[i] = (const float*)d_in[i];
    a.out = (float*)d_out; a.ws = (unsigned char*)d_ws;
#if MK_ONE_LAUNCH
    a.ph_lo = 0; a.ph_hi = NPHASE;
    hipLaunchKernelGGL(mk_fwd, dim3(grid), dim3(NWAVES * 64), LDS_BYTES, stream, a);
#else
    for (int p = 0; p < NPHASE; ++p) {
        if (p == 14 || p == 15) continue;
        a.ph_lo = p; a.ph_hi = p + 1;
        hipLaunchKernelGGL(mk_fwd, dim3(grid), dim3(NWAVES * 64), LDS_BYTES, stream, a);
    }
#endif
}
```

```cpp
#include <hip/hip_runtime.h>
#include <cstdio>
#include <cstdint>
namespace pg8 {
#define PG8_LAS __attribute__((address_space(3)))
typedef unsigned short bf16_t;
typedef short bf16x8 __attribute__((ext_vector_type(8)));
typedef float f32x4 __attribute__((ext_vector_type(4)));
typedef unsigned u32x4 __attribute__((ext_vector_type(4)));
typedef int i32x8 __attribute__((ext_vector_type(8)));
constexpr int BM = 256, BK = 64, HALF = 128, HTB = HALF * BK * 2  , STAGE_BYTES = 8 * HTB, NXCD = 8, WGM = 8;

__host__ __device__ __forceinline__ int lds_byte(int r, int c) { const int st = (r >> 4) * 2 + (c >> 5), rr = r & 15, cc = c & 31, ob = rr * 64 + cc * 2; return st * 1024 + (ob ^ (((ob >> 9) & 1) << 5)); }
__host__ __device__ __forceinline__ void stage_rc(int b, int& R, int& C) { const int st = b / 1024, sb = b % 1024, swz = sb ^ (((sb >> 9) & 1) << 5); R = (st >> 1) * 16 + swz / 64; C = (st & 1) * 32 + (swz % 64) / 2; }
__host__ __device__ __forceinline__ int perm32(int rho) { const int n = rho >> 4, i = rho & 15; return 8 * (i >> 2) + 4 * n + (i & 3); }

struct Unit { int pm, pn; };
struct Gemm { const bf16_t* A; const bf16_t* Bt; int M, N, K, lda, tid; int scaleA, scaleB; int ldb = 0; };

struct StaticOrder {
    int nM, nN, nwg, G, c;
    __host__ __device__ void init(int M, int N, int G_, int c_) { nM = M / BM; nN = N / BM; nwg = nM * nN; G = G_; c = c_; }
    __host__ __device__ bool next(int i, Unit& u) const {
        const long L = (long)i * G + c; if (L >= nwg) return false;
        int wgid = (int)L; { const int q = nwg / NXCD, r = nwg % NXCD, xcd = wgid % NXCD, off = wgid / NXCD; wgid = (xcd < r ? xcd * (q + 1) : r * (q + 1) + (xcd - r) * q) + off; }
        const int nig = WGM * nN, gid = wgid / nig, fm = gid * WGM, gsz = (nM - fm) < WGM ? (nM - fm) : WGM;
        u.pm = fm + ((wgid % nig) % gsz); u.pn = (wgid % nig) / gsz; return true;
    }
    __device__ __forceinline__ void a_ready(const Unit&) const {}
    __device__ __forceinline__ void done(const Unit&) const {}
};

__device__ __forceinline__ unsigned cvt_pk_bf16(float lo, float hi) { unsigned r; asm volatile("v_cvt_pk_bf16_f32 %0, %1, %2" : "=v"(r) : "v"(lo), "v"(hi)); return r; }
__device__ __forceinline__ float bflo(unsigned w) { return __builtin_bit_cast(float, w << 16); }
__device__ __forceinline__ float bfhi(unsigned w) { return __builtin_bit_cast(float, w & 0xffff0000u); }
__device__ __forceinline__ float sigm(float x) { return __builtin_amdgcn_rcpf(1.0f + __builtin_amdgcn_exp2f(-1.4426950408889634f * x)); }
__device__ __forceinline__ float silu(float x) { return x * __builtin_amdgcn_rcpf(1.0f + __builtin_amdgcn_exp2f(-1.4426950408889634f * x)); }

struct EpiScaleBf16 {
    static constexpr bool PERM = true, AFTER_DRAIN = false;
    bf16_t* O; int ldc; const float* rs;
    __device__ __forceinline__ void operator()(const f32x4 (&acc)[2][2][4][2], const Unit& u, int wr, int wc, int fr, int fq) const {
        const int row0 = u.pm * BM + wr * 64 + fr, col0 = u.pn * BM + wc * 32 + 8 * fq;
#pragma unroll
        for (int ai = 0; ai < 2; ++ai)
#pragma unroll
            for (int m = 0; m < 4; ++m) { const int row = row0 + ai * HALF + m * 16; const float s = rs[row]; bf16_t* rowp = O + (size_t)row * ldc + col0;
#pragma unroll
                for (int bj = 0; bj < 2; ++bj) { const f32x4 v0 = acc[ai][bj][m][0] * s, v1 = acc[ai][bj][m][1] * s;
                    u32x4 w; w.x = cvt_pk_bf16(v0[0], v0[1]); w.y = cvt_pk_bf16(v0[2], v0[3]); w.z = cvt_pk_bf16(v1[0], v1[1]); w.w = cvt_pk_bf16(v1[2], v1[3]);
                    *(u32x4*)(rowp + bj * HALF) = w; } }
    }
};
template <int MODE> struct EpiGate {
    static constexpr bool PERM = true, AFTER_DRAIN = false;
    float* C; bf16_t* O; int ldc; const bf16_t* G; int ldg;
    __device__ __forceinline__ void operator()(const f32x4 (&acc)[2][2][4][2], const Unit& u, int wr, int wc, int fr, int fq) const {
        const int row0 = u.pm * BM + wr * 64 + fr, col0 = u.pn * BM + wc * 32 + 8 * fq;
#pragma unroll
        for (int ai = 0; ai < 2; ++ai)
#pragma unroll
            for (int m = 0; m < 4; ++m) { const int row = row0 + ai * HALF + m * 16;
#pragma unroll
                for (int bj = 0; bj < 2; ++bj) { const int col = col0 + bj * HALF;
                    const u32x4 gw = *(const u32x4*)(G + (size_t)row * ldg + col);
                    f32x4 g0, g1; g0[0] = sigm(bflo(gw.x)); g0[1] = sigm(bfhi(gw.x)); g0[2] = sigm(bflo(gw.y)); g0[3] = sigm(bfhi(gw.y));
                    g1[0] = sigm(bflo(gw.z)); g1[1] = sigm(bfhi(gw.z)); g1[2] = sigm(bflo(gw.w)); g1[3] = sigm(bfhi(gw.w));
                    float* cp = C + (size_t)row * ldc + col;
                    if (MODE == 0) { *(f32x4*)cp = acc[ai][bj][m][0] * g0; *(f32x4*)(cp + 4) = acc[ai][bj][m][1] * g1; }
                    else { const f32x4 v0 = *(const f32x4*)cp + acc[ai][bj][m][0] * g0, v1 = *(const f32x4*)(cp + 4) + acc[ai][bj][m][1] * g1;
                        u32x4 w; w.x = cvt_pk_bf16(v0[0], v0[1]); w.y = cvt_pk_bf16(v0[2], v0[3]); w.z = cvt_pk_bf16(v1[0], v1[1]); w.w = cvt_pk_bf16(v1[2], v1[3]);
                        *(u32x4*)(O + (size_t)row * ldc + col) = w; } } }
    }
};
struct EpiResF32 {
    static constexpr bool PERM = true, AFTER_DRAIN = false;
    const float* res; float* out; int ldc, npn;
    __device__ __forceinline__ void operator()(const f32x4 (&acc)[2][2][4][2], const Unit& u, int wr, int wc, int fr, int fq) const {
        const int row0 = u.pm * BM + wr * 64 + fr, col0 = (u.pn % npn) * BM + wc * 32 + 8 * fq;
#pragma unroll
        for (int ai = 0; ai < 2; ++ai)
#pragma unroll
            for (int m = 0; m < 4; ++m) { const size_t off = (size_t)(row0 + ai * HALF + m * 16) * ldc + col0;
#pragma unroll
                for (int bj = 0; bj < 2; ++bj) { f32x4 v0 = acc[ai][bj][m][0], v1 = acc[ai][bj][m][1];
                    if (res) { v0 += *(const f32x4*)(res + off + bj * HALF); v1 += *(const f32x4*)(res + off + bj * HALF + 4); }
                    *(f32x4*)(out + off + bj * HALF) = v0; *(f32x4*)(out + off + bj * HALF + 4) = v1; } }
    }
};
template <bool F8OUT> struct EpiSwiGLUT {
    static constexpr bool PERM = true, AFTER_DRAIN = false;
    bf16_t* O; int ldc, npn; const float* rs;
    __device__ __forceinline__ void operator()(const f32x4 (&acc)[2][2][4][2], const Unit& u, int wr, int wc, int fr, int fq) const {
        const int row0 = u.pm * BM + wr * 64 + fr, col0 = (u.pn % npn) * HALF + wc * 32 + 8 * fq;
#pragma unroll
        for (int ai = 0; ai < 2; ++ai)
#pragma unroll
            for (int m = 0; m < 4; ++m) { const int row = row0 + ai * HALF + m * 16; const float r = rs[row];
                float o[8];
#pragma unroll
                for (int n = 0; n < 2; ++n)
#pragma unroll
                    for (int j = 0; j < 4; ++j) { const float a1 = acc[ai][0][m][n][j] * r, a3 = acc[ai][1][m][n][j] * r; o[4 * n + j] = silu(a1) * a3; }
                if constexpr (F8OUT) {
                    unsigned w0 = 0u, w1 = 0u;
#pragma unroll
                    for (int j = 0; j < 8; ++j) o[j] = __builtin_amdgcn_fmed3f(o[j] * 8.0f, -440.f, 440.f);
                    w0 = __builtin_amdgcn_cvt_pk_fp8_f32(o[0], o[1], w0, false); w0 = __builtin_amdgcn_cvt_pk_fp8_f32(o[2], o[3], w0, true);
                    w1 = __builtin_amdgcn_cvt_pk_fp8_f32(o[4], o[5], w1, false); w1 = __builtin_amdgcn_cvt_pk_fp8_f32(o[6], o[7], w1, true);
                    typedef unsigned u32x2_ __attribute__((ext_vector_type(2)));
                    *(u32x2_*)((unsigned char*)O + (size_t)row * ldc + col0) = (u32x2_){w0, w1};
                } else {
                u32x4 w; w.x = cvt_pk_bf16(o[0], o[1]); w.y = cvt_pk_bf16(o[2], o[3]); w.z = cvt_pk_bf16(o[4], o[5]); w.w = cvt_pk_bf16(o[6], o[7]);
                *(u32x4*)(O + (size_t)row * ldc + col0) = w; } }
    }
};
typedef EpiSwiGLUT<false> EpiSwiGLU;
struct OneUnit { int pm, pn; bool has;
    __device__ __forceinline__ bool next(int i, Unit& u) const { if (i > 0 || !has) return false; u.pm = pm; u.pn = pn; return true; }
    __device__ __forceinline__ void a_ready(const Unit&) const {}
    __device__ __forceinline__ void done(const Unit&) const {}
};
struct MoeOrder {
    int G, c, nN; int t0, t1, t2, t3, t4, t5, t6, t7, t8; int lim;
    __device__ __forceinline__ bool next(int i, Unit& u) const { const long L = (long)i * G + c; if (L >= (long)lim) return false; at(L, u); return true; }
    __device__ __forceinline__ void at(long L, Unit& u) const {
        int ts = t0, te = t1;
        if (L >= (long)t1 * nN) { ts = t1; te = t2; } if (L >= (long)t2 * nN) { ts = t2; te = t3; } if (L >= (long)t3 * nN) { ts = t3; te = t4; } if (L >= (long)t4 * nN) { ts = t4; te = t5; }
        if (L >= (long)t5 * nN) { ts = t5; te = t6; } if (L >= (long)t6 * nN) { ts = t6; te = t7; } if (L >= (long)t7 * nN) { ts = t7; te = t8; }
        int e = 0; e += (L >= (long)t1 * nN); e += (L >= (long)t2 * nN); e += (L >= (long)t3 * nN); e += (L >= (long)t4 * nN); e += (L >= (long)t5 * nN); e += (L >= (long)t6 * nN); e += (L >= (long)t7 * nN);
        const int Ll = (int)(L - (long)ts * nN), Te = te - ts;
        u.pm = ts + Ll % Te; u.pn = e * nN + Ll / Te;
    }
    __device__ __forceinline__ void a_ready(const Unit&) const {}
    __device__ __forceinline__ void done(const Unit&) const {}
};
template <bool FP8> struct FragT;
template <> struct FragT<false> { bf16x8 k[2]; };
template <> struct FragT<true>  { i32x8 v; };
__device__ __forceinline__ void ld_frag(FragT<false>& f, const PG8_LAS unsigned char* p, int o0, int o1) { f.k[0] = *(const PG8_LAS bf16x8*)(p + o0); f.k[1] = *(const PG8_LAS bf16x8*)(p + o1); }
__device__ __forceinline__ void ld_frag(FragT<true>& f, const PG8_LAS unsigned char* p, int o0, int o1) { const u32x4 a = *(const PG8_LAS u32x4*)(p + o0), b = *(const PG8_LAS u32x4*)(p + o1);
    f.v = (i32x8){(int)a.x, (int)a.y, (int)a.z, (int)a.w, (int)b.x, (int)b.y, (int)b.z, (int)b.w}; }
__device__ __forceinline__ f32x4 mma_frag(const FragT<false>& b, const FragT<false>& a, f32x4 c, int, int) { c = __builtin_amdgcn_mfma_f32_16x16x32_bf16(b.k[0], a.k[0], c, 0, 0, 0); return __builtin_amdgcn_mfma_f32_16x16x32_bf16(b.k[1], a.k[1], c, 0, 0, 0); }
__device__ __forceinline__ f32x4 mma_frag(const FragT<true>& b, const FragT<true>& a, f32x4 c, int sb, int sa) {
    asm volatile("v_mfma_scale_f32_16x16x128_f8f6f4 %0, %1, %2, %0, %3, %4 op_sel_hi:[0,0,0]" : "+v"(c) : "v"(b.v), "v"(a.v), "v"(sb), "v"(sa)); return c; }
template <class Epi, class Sched, bool ALIGN_EPI = false, bool SP2 = false, bool FP8 = false>
__device__ __forceinline__ void gemm_phase(PG8_LAS unsigned char* lds, const Gemm g, const Sched& S, const Epi& E) {
    const int tid = g.tid, wid = __builtin_amdgcn_readfirstlane(tid >> 6), lane = tid & 63, wr = wid >> 2, wc = wid & 3, fr = lane & 15, fq = lane >> 4;
    const int K = g.K, nt = K / BK, ldb = g.ldb ? g.ldb : g.K;
    unsigned voffA[2], voffB[2];
#pragma unroll
    for (int i = 0; i < 2; ++i) { int R, C; stage_rc(tid * 16 + i * 8192, R, C); const int Rb = Epi::PERM ? ((R & ~31) + perm32(R & 31)) : R;
        voffA[i] = (unsigned)(R * g.lda + C) * 2u; voffB[i] = (unsigned)(Rb * ldb + C) * 2u; }
    const size_t kstep = (size_t)(BK * 2);
    const size_t hstepB = (size_t)HALF * ldb * 2, hstepA = (size_t)HALF * g.lda * 2;
    const size_t tstepA = 2 * hstepA, tstepB = 2 * hstepB;
    const unsigned ldsw = (unsigned)wid * 1024u;
    const int aoff = FP8 ? lds_byte(wr * 64 + fr, fq * 16) : lds_byte(wr * 64 + fr, fq * 8), boff = FP8 ? lds_byte(wc * 32 + fr, fq * 16) : lds_byte(wc * 32 + fr, fq * 8);
    const int aoff1 = FP8 ? aoff + 16 : aoff + 1024, boff1 = FP8 ? boff + 16 : boff + 1024;
    int scA = g.scaleA, scB = g.scaleB; asm volatile("" : "+v"(scA), "+v"(scB));
#define PG8_SA(b, h) (((b) * 2 + (h)) * HTB)
#define PG8_SB(b, h) ((4 + (b) * 2 + (h)) * HTB)
#define PG8_STAGE(bufoff, gbase, voff) do { _Pragma("unroll") for (int _i = 0; _i < 2; ++_i) \
        __builtin_amdgcn_global_load_lds((const unsigned*)((const char*)(gbase) + (voff)[_i]), (PG8_LAS unsigned*)(lds + (bufoff) + ldsw + _i * 8192), 16, 0, 0); } while (0)
#define PG8_LDA(dst, b, h) do { _Pragma("unroll") for (int m = 0; m < 4; ++m) ld_frag(dst[m], lds + PG8_SA(b, h) + m * 2048, aoff, aoff1); } while (0)
#define PG8_LDB(dst, b, h) do { _Pragma("unroll") for (int n = 0; n < 2; ++n) ld_frag(dst[n], lds + PG8_SB(b, h) + n * 2048, boff, boff1); } while (0)
#define PG8_MMA(ai, bj, At, Bt) do { __builtin_amdgcn_s_setprio(1); _Pragma("unroll") for (int m = 0; m < 4; ++m) _Pragma("unroll") for (int n = 0; n < 2; ++n) \
        acc[ai][bj][m][n] = mma_frag(Bt[n], At[m], acc[ai][bj][m][n], scB, scA); __builtin_amdgcn_s_setprio(0); } while (0)
#define PG8_WAIT_V(n) asm volatile("s_waitcnt vmcnt(" #n ")" ::: "memory")
#define PG8_WAIT_L(n) asm volatile("s_waitcnt lgkmcnt(" #n ")" ::: "memory")
#define PG8_BAR __builtin_amdgcn_s_barrier()
#define PG8_SCHED __builtin_amdgcn_sched_barrier(0)
    Unit cur, nxt; int ui = 0;
    if (!S.next(0, cur)) return;
    f32x4 acc[2][2][4][2];
#pragma unroll
    for (int a = 0; a < 2; ++a)
#pragma unroll
        for (int b = 0; b < 2; ++b)
#pragma unroll
            for (int m = 0; m < 4; ++m)
#pragma unroll
                for (int n = 0; n < 2; ++n) acc[a][b][m][n] = (f32x4){0.f, 0.f, 0.f, 0.f};
    FragT<FP8> At[4], B0[2], B1[2];
    const char* cA = (const char*)g.A + (size_t)cur.pm * tstepA; const char* cB = (const char*)g.Bt + (size_t)cur.pn * tstepB;
    S.a_ready(cur);
    if constexpr (SP2) {
        PG8_STAGE(PG8_SB(0, 0), cB, voffB); PG8_STAGE(PG8_SB(0, 1), cB + hstepB, voffB); PG8_STAGE(PG8_SA(0, 0), cA, voffA); PG8_STAGE(PG8_SA(0, 1), cA + hstepA, voffA);
        if (wr == 1) PG8_BAR;
        PG8_WAIT_V(2); PG8_BAR;
        PG8_STAGE(PG8_SB(1, 0), cB + kstep, voffB); PG8_STAGE(PG8_SA(1, 0), cA + kstep, voffA); PG8_STAGE(PG8_SB(1, 1), cB + hstepB + kstep, voffB);
        PG8_WAIT_V(6); PG8_BAR;
    } else {
        PG8_STAGE(PG8_SB(0, 0), cB, voffB); PG8_STAGE(PG8_SA(0, 0), cA, voffA); PG8_STAGE(PG8_SB(0, 1), cB + hstepB, voffB); PG8_STAGE(PG8_SA(0, 1), cA + hstepA, voffA);
        if (wr == 1) PG8_BAR;
        PG8_WAIT_V(4); PG8_BAR;
        PG8_STAGE(PG8_SB(1, 0), cB + kstep, voffB); PG8_STAGE(PG8_SA(1, 0), cA + kstep, voffA); PG8_STAGE(PG8_SB(1, 1), cB + hstepB + kstep, voffB);
        PG8_WAIT_V(6); PG8_BAR;
    }
    for (;;) {
        const bool has_next = S.next(ui + 1, nxt);
        const char* nA = has_next ? (const char*)g.A + (size_t)nxt.pm * tstepA : cA; const char* nB = has_next ? (const char*)g.Bt + (size_t)nxt.pn * tstepB : cB;
        for (int t = 0; t < nt; t += 2) {
            const bool last = (t == nt - 2);
            const char* a1 = cA + (size_t)(t + 1) * kstep;
            const char* a2 = last ? nA : cA + (size_t)(t + 2) * kstep; const char* b2 = last ? nB : cB + (size_t)(t + 2) * kstep;
            const char* a3 = a2 + kstep; const char* b3 = b2 + kstep;
            if (last && has_next) S.a_ready(nxt);
            if constexpr (SP2) {
            PG8_LDB(B0, 0, 0); PG8_LDB(B1, 0, 1); PG8_SCHED; PG8_LDA(At, 0, 0); PG8_STAGE(PG8_SA(1, 1), a1 + hstepA, voffA);
            PG8_WAIT_V(8); PG8_WAIT_L(0); PG8_BAR; PG8_MMA(0, 0, At, B0); PG8_MMA(0, 1, At, B1); PG8_BAR; PG8_SCHED;
            PG8_LDA(At, 0, 1); PG8_STAGE(PG8_SB(0, 0), b2, voffB); PG8_STAGE(PG8_SB(0, 1), b2 + hstepB, voffB); PG8_STAGE(PG8_SA(0, 0), a2, voffA);
            PG8_WAIT_V(8); PG8_WAIT_L(0); PG8_BAR; PG8_MMA(1, 0, At, B0); PG8_MMA(1, 1, At, B1); PG8_BAR; PG8_SCHED;
            PG8_LDB(B0, 1, 0); PG8_LDB(B1, 1, 1); PG8_SCHED; PG8_LDA(At, 1, 0); PG8_STAGE(PG8_SA(0, 1), a2 + hstepA, voffA);
            PG8_WAIT_V(8); PG8_WAIT_L(0); PG8_BAR; PG8_MMA(0, 0, At, B0); PG8_MMA(0, 1, At, B1); PG8_BAR; PG8_SCHED;
            PG8_LDA(At, 1, 1); PG8_STAGE(PG8_SB(1, 0), b3, voffB); PG8_STAGE(PG8_SB(1, 1), b3 + hstepB, voffB); PG8_STAGE(PG8_SA(1, 0), a3, voffA);
            PG8_WAIT_V(8); PG8_WAIT_L(0); PG8_BAR; PG8_MMA(1, 0, At, B0); PG8_MMA(1, 1, At, B1); PG8_BAR; PG8_SCHED;
            } else {
            PG8_LDB(B0, 0, 0); PG8_SCHED; PG8_LDA(At, 0, 0); PG8_STAGE(PG8_SA(1, 1), a1 + hstepA, voffA);
            PG8_WAIT_L(8); PG8_BAR; PG8_WAIT_L(0); PG8_MMA(0, 0, At, B0); PG8_BAR; PG8_SCHED;
            PG8_LDB(B1, 0, 1); PG8_STAGE(PG8_SB(0, 0), b2, voffB);
            PG8_BAR; PG8_WAIT_L(0); PG8_MMA(0, 1, At, B1); PG8_BAR;
            PG8_LDA(At, 0, 1); PG8_STAGE(PG8_SA(0, 0), a2, voffA);
            PG8_BAR; PG8_WAIT_L(0); PG8_MMA(1, 0, At, B0); PG8_BAR; PG8_SCHED;
            PG8_STAGE(PG8_SB(0, 1), b2 + hstepB, voffB);
            PG8_WAIT_V(6); PG8_BAR; PG8_MMA(1, 1, At, B1); PG8_BAR;
            PG8_LDB(B0, 1, 0); PG8_SCHED; PG8_LDA(At, 1, 0); PG8_STAGE(PG8_SA(0, 1), a2 + hstepA, voffA);
            PG8_WAIT_L(8); PG8_BAR; PG8_WAIT_L(0); PG8_MMA(0, 0, At, B0); PG8_BAR; PG8_SCHED;
            PG8_LDB(B1, 1, 1); PG8_STAGE(PG8_SB(1, 0), b3, voffB);
            PG8_BAR; PG8_WAIT_L(0); PG8_MMA(0, 1, At, B1); PG8_BAR;
            PG8_LDA(At, 1, 1); PG8_STAGE(PG8_SA(1, 0), a3, voffA);
            PG8_BAR; PG8_WAIT_L(0); PG8_MMA(1, 0, At, B0); PG8_BAR; PG8_SCHED;
            PG8_STAGE(PG8_SB(1, 1), b3 + hstepB, voffB);
            PG8_WAIT_V(6); PG8_BAR; PG8_MMA(1, 1, At, B1); PG8_BAR;
            }
        }
        if constexpr (FP8) asm volatile("s_nop 15\n\ts_nop 15" : "+v"(acc[1][1][0][0]), "+v"(acc[1][1][0][1]), "+v"(acc[1][1][1][0]), "+v"(acc[1][1][1][1]), "+v"(acc[1][1][2][0]), "+v"(acc[1][1][2][1]), "+v"(acc[1][1][3][0]), "+v"(acc[1][1][3][1]) :: "memory");
        if constexpr (ALIGN_EPI) { if (wr == 0) PG8_BAR; }
        if constexpr (!Epi::AFTER_DRAIN) { E(acc, cur, wr, wc, fr, fq); S.done(cur); }
        if (!has_next) break;
#pragma unroll
        for (int a = 0; a < 2; ++a)
#pragma unroll
            for (int b = 0; b < 2; ++b)
#pragma unroll
                for (int m = 0; m < 4; ++m)
#pragma unroll
                    for (int n = 0; n < 2; ++n) acc[a][b][m][n] = (f32x4){0.f, 0.f, 0.f, 0.f};
        cur = nxt; cA = nA; cB = nB; ++ui;
        if constexpr (ALIGN_EPI) { if (wr == 1) PG8_BAR; }
    }
    PG8_WAIT_V(0);
    if constexpr (!ALIGN_EPI) { if (wr == 0) PG8_BAR; }
    PG8_BAR;
    if constexpr (Epi::AFTER_DRAIN) { E.fused(acc, cur, wr, wc, fr, fq, lds, wid, lane); S.done(cur); }
#undef PG8_SA
#undef PG8_SB
#undef PG8_STAGE
#undef PG8_LDA
#undef PG8_LDB
#undef PG8_MMA
#undef PG8_WAIT_V
#undef PG8_WAIT_L
#undef PG8_BAR
#undef PG8_SCHED
}
}

#define GAS __attribute__((address_space(1)))
#define LAS __attribute__((address_space(3)))
typedef unsigned short bf16;
typedef unsigned v4u __attribute__((ext_vector_type(4)));
typedef float f32x4 __attribute__((ext_vector_type(4)));
typedef short bf16x8 __attribute__((ext_vector_type(8)));
typedef GAS unsigned gu32;
typedef GAS unsigned long long gu64;
#define RLX_AGENT __ATOMIC_RELAXED, __HIP_MEMORY_SCOPE_AGENT
#define LDS_WAIT() asm volatile("s_waitcnt lgkmcnt(0)" ::: "memory")
#define VM_WAIT() asm volatile("s_waitcnt vmcnt(0)" ::: "memory")
__device__ __forceinline__ unsigned long long rt() { return __builtin_amdgcn_s_memrealtime(); }
__device__ __forceinline__ unsigned f2bf(float f) { unsigned u = __builtin_bit_cast(unsigned, f); return (u + 0x7fffu + ((u >> 16) & 1u)) >> 16; }
__device__ __forceinline__ unsigned pk2(float lo, float hi) { unsigned r; asm volatile("v_cvt_pk_bf16_f32 %0, %1, %2" : "=v"(r) : "v"(lo), "v"(hi)); return r; }

#define XB_TMO      128
#define XB_XCNT(j)  (256  + 64 * (j))
#define XB_XSUB(j)  (1280 + 64 * (j))
#define XB_XGEN(j)  (2304 + 64 * (j))
#define XB_TOP      3328
#define XB_TOPGEN   3392
#define XCD_BAR_WORDS 3456
#define XB_SPIN_CAP (1u << 18)

__device__ __forceinline__ unsigned xb_ld(unsigned* p)              { return __hip_atomic_load(p, __ATOMIC_RELAXED, __HIP_MEMORY_SCOPE_AGENT); }
__device__ __forceinline__ unsigned xb_add(unsigned* p, unsigned v) { return __hip_atomic_fetch_add(p, v, __ATOMIC_RELAXED, __HIP_MEMORY_SCOPE_AGENT); }
__device__ __forceinline__ unsigned xb_xcc_id() { return (unsigned)__builtin_amdgcn_s_getreg((3 << 11) | 20) & 0xFu; }
#define XB_SPIN(cond, bar) do { unsigned _sp = 0; while (cond) { __builtin_amdgcn_s_sleep(1); \
    if ((++_sp & 255u) == 0u) { if (xb_ld(&(bar)[XB_TMO])) break; if (_sp > XB_SPIN_CAP) { atomicAdd(&(bar)[XB_TMO], 1u); break; } } } } while (0)

struct XcdBarrier {
    unsigned* bar; unsigned x;
    volatile LAS unsigned* st;
};

__device__ __forceinline__ XcdBarrier xcd_barrier_post(unsigned* bar, volatile LAS unsigned* st) {
    XcdBarrier b; b.bar = bar; b.x = xb_xcc_id(); b.st = st;
    if (threadIdx.x == 0) (void)xb_add(&bar[XB_XCNT(b.x)], 1u);
    return b;
}
__device__ __forceinline__ void xcd_barrier_complete(unsigned* bar, unsigned x, unsigned& nloc, unsigned& nx) {
    const unsigned G = gridDim.x * gridDim.y * gridDim.z;
    unsigned sum, cnt, mine, sp = 0u;
    for (;;) {
        sum = 0u; cnt = 0u; mine = 0u;
#pragma unroll
        for (unsigned j = 0; j < 16; ++j) { const unsigned c = xb_ld(&bar[XB_XCNT(j)]); sum += c; cnt += (c > 0u) ? 1u : 0u; mine = (j == x) ? c : mine; }
        if (sum == G) break;
        __builtin_amdgcn_s_sleep(1);
        if ((++sp & 255u) == 0u) { if (xb_ld(&bar[XB_TMO])) break; if (sp > XB_SPIN_CAP) { atomicAdd(&bar[XB_TMO], 1u); break; } }
    }
    nloc = mine > 0u ? mine : 1u; nx = cnt > 0u ? cnt : 1u;
}

__device__ __forceinline__ void xcd_barrier(const XcdBarrier& b) {
    asm volatile("s_waitcnt vmcnt(0)" ::: "memory");
    __syncthreads();
    if (threadIdx.x == 0) {
        unsigned* bar = b.bar;
        __builtin_amdgcn_s_waitcnt(0);
        unsigned nloc = b.st[0], nx = b.st[1];
        if (nloc == 0u) { xcd_barrier_complete(bar, b.x, nloc, nx); b.st[0] = nloc; b.st[1] = nx; }
        const unsigned old = xb_add(&bar[XB_XSUB(b.x)], 1u);
        const unsigned gen = old / nloc;
        if (old + 1u == (gen + 1u) * nloc) {
            __builtin_amdgcn_fence(__ATOMIC_RELEASE, "agent");
            asm volatile("s_waitcnt vmcnt(0)" ::: "memory");
            const unsigned og = xb_add(&bar[XB_TOP], 1u);
            const unsigned tg = og / nx;
            if (og + 1u == (tg + 1u) * nx) xb_add(&bar[XB_TOPGEN], 1u);
            else XB_SPIN(xb_ld(&bar[XB_TOPGEN]) == tg, bar);
            __builtin_amdgcn_fence(__ATOMIC_ACQUIRE, "agent");
            xb_add(&bar[XB_XGEN(b.x)], 1u);
            asm volatile("s_waitcnt vmcnt(0)" ::: "memory");
        } else {
            XB_SPIN(xb_ld(&bar[XB_XGEN(b.x)]) == gen, bar);
            __builtin_amdgcn_fence(__ATOMIC_ACQUIRE, "agent");
            asm volatile("s_waitcnt vmcnt(0)" ::: "memory");
        }
    }
    __syncthreads();
}

constexpr int NWAVES = 8;
constexpr int BATCH = 8, T = 2048, D = 2048, M = BATCH * T;
constexpr int NPROJ = 10320, NPROJ_P = 10496;
constexpr int C_Q = 0, C_K = 1024, C_V = 1280, C_CQ = 1536, C_KID = 2048, C_WID = 2112, C_HQ = 2128, C_HF = 3152, C_HI = 4176, C_HG = 5200, C_GA = 6224, C_GH = 8272;
constexpr int FFD = 5632, FFE = 7168, NEXP = 8;
constexpr int MS = 34816;
constexpr float EPS = 1e-6f;
constexpr float ATT_SCALE = 0.08838834764831845f;
constexpr float IDX_WSCALE = 0.25f * 0.125f;
constexpr int NSEL = 256;

constexpr size_t MiB = 1u << 20;
constexpr size_t WS_CTL = 0, CTL_ZERO_BYTES = 1 * MiB;
constexpr size_t WS_WIN = 2 * MiB, WIN_SZ = 41 * MiB;
constexpr size_t WS_WIDX = 84 * MiB, WIDX_SZ = 1 * MiB;
constexpr size_t WS_WUA = 86 * MiB, WS_WUH = 94 * MiB, WU_SZ = 4 * MiB;
constexpr size_t WS_WO = 102 * MiB, WO_SZ = 8 * MiB;
constexpr size_t WS_W13D = 118 * MiB, WS_W2D = 162 * MiB;
constexpr size_t WS_W13M = 184 * MiB, WS_W2M = 632 * MiB;
constexpr size_t WS_XB = 856 * MiB;
constexpr size_t WS_PROJ = 920 * MiB;
constexpr size_t WS_QN = 1248 * MiB, WS_QIDX = 1280 * MiB, WS_KN = 1312 * MiB, WS_KIDX = 1320 * MiB, WS_WIDXV = 1322 * MiB, WS_MASK = 1323 * MiB;
constexpr size_t WS_RSTD1 = 1327 * MiB, WS_RSTDCQ = WS_RSTD1 + 65536;
constexpr size_t WS_MIX = 1328 * MiB;
constexpr size_t WS_TMP = 1392 * MiB;
constexpr size_t WS_MRG = 1520 * MiB;
constexpr size_t WS_H = 1584 * MiB;
constexpr size_t WS_ACTM = 920 * MiB;
constexpr size_t WS_Y = 1396 * MiB, WS_HS = 1396 * MiB;
constexpr size_t WS_TAB = 1712 * MiB;
constexpr size_t TAB_RSTD2 = 0, TAB_RSTDS = 1 * 65536, TAB_TOKE = 4 * 65536, TAB_TOKPOS = 6 * 65536, TAB_TOKP = 8 * 65536, TAB_TOKDEST = 10 * 65536;
constexpr size_t WS_ISCR = 408 * MiB;
constexpr size_t WS_HOI = 472 * MiB;
constexpr size_t WS_HSX = 536 * MiB;
constexpr size_t WS_HDEC = 604 * MiB;
constexpr size_t WS_HQH = 744 * MiB, WS_HUT = 776 * MiB;
static_assert(WS_W13M + 8ull * 2 * FFE * 2048 <= WS_ISCR && WS_HDEC + 2 * MiB <= WS_W2M && WS_W2M + 8ull * 2048 * FFE <= WS_HQH && WS_HUT + 64 * MiB <= WS_XB, "dedicated regions sit in the unused halves of the expert-weight slots");
constexpr size_t WS_HB = 1714 * MiB;
constexpr size_t WS_END = 1778 * MiB;
static_assert(WS_WIN + 2 * WIN_SZ <= WS_WIDX && WS_W2M + 8ull * 2048 * 7168 * 2 <= WS_XB && WS_PROJ + (size_t)M * NPROJ_P * 2 <= WS_QN && WS_ACTM + (size_t)MS * FFE * 2 <= WS_Y && WS_Y + (size_t)MS * 2048 * 4 <= WS_TAB && WS_H + (size_t)M * D * 4 <= WS_TAB && WS_MRG + (size_t)M * D * 2 <= WS_H && WS_TMP + (size_t)M * D * 4 <= WS_MRG && WS_MIX + (size_t)M * D * 2 <= WS_TMP && WS_RSTDCQ + 65536 <= WS_MIX && WS_XB + (size_t)M * D * 2 <= WS_PROJ && WS_TAB + 12 * 65536 <= WS_END, "ws map");
constexpr int CW_BAR = 4096;
constexpr int CW_ECNT = 16384;

constexpr size_t WS_SLAB = WS_WIN;
static_assert(WS_SLAB + 256ull * 65536 * 4 <= WS_W13M, "slabs sit in dead weight slots");
__device__ __forceinline__ void md_split(int Ltot, int G, int& Lreg, int& KS) {
    Lreg = (Ltot / G) * G; const int R = Ltot - Lreg;
    KS = (R > 0 && 4 * R <= G) ? 4 : (R > 0 && 2 * R <= G) ? 2 : 1;
    if (KS == 1) Lreg = Ltot;
}
constexpr int RING_OFF = 0, RING_BYTES = 131072;
constexpr int LDSCTL_OFF = 135168, MISC_OFF = LDSCTL_OFF + 320;
constexpr int LDS_BYTES = 147456;

__device__ const unsigned char BUCKET[129] = {0, 1, 2, 3, 4, 5, 6, 7, 8, 9, 10, 11, 12, 13, 14, 15, 16, 16, 16, 17, 17, 18, 18, 18, 19, 19, 19, 20, 20, 20, 20, 21, 21, 21, 21, 22, 22, 22, 22, 22, 23, 23, 23, 23, 23, 23, 24, 24, 24, 24, 24, 24, 25, 25, 25, 25, 25, 25, 25, 26, 26, 26, 26, 26, 26, 26, 26, 27, 27, 27, 27, 27, 27, 27, 27, 27, 27, 28, 28, 28, 28, 28, 28, 28, 28, 28, 28, 29, 29, 29, 29, 29, 29, 29, 29, 29, 29, 29, 29, 30, 30, 30, 30, 30, 30, 30, 30, 30, 30, 30, 30, 30, 30, 31, 31, 31, 31, 31, 31, 31, 31, 31, 31, 31, 31, 31, 31, 31, 31};

typedef unsigned v2u __attribute__((ext_vector_type(2)));
struct Args { const float* in[23]; float* out; unsigned char* ws; int ph_lo, ph_hi; };
typedef const __attribute__((address_space(4))) Args* KA;
__device__ __forceinline__ KA ka_get() { KA p = (KA)__builtin_amdgcn_kernarg_segment_ptr(); asm volatile("" : "+s"(p)); return p; }

struct Frame {
    LAS unsigned char* lds;
    int tid, lane, wave, G, bid;
};
__device__ __forceinline__ Frame make_frame(LAS unsigned char* lds, int wave_s) {
    Frame F; int ln; asm volatile("v_mbcnt_lo_u32_b32 %0, -1, 0\n\tv_mbcnt_hi_u32_b32 %0, -1, %0" : "=v"(ln));
    int w = wave_s, b = blockIdx.x, g = gridDim.x; asm volatile("" : "+s"(w), "+s"(b), "+s"(g));
    F.lds = lds; F.lane = ln; F.wave = w; F.tid = w * 64 + ln; F.G = g; F.bid = b; return F;
}
__device__ __forceinline__ bool in_range(int k, int lo, int hi) { asm volatile("" : "+s"(k)); return lo <= k && k < hi; }
template <int O> __device__ __forceinline__ float swz(float v) { return __builtin_bit_cast(float, __builtin_amdgcn_ds_swizzle(__builtin_bit_cast(int, v), (O << 10) | 0x1f)); }
__device__ __forceinline__ void swap32(unsigned a, unsigned& r0, unsigned& r1) { unsigned b = a; asm volatile("" : "+v"(b)); auto rr = __builtin_amdgcn_permlane32_swap(a, b, false, false); r0 = rr[0]; r1 = rr[1]; }
__device__ __forceinline__ float x32_sum(float v) { unsigned r0, r1; swap32(__builtin_bit_cast(unsigned, v), r0, r1); return __builtin_bit_cast(float, r0) + __builtin_bit_cast(float, r1); }
__device__ __forceinline__ float x32_max(float v) { unsigned r0, r1; swap32(__builtin_bit_cast(unsigned, v), r0, r1); return fmaxf(__builtin_bit_cast(float, r0), __builtin_bit_cast(float, r1)); }
__device__ __forceinline__ float wave_sum(float v) { v += swz<1>(v); v += swz<2>(v); v += swz<4>(v); v += swz<8>(v); v += swz<16>(v); return x32_sum(v); }
__device__ __forceinline__ float wave_max(float v) { v = fmaxf(v, swz<1>(v)); v = fmaxf(v, swz<2>(v)); v = fmaxf(v, swz<4>(v)); v = fmaxf(v, swz<8>(v)); v = fmaxf(v, swz<16>(v)); return x32_max(v); }
__device__ __forceinline__ float bf2f(bf16 v) { return __builtin_bit_cast(float, (unsigned)v << 16); }
__device__ __forceinline__ float blo(unsigned w) { return __builtin_bit_cast(float, w << 16); }
__device__ __forceinline__ float bhi(unsigned w) { return __builtin_bit_cast(float, w & 0xffff0000u); }
__device__ __forceinline__ float sigmf(float x) { return __builtin_amdgcn_rcpf(1.0f + __builtin_amdgcn_exp2f(-1.4426950408889634f * x)); }
__device__ __forceinline__ float siluf(float x) { return x * __builtin_amdgcn_rcpf(1.0f + __builtin_amdgcn_exp2f(-1.4426950408889634f * x)); }

struct ConvD { const float* src; bf16* dst; const float* gain; int K, N, Npad, nb; size_t sstride, dstride; int grp, gstride, goff; int f8; };
__device__ __forceinline__ void get_conv(int id, KA a, ConvD& d) {
    const int l = id >> 3, k = id & 7;
    bf16* ws16 = (bf16*)a->ws;
    d.gain = nullptr; d.nb = 1; d.sstride = 0; d.dstride = 0; d.grp = 30; d.gstride = 0; d.goff = 0; d.f8 = 0;
    if (k == 0) { d.src = a->in[4] + (size_t)l * 2048 * NPROJ; d.dst = (bf16*)(a->ws + WS_WIN + l * WIN_SZ); d.gain = a->in[2] + l * 2048; d.K = 2048; d.N = NPROJ; d.Npad = NPROJ_P; d.f8 = 1; }
    else if (k == 1) { d.src = a->in[8] + (size_t)l * 512 * 1024; d.dst = (bf16*)(a->ws + WS_WIDX + l * WIDX_SZ); d.gain = a->in[7] + l * 512; d.K = 512; d.N = 1024; d.Npad = 1024; }
    else if (k == 2) { d.src = a->in[13] + (size_t)l * 1024 * 2048; d.dst = (bf16*)(a->ws + WS_WUA + l * WU_SZ); d.K = 1024; d.N = 2048; d.Npad = 2048; }
    else if (k == 3) { d.src = a->in[14] + (size_t)l * 1024 * 2048; d.dst = (bf16*)(a->ws + WS_WUH + l * WU_SZ); d.K = 1024; d.N = 2048; d.Npad = 2048; }
    else if (k == 4) { d.src = a->in[15] + (size_t)l * 2048 * 2048; d.dst = (bf16*)(a->ws + WS_WO + l * WO_SZ); d.K = 2048; d.N = 2048; d.Npad = 2048; }
    else if (l == 0) {
        if (k == 5) { d.src = a->in[16]; d.dst = (bf16*)(a->ws + WS_W13D); d.gain = a->in[3]; d.K = 2048; d.N = FFD; d.Npad = FFD; d.grp = 7; d.gstride = 256; d.goff = 0; }
        else if (k == 6) { d.src = a->in[17]; d.dst = (bf16*)(a->ws + WS_W13D); d.gain = a->in[3]; d.K = 2048; d.N = FFD; d.Npad = FFD; d.grp = 7; d.gstride = 256; d.goff = 128; }
        else { d.src = a->in[18]; d.dst = (bf16*)(a->ws + WS_W2D); d.K = FFD; d.N = 2048; d.Npad = 2048; }
    } else {
        if (k == 5) { d.src = a->in[20]; d.dst = (bf16*)(a->ws + WS_W13M); d.gain = a->in[3] + 2048; d.K = 2048; d.N = FFE; d.Npad = FFE; d.nb = NEXP; d.sstride = (size_t)2048 * FFE; d.dstride = (size_t)2 * FFE * 2048; d.grp = 7; d.gstride = 256; d.goff = 0; d.f8 = 1; }
        else if (k == 6) { d.src = a->in[21]; d.dst = (bf16*)(a->ws + WS_W13M); d.gain = a->in[3] + 2048; d.K = 2048; d.N = FFE; d.Npad = FFE; d.nb = NEXP; d.sstride = (size_t)2048 * FFE; d.dstride = (size_t)2 * FFE * 2048; d.grp = 7; d.gstride = 256; d.goff = 128; d.f8 = 1; }
        else { d.src = a->in[22]; d.dst = (bf16*)(a->ws + WS_W2M); d.K = FFE; d.N = 2048; d.Npad = 2048; d.nb = NEXP; d.sstride = (size_t)FFE * 2048; d.dstride = (size_t)2048 * FFE; d.f8 = 1; }
    }
    (void)ws16;
}
__device__ __forceinline__ void conv_item(const ConvD& d, long item, LAS float* scr, int lane) {
    const int nblk = d.Npad / 64, kblk = d.K / 64; const int per = kblk * nblk, it32 = (int)item;
    const int e = it32 / per; const int r = it32 - e * per; const int kb = r / nblk, nbi = r - kb * nblk, k0 = 64 * kb, n0 = 64 * nbi;
    const float* src = d.src + (size_t)e * d.sstride; bf16* dst = d.dst + (size_t)e * d.dstride; unsigned char* dst8 = (unsigned char*)d.dst + (size_t)e * d.dstride;
    const int nn = (lane & 15) * 4, kq = lane >> 4;
    const int c = lane & 7;
    f32x4 g0 = {1.f, 1.f, 1.f, 1.f}, g1 = g0;
    if (d.gain) { g0 = *(const GAS f32x4*)(d.gain + k0 + 8 * c); g1 = *(const GAS f32x4*)(d.gain + k0 + 8 * c + 4); }
    f32x4 v[16];
    if (n0 + 64 <= d.N) {
#pragma unroll
        for (int i = 0; i < 16; ++i) { const int kk = 4 * i + kq; v[i] = __builtin_nontemporal_load((const GAS f32x4*)(src + (size_t)(k0 + kk) * d.N + n0 + nn)); }
    } else {
#pragma unroll
        for (int i = 0; i < 16; ++i) { const int kk = 4 * i + kq; v[i] = (n0 + nn < d.N) ? *(const GAS f32x4*)(src + (size_t)(k0 + kk) * d.N + n0 + nn) : (f32x4){0.f, 0.f, 0.f, 0.f}; }
    }
#pragma unroll
    for (int i = 0; i < 16; ++i) { const int kk = 4 * i + kq; LAS float* p = scr + kk * 65 + nn; p[0] = v[i][0]; p[1] = v[i][1]; p[2] = v[i][2]; p[3] = v[i][3]; }
    LDS_WAIT(); asm volatile("" ::: "memory");
    const float g[8] = {g0[0], g0[1], g0[2], g0[3], g1[0], g1[1], g1[2], g1[3]};
#pragma unroll
    for (int j = 0; j < 8; ++j) { const int n = (lane >> 3) + 8 * j; const LAS float* s = scr + (8 * c) * 65 + n;
        const int ng = n0 + n; const int row = (ng >> d.grp) * d.gstride + d.goff + (ng & ((1 << d.grp) - 1));
        if (d.f8) { unsigned w0 = 0u, w1 = 0u;
            w0 = __builtin_amdgcn_cvt_pk_fp8_f32(s[0 * 65] * g[0] * 64.f, s[1 * 65] * g[1] * 64.f, w0, false); w0 = __builtin_amdgcn_cvt_pk_fp8_f32(s[2 * 65] * g[2] * 64.f, s[3 * 65] * g[3] * 64.f, w0, true);
            w1 = __builtin_amdgcn_cvt_pk_fp8_f32(s[4 * 65] * g[4] * 64.f, s[5 * 65] * g[5] * 64.f, w1, false); w1 = __builtin_amdgcn_cvt_pk_fp8_f32(s[6 * 65] * g[6] * 64.f, s[7 * 65] * g[7] * 64.f, w1, true);
            __builtin_nontemporal_store((v2u){w0, w1}, (GAS v2u*)(dst8 + (size_t)row * d.K + k0 + 8 * c)); }
        else { v4u o; o.x = pk2(s[0 * 65] * g[0], s[1 * 65] * g[1]); o.y = pk2(s[2 * 65] * g[2], s[3 * 65] * g[3]); o.z = pk2(s[4 * 65] * g[4], s[5 * 65] * g[5]); o.w = pk2(s[6 * 65] * g[6], s[7 * 65] * g[7]);
            __builtin_nontemporal_store(o, (GAS v4u*)(dst + (size_t)row * d.K + k0 + 8 * c)); } }
    LDS_WAIT(); asm volatile("" ::: "memory");
}
__device__ __forceinline__ void phase_conv(Frame& F, KA a, int id_lo, int id_hi, int vb, int vG) {
    LAS float* scr = (LAS float*)(F.lds + F.wave * 16640);
    const long gw = (long)vb * NWAVES + F.wave, NGW = (long)vG * NWAVES;
    long base = 0;
#pragma unroll 1
    for (int id = id_lo; id < id_hi; ++id) {
        ConvD d; get_conv(id, a, d);
        const long items = (long)d.nb * (d.K / 64) * (d.Npad / 64);
        long first = (gw - base % NGW + NGW) % NGW;
#pragma unroll 1
        for (long it = first; it < items; it += NGW) conv_item(d, it, scr, F.lane);
        base += items;
    }
}

template <bool F8> __device__ __forceinline__ void phase_norm_t(Frame& F, const float* src, bf16* dst, float* rstd) {
    const int gw = F.bid * NWAVES + F.wave, NGW = F.G * NWAVES;
    for (int row = gw; row < M; row += NGW) {
        const GAS f32x4* xr = (const GAS f32x4*)(src + (size_t)row * D) + F.lane;
        f32x4 v[8]; float s = 0.f;
#pragma unroll
        for (int j = 0; j < 8; ++j) { v[j] = xr[64 * j]; s += (v[j].x * v[j].x + v[j].y * v[j].y) + (v[j].z * v[j].z + v[j].w * v[j].w); }
        s = wave_sum(s);
        if constexpr (F8) { GAS unsigned* o4 = (GAS unsigned*)((unsigned char*)dst + (size_t)row * D) + F.lane;
#pragma unroll
            for (int j = 0; j < 8; ++j) { unsigned w = 0u; w = __builtin_amdgcn_cvt_pk_fp8_f32(v[j].x, v[j].y, w, false); w = __builtin_amdgcn_cvt_pk_fp8_f32(v[j].z, v[j].w, w, true); o4[64 * j] = w; } }
        else { GAS v2u* o8 = (GAS v2u*)(dst + (size_t)row * D) + F.lane;
#pragma unroll
            for (int j = 0; j < 8; ++j) { v2u w; w.x = pk2(v[j].x, v[j].y); w.y = pk2(v[j].z, v[j].w); o8[64 * j] = w; } }
        if (F.lane == 0) rstd[row] = 1.0f / sqrtf(s * (1.0f / D) + EPS);
    }
}

__device__ __forceinline__ void phase_post(Frame& F, KA a, int l) {
    const int gw = F.bid * NWAVES + F.wave, NGW = F.G * NWAVES, lane = F.lane;
    const bf16* proj = (const bf16*)(a->ws + WS_PROJ);
    bf16* qn = (bf16*)(a->ws + WS_QN); bf16* kn = (bf16*)(a->ws + WS_KN); bf16* kidx = (bf16*)(a->ws + WS_KIDX); float* widx = (float*)(a->ws + WS_WIDXV); float* rstdcq = (float*)(a->ws + WS_RSTDCQ);
    const float* qg = a->in[5] + l * 128; const float* kg = a->in[6] + l * 128; const float* lng = a->in[9] + l * 64; const float* lnb = a->in[10] + l * 64;
    for (int row = gw; row < M; row += NGW) {
        const bf16* pr = proj + (size_t)row * NPROJ_P;
        {
            const v4u w0 = *(const GAS v4u*)(pr + C_Q + 16 * lane), w1 = *(const GAS v4u*)(pr + C_Q + 16 * lane + 8);
            float x[16] = {blo(w0.x), bhi(w0.x), blo(w0.y), bhi(w0.y), blo(w0.z), bhi(w0.z), blo(w0.w), bhi(w0.w), blo(w1.x), bhi(w1.x), blo(w1.y), bhi(w1.y), blo(w1.z), bhi(w1.z), blo(w1.w), bhi(w1.w)};
            float ss = 0.f;
#pragma unroll
            for (int i = 0; i < 16; ++i) ss += x[i] * x[i];
            ss += swz<1>(ss); ss += swz<2>(ss); ss += swz<4>(ss);
            const float r = ATT_SCALE / sqrtf(ss * (1.0f / 128.0f) + EPS); const int d0 = (lane & 7) * 16;
            unsigned o[8];
#pragma unroll
            for (int i = 0; i < 8; ++i) o[i] = pk2(x[2 * i] * r * qg[d0 + 2 * i], x[2 * i + 1] * r * qg[d0 + 2 * i + 1]);
            *(GAS v4u*)(qn + (size_t)row * 1024 + 16 * lane) = (v4u){o[0], o[1], o[2], o[3]}; *(GAS v4u*)(qn + (size_t)row * 1024 + 16 * lane + 8) = (v4u){o[4], o[5], o[6], o[7]};
        }
        {
            const v2u w = *(const GAS v2u*)(pr + C_K + 4 * lane);
            const float x0 = blo(w.x), x1 = bhi(w.x), x2 = blo(w.y), x3 = bhi(w.y);
            float ss = x0 * x0 + x1 * x1 + x2 * x2 + x3 * x3;
            ss += swz<1>(ss); ss += swz<2>(ss); ss += swz<4>(ss); ss += swz<8>(ss); ss += swz<16>(ss);
            const float r = 1.0f / sqrtf(ss * (1.0f / 128.0f) + EPS); const int d0 = (lane & 31) * 4;
            v2u o; o.x = pk2(x0 * r * kg[d0], x1 * r * kg[d0 + 1]); o.y = pk2(x2 * r * kg[d0 + 2], x3 * r * kg[d0 + 3]);
            *(GAS v2u*)(kn + (size_t)row * 256 + 4 * lane) = o;
        }
        {
            const v4u w = *(const GAS v4u*)(pr + C_CQ + 8 * lane);
            const float x[8] = {blo(w.x), bhi(w.x), blo(w.y), bhi(w.y), blo(w.z), bhi(w.z), blo(w.w), bhi(w.w)};
            float ss = 0.f;
#pragma unroll
            for (int i = 0; i < 8; ++i) ss += x[i] * x[i];
            ss = wave_sum(ss);
            if (lane == 0) rstdcq[row] = 1.0f / sqrtf(ss * (1.0f / 512.0f) + EPS);
        }
        {
            const float x = bf2f(pr[C_KID + lane]);
            const float mu = wave_sum(x) * (1.0f / 64.0f); const float dd = x - mu; const float var = wave_sum(dd * dd) * (1.0f / 64.0f);
            const float y = dd / sqrtf(var + EPS) * lng[lane] + lnb[lane];
            kidx[(size_t)row * 64 + lane] = (bf16)f2bf(y);
        }
        if (lane < 16) widx[(size_t)row * 16 + lane] = bf2f(pr[C_WID + lane]) * IDX_WSCALE;
    }
}

__device__ __forceinline__ unsigned ordkey(float v) { const unsigned u = __builtin_bit_cast(unsigned, v); return (u & 0x80000000u) ? ~u : (u | 0x80000000u); }
typedef float f32x16 __attribute__((ext_vector_type(16)));
typedef float f32x2 __attribute__((ext_vector_type(2)));
__device__ __forceinline__ int wave_total6(int cl) { int c = 0;
#pragma unroll
    for (int b = 0; b < 6; ++b) c += __popcll(__ballot((cl >> b) & 1)) << b;
    return c; }
__device__ __forceinline__ void select_row(unsigned (&key)[32], int t, unsigned long long* mrow, int lane) {
    if (t + 1 <= NSEL) {
#pragma unroll
        for (int j = 0; j < 32; ++j) { const unsigned long long bs = __ballot(key[j] != 0u); if (lane == 0) mrow[j] = bs; }
    } else {
#pragma unroll
        for (int st = 0; st < 5; ++st) { const int j = 16 >> st; const unsigned m = st == 0 ? 0x0000FFFFu : st == 1 ? 0x00FF00FFu : st == 2 ? 0x0F0F0F0Fu : st == 3 ? 0x33333333u : 0x55555555u;
#pragma unroll
            for (int k = 0; k < 32; ++k) if (!(k & j)) { const unsigned x = ((key[k] >> j) ^ key[k + j]) & m; key[k] ^= x << j; key[k + j] ^= x; } }
        unsigned G = 0u, E = 0xffffffffu;
#pragma unroll
        for (int bit = 31; bit >= 0; --bit) {
            const unsigned m = E & key[bit];
            const bool take = wave_total6(__popc(G) + __popc(m)) >= NSEL;
            E = take ? m : (E & ~m); G = take ? G : (G | m);
        }
        const int need = NSEL - wave_total6(__popc(G)); int running = 0;
        const unsigned long long lt = (lane == 0) ? 0ull : (~0ull >> (64 - lane));
#pragma unroll
        for (int j = 0; j < 32; ++j) {
            const bool eq = (E >> j) & 1u; const unsigned long long be = __ballot(eq);
            const int rank = running + __popcll(be & lt);
            const bool sel = ((G >> j) & 1u) || (eq && rank < need);
            running += __popcll(be);
            const unsigned long long bs = __ballot(sel); if (lane == 0) mrow[j] = bs;
        }
    }
}
__device__ __forceinline__ void phase_index2(Frame& F, KA a) {
    LAS unsigned char* Ws = F.lds + 66048;
    LAS unsigned char* Qs = F.lds;
    const bf16* qidx = (const bf16*)(a->ws + WS_QIDX); const bf16* kidx = (const bf16*)(a->ws + WS_KIDX); const float* widx = (const float*)(a->ws + WS_WIDXV);
    unsigned long long* mask = (unsigned long long*)(a->ws + WS_MASK);
    float* scr = (float*)(a->ws + WS_ISCR) + (size_t)F.bid * 65536;
    const int tid = F.tid, lane = F.lane, r = lane & 31, hi = lane >> 5, wave = F.wave;
    for (int u = F.bid; u < 256; u += F.G) {
        const int b = u >> 5, ii = u & 31;
#pragma unroll 1
        for (int half = 0; half < 2; ++half) {
            const int qb = half ? 63 - ii : ii; const int row0 = b * T + 32 * qb;
#pragma unroll
            for (int c = 0; c < 8; ++c) { const int row = tid >> 4, ch = (tid & 15) + 16 * c;
                *(LAS v4u*)(Qs + row * 2064 + ch * 16) = *(const GAS v4u*)(qidx + (size_t)(row0 + row) * 1024 + ch * 8); }
            if (tid < 128) *(LAS f32x4*)(Ws + 16 * tid) = *(const GAS f32x4*)(widx + (size_t)row0 * 16 + 4 * tid);
            __syncthreads();
#pragma unroll 1
            for (int kb = wave; kb <= qb; kb += 8) {
                bf16x8 kf[4]; const bf16* kp = kidx + (size_t)(b * T + 32 * kb + r) * 64 + 8 * hi;
#pragma unroll
                for (int ks = 0; ks < 4; ++ks) kf[ks] = *(const GAS bf16x8*)(kp + 16 * ks);
                f32x16 sc;
#pragma unroll
                for (int i = 0; i < 16; ++i) sc[i] = 0.f;
                const LAS unsigned char* qrow = Qs + r * 2064 + hi * 16; const LAS float* wrow = (const LAS float*)(Ws + r * 64);
                bf16x8 qa[4], qb[4];
#pragma unroll
                for (int ks = 0; ks < 4; ++ks) qa[ks] = *(const LAS bf16x8*)(qrow + ks * 32);
#pragma unroll 1
                for (int h = 0; h < 16; h += 2) {
#pragma unroll
                    for (int ks = 0; ks < 4; ++ks) qb[ks] = *(const LAS bf16x8*)(qrow + (h + 1) * 128 + ks * 32);
                    const float wA = wrow[h], wB = wrow[h + 1];
                    f32x16 accA, accB;
#pragma unroll
                    for (int i = 0; i < 16; ++i) { accA[i] = 0.f; accB[i] = 0.f; }
                    __builtin_amdgcn_sched_barrier(0);
#pragma unroll
                    for (int ks = 0; ks < 4; ++ks) accA = __builtin_amdgcn_mfma_f32_32x32x16_bf16(kf[ks], qa[ks], accA, 0, 0, 0);
                    __builtin_amdgcn_sched_barrier(0);
                    if (h + 2 < 16) {
#pragma unroll
                        for (int ks = 0; ks < 4; ++ks) qa[ks] = *(const LAS bf16x8*)(qrow + (h + 2) * 128 + ks * 32); }
#pragma unroll
                    for (int ks = 0; ks < 4; ++ks) accB = __builtin_amdgcn_mfma_f32_32x32x16_bf16(kf[ks], qb[ks], accB, 0, 0, 0);
                    __builtin_amdgcn_sched_barrier(0);
#pragma unroll
                    for (int i = 0; i < 16; ++i) sc[i] = fmaf(wA, __builtin_amdgcn_fmed3f(accA[i], 0.f, 3.0e38f), sc[i]);
#pragma unroll
                    for (int i = 0; i < 16; ++i) sc[i] = fmaf(wB, __builtin_amdgcn_fmed3f(accB[i], 0.f, 3.0e38f), sc[i]);
                }
                LAS float* Tw = (LAS float*)(F.lds + 68096 + wave * 4224);
#pragma unroll
                for (int i = 0; i < 16; ++i) Tw[r * 33 + (i & 3) + 8 * (i >> 2) + 4 * hi] = sc[i];
                asm volatile("s_waitcnt lgkmcnt(0)" ::: "memory");
#pragma unroll
                for (int j = 0; j < 16; ++j) { const int q = 2 * j + hi; scr[(size_t)q * 2048 + 32 * kb + r] = Tw[q * 33 + r]; }
                asm volatile("s_waitcnt lgkmcnt(0)" ::: "memory");
            }
            __syncthreads();
#pragma unroll 1
            for (int pass = 0; pass < 2; ++pass) {
                const int q0 = 4 * wave + 2 * pass, ta = 32 * qb + q0, tb = ta + 1; const size_t rowa = (size_t)row0 + q0;
                unsigned ka[32], kb2[32];
#pragma unroll
                for (int j = 0; j < 32; ++j) { const int s = lane + 64 * j; float vx = 0.f, vy = 0.f;
                    if (s <= 32 * qb + 31) { vx = *(const GAS float*)(scr + (size_t)q0 * 2048 + s); vy = *(const GAS float*)(scr + (size_t)(q0 + 1) * 2048 + s); }
                    ka[j] = (s <= ta) ? ordkey(vx) : 0u; kb2[j] = (s <= tb) ? ordkey(vy) : 0u; }
                select_row(ka, ta, mask + rowa * 32, lane);
                select_row(kb2, tb, mask + (rowa + 1) * 32, lane);
            }
            __syncthreads();
        }
    }
}

namespace att {
using s16x4  = __attribute__((ext_vector_type(4))) short;
constexpr int KVBLK = 64; constexpr size_t SHM_V = 16384, SHM_K = 16384; constexpr int OFF_WS = 65536, OFF_BIAS = 67584;
constexpr float THR = 8.f, LOG2E = 1.4426950408889634f;
#define KSWZ(row, colB) ((row) * 256 + ((colB) ^ (((row) & 7) << 4)))
#define SBAR() __builtin_amdgcn_sched_barrier(0)
__device__ __forceinline__ int crow(int r, int hi) { return (r & 3) + 8 * (r >> 2) + 4 * hi; }
__device__ __forceinline__ unsigned cvtpk(float lo, float hi) { unsigned r; asm volatile("v_cvt_pk_bf16_f32 %0, %1, %2" : "=v"(r) : "v"(lo), "v"(hi)); return r; }
template <bool NEAR> __device__ __forceinline__ void mask_bias(f32x16& p0, f32x16& p1, unsigned w0, unsigned w1, int hi, int dbase, const LAS float* bt) {
    const unsigned s0 = w0 >> (4 * hi), s1 = w1 >> (4 * hi);
#pragma unroll
    for (int r = 0; r < 16; ++r) { const int bp = (r & 3) + 8 * (r >> 2);
        float a = p0[r], b = p1[r];
        if (NEAR) { int i0 = dbase - bp, i1 = dbase - bp - 32; i0 = i0 < 0 ? 0 : (i0 > 128 ? 128 : i0); i1 = i1 < 0 ? 0 : (i1 > 128 ? 128 : i1); a += bt[i0]; b += bt[i1]; }
        p0[r] = ((s0 >> bp) & 1u) ? a : -INFINITY; p1[r] = ((s1 >> bp) & 1u) ? b : -INFINITY; }
}
__device__ __forceinline__ void partialSM(f32x16& p0, f32x16& p1, float badd, float& m_reg, float& mn, float& alpha) {
  float pmax = p0[0];
#pragma unroll
  for (int r = 1; r < 16; ++r) pmax = __builtin_amdgcn_fmed3f(pmax, p0[r], INFINITY);
#pragma unroll
  for (int r = 0; r < 16; ++r) pmax = __builtin_amdgcn_fmed3f(pmax, p1[r], INFINITY);
  pmax += badd;
  pmax = x32_max(pmax);
  if (__builtin_expect(__all(pmax - m_reg <= THR), 1)) { mn = m_reg; alpha = 1.f; }
  else { mn = fmaxf(m_reg, pmax); alpha = __builtin_amdgcn_exp2f((m_reg - mn) * LOG2E); m_reg = mn; }
  const float mnC = (badd - mn) * LOG2E;
#pragma unroll
  for (int r = 0; r < 16; ++r) p0[r] = fmaf(p0[r], LOG2E, mnC);
#pragma unroll
  for (int r = 0; r < 16; ++r) p1[r] = fmaf(p1[r], LOG2E, mnC);
#pragma unroll
  for (int r = 0; r < 16; ++r) p0[r] = __builtin_amdgcn_exp2f(p0[r]);
}
__device__ __forceinline__ void finishSM(f32x16& p0, f32x16& p1, float alpha, float& l_reg, bf16x8& pa0, bf16x8& pa1, bf16x8& pa2, bf16x8& pa3) {
#pragma unroll
  for (int r = 0; r < 16; ++r) p1[r] = __builtin_amdgcn_exp2f(p1[r]);
  float ps = 0;
#pragma unroll
  for (int r = 0; r < 16; ++r) ps += p0[r];
#pragma unroll
  for (int r = 0; r < 16; ++r) ps += p1[r];
  ps = x32_sum(ps);
  l_reg = l_reg * alpha + ps;
#define PK4(P, BASE, OUT) do { unsigned a0 = cvtpk(P[BASE + 0], P[BASE + 1]), a1 = cvtpk(P[BASE + 2], P[BASE + 3]);   \
    unsigned b0 = cvtpk(P[BASE + 4], P[BASE + 5]), b1 = cvtpk(P[BASE + 6], P[BASE + 7]);                              \
    auto r0 = __builtin_amdgcn_permlane32_swap(a0, b0, false, false); auto r1 = __builtin_amdgcn_permlane32_swap(a1, b1, false, false); \
    v4u w = {r0[0], r1[0], r0[1], r1[1]}; OUT = __builtin_bit_cast(bf16x8, w); } while (0)
  PK4(p0, 0, pa0); PK4(p0, 8, pa1); PK4(p1, 0, pa2); PK4(p1, 8, pa3);
#undef PK4
}
__device__ __forceinline__ void qkt(f32x16& p0, f32x16& p1, const LAS char* Ks, const bf16x8* qr, int r32, int hi) {
#pragma unroll
  for (int r = 0; r < 16; ++r) { p0[r] = 0.f; p1[r] = 0.f; }
#pragma unroll
  for (int d0 = 0; d0 < 8; ++d0) { const int cb = (d0 * 16 + hi * 8) * 2;
    const bf16x8 b0 = *(const LAS bf16x8*)(Ks + KSWZ(r32, cb));
    const bf16x8 b1 = *(const LAS bf16x8*)(Ks + KSWZ(32 + r32, cb));
    p0 = __builtin_amdgcn_mfma_f32_32x32x16_bf16(b0, qr[d0], p0, 0, 0, 0);
    p1 = __builtin_amdgcn_mfma_f32_32x32x16_bf16(b1, qr[d0], p1, 0, 0, 0); }
}
__device__ __forceinline__ int v_st(int k, int c) { const int kk = (k & ~0xC) | ((k & 4) << 1) | ((k & 8) >> 1); return ((kk >> 3) * 4 + (c >> 5)) * 512 + ((kk & 7) * 32 + (c & 31)) * 2; }
__device__ __forceinline__ int v_rd_base(int lane) { return ((lane & 3) << 3) | (((lane >> 2) & 3) << 6) | (((lane >> 4) & 1) << 5) | (((lane >> 5) & 1) << 8); }
constexpr int v_rd_off(int d0, int ks, int half) { return d0 * 512 + ks * 4096 + half * 2048; }
template <int OFF> __device__ __forceinline__ s16x4 tr_read(int vb) { s16x4 r; asm volatile("ds_read_b64_tr_b16 %0, %1 offset:%2" : "=&v"(r) : "v"(vb), "i"(OFF) : "memory"); return r; }
template <int D0> __device__ __forceinline__ void pv_one(f32x16& od, int vb, bf16x8 pa0, bf16x8 pa1, bf16x8 pa2, bf16x8 pa3) {
  const s16x4 l0 = tr_read<v_rd_off(D0, 0, 0)>(vb), h0 = tr_read<v_rd_off(D0, 0, 1)>(vb), l1 = tr_read<v_rd_off(D0, 1, 0)>(vb), h1 = tr_read<v_rd_off(D0, 1, 1)>(vb);
  const s16x4 l2 = tr_read<v_rd_off(D0, 2, 0)>(vb), h2 = tr_read<v_rd_off(D0, 2, 1)>(vb), l3 = tr_read<v_rd_off(D0, 3, 0)>(vb), h3 = tr_read<v_rd_off(D0, 3, 1)>(vb);
  asm volatile("s_waitcnt lgkmcnt(0)" ::: "memory"); SBAR();
#define PK(L, H) (bf16x8){L[0], L[1], L[2], L[3], H[0], H[1], H[2], H[3]}
  od = __builtin_amdgcn_mfma_f32_32x32x16_bf16(pa0, PK(l0, h0), od, 0, 0, 0);
  od = __builtin_amdgcn_mfma_f32_32x32x16_bf16(pa1, PK(l1, h1), od, 0, 0, 0);
  od = __builtin_amdgcn_mfma_f32_32x32x16_bf16(pa2, PK(l2, h2), od, 0, 0, 0);
  od = __builtin_amdgcn_mfma_f32_32x32x16_bf16(pa3, PK(l3, h3), od, 0, 0, 0);
#undef PK
}
__device__ __forceinline__ void pv_d0(f32x16* o, int vb, bf16x8 pa0, bf16x8 pa1, bf16x8 pa2, bf16x8 pa3) {
  pv_one<0>(o[0], vb, pa0, pa1, pa2, pa3); pv_one<1>(o[1], vb, pa0, pa1, pa2, pa3); pv_one<2>(o[2], vb, pa0, pa1, pa2, pa3); pv_one<3>(o[3], vb, pa0, pa1, pa2, pa3);
}
__device__ __forceinline__ void attn_unit(const bf16* __restrict__ Qt, const bf16* __restrict__ Kh, const bf16* __restrict__ Vh, const unsigned* __restrict__ mrow, bf16* __restrict__ Ob,
                                          int kvh, int qt, const float* relb, LAS char* lds, int tid) {
  constexpr int LDKK = 256, LDKV = NPROJ_P;
  const int wid = __builtin_amdgcn_readfirstlane(tid >> 6), lane = tid & 63, r32 = lane & 31, hi = lane >> 5;
  LAS char* V_lds = lds; LAS char* K_lds = lds + 2 * SHM_V;
  LAS float* wsf = (LAS float*)(lds + OFF_WS) + wid * 64; LAS float* li_l = wsf; LAS float* al_l = wsf + 32;
  const int hq = kvh * 4 + (wid >> 1), tq0 = 64 * qt + 32 * (wid & 1), tq = tq0 + r32;
  const LAS float* bt = (const LAS float*)(lds + OFF_BIAS) + hq * 132;
  const float bfar = relb[31 * 8 + hq];
  float m_reg = -1e30f, l_reg = 0; f32x16 o[4]; bf16x8 qr[8];
#pragma unroll
  for (int d = 0; d < 4; ++d)
#pragma unroll
    for (int r = 0; r < 16; ++r) o[d][r] = 0.f;
  const bf16* Qw = Qt + (size_t)tq * 1024 + hq * 128 + hi * 8;
#pragma unroll
  for (int d0 = 0; d0 < 8; ++d0) qr[d0] = *(const GAS bf16x8*)(Qw + d0 * 16);
  const unsigned* mq = mrow + (size_t)tq * 64;
  const int sr = tid >> 4, sc = (tid & 15) * 8, vst0 = v_st(sr, sc), vst1 = v_st(32 + sr, sc);
  const int vb0 = (int)(size_t)V_lds + v_rd_base(lane);
  struct { bf16x8 vs0, vs1, ks0, ks1; } sr_[1];
#define SLOAD(i, k0) do { sr_[i].vs0 = *(const GAS bf16x8*)(&Vh[(size_t)((k0) + sr) * LDKV + sc]); sr_[i].vs1 = *(const GAS bf16x8*)(&Vh[(size_t)((k0) + 32 + sr) * LDKV + sc]); \
    sr_[i].ks0 = *(const GAS bf16x8*)(&Kh[(size_t)((k0) + sr) * LDKK + sc]); sr_[i].ks1 = *(const GAS bf16x8*)(&Kh[(size_t)((k0) + 32 + sr) * LDKK + sc]); } while (0)
#define SWRITE(b, i) do { *(LAS bf16x8*)(V_lds + (b) * SHM_V + vst0) = sr_[i].vs0;          \
    *(LAS bf16x8*)(V_lds + (b) * SHM_V + vst1) = sr_[i].vs1; const int kc = sc * 2;               \
    *(LAS bf16x8*)(K_lds + (b) * SHM_K + KSWZ(sr, kc)) = sr_[i].ks0;                       \
    *(LAS bf16x8*)(K_lds + (b) * SHM_K + KSWZ(32 + sr, kc)) = sr_[i].ks1; } while (0)
#define RESC(a) do { if (__any((a) < 1.f)) { if (hi == 0) al_l[r32] = (a); asm volatile("s_waitcnt lgkmcnt(0)" ::: "memory"); \
    _Pragma("unroll") for (int d = 0; d < 4; ++d) _Pragma("unroll") for (int r = 0; r < 16; ++r) o[d][r] *= al_l[crow(r, hi)]; } } while (0)
#define MASKB(P0, P1, j, BADD) do { const v2u mw_ = *(const GAS v2u*)(mq + 2 * (j)); \
    if ((j) + 3 <= qt) { mask_bias<false>(P0, P1, mw_.x, mw_.y, hi, 0, bt); BADD = bfar; } \
    else { mask_bias<true>(P0, P1, mw_.x, mw_.y, hi, tq - 64 * (j) - 4 * hi, bt); BADD = 0.f; } } while (0)
  f32x16 p0, p1; float mn, al, bd; bf16x8 pa0, pa1, pa2, pa3;
  const int NT = qt + 1;
  SLOAD(0, 0); asm volatile("s_waitcnt vmcnt(0)" ::: "memory"); SWRITE(0, 0); __syncthreads();
#pragma unroll 1
  for (int j = 0; j < NT; ++j) {
    const int bsel = j & 1;
    if (j + 1 < NT) SLOAD(0, (j + 1) * KVBLK);
    SBAR(); qkt(p0, p1, K_lds + bsel * SHM_K, qr, r32, hi);
    MASKB(p0, p1, j, bd); partialSM(p0, p1, bd, m_reg, mn, al);
    RESC(al);
    finishSM(p0, p1, al, l_reg, pa0, pa1, pa2, pa3); SBAR();
    pv_d0(o, vb0 + bsel * (int)SHM_V, pa0, pa1, pa2, pa3);
    if (j + 1 < NT) { asm volatile("s_waitcnt vmcnt(0)" ::: "memory"); SWRITE(bsel ^ 1, 0); }
    __syncthreads();
  }
  if (hi == 0) li_l[r32] = l_reg; asm volatile("s_waitcnt lgkmcnt(0)" ::: "memory");
  float rli[16];
#pragma unroll
  for (int r = 0; r < 16; ++r) rli[r] = __builtin_amdgcn_rcpf(li_l[crow(r, hi)]);
  bf16* Ow = Ob + (size_t)tq0 * 2048 + hq * 128;
#pragma unroll
  for (int r = 0; r < 16; ++r) { const int orow = crow(r, hi);
#pragma unroll
    for (int d0 = 0; d0 < 4; ++d0) Ow[(size_t)orow * 2048 + d0 * 32 + r32] = (bf16)f2bf(o[d0][r] * rli[r]); }
  __syncthreads();
#undef SLOAD
#undef SWRITE
#undef RESC
#undef MASKB
}
#undef KSWZ
#undef SBAR
}
__device__ __forceinline__ void phase_attn2(Frame& F, KA a) {
    const bf16* qn = (const bf16*)(a->ws + WS_QN); const bf16* kn = (const bf16*)(a->ws + WS_KN); const bf16* proj = (const bf16*)(a->ws + WS_PROJ);
    const unsigned* mask = (const unsigned*)(a->ws + WS_MASK); bf16* mix = (bf16*)(a->ws + WS_MIX); const float* relb = a->in[1];
    LAS float* btab = (LAS float*)(F.lds + att::OFF_BIAS);
    for (int i = F.tid; i < 8 * 129; i += NWAVES * 64) { const int h = i / 129, d = i - h * 129; btab[h * 132 + d] = relb[BUCKET[d] * 8 + h]; }
    __syncthreads();
    for (int u = F.bid; u < 256; u += F.G) {
        const int b = u >> 5, kvh = (u >> 4) & 1, ip = u & 15;
#pragma unroll 1
        for (int half = 0; half < 2; ++half) {
            const int qt = half ? ip : 31 - ip;
            att::attn_unit(qn + (size_t)b * T * 1024, kn + (size_t)b * T * 256 + kvh * 128, proj + (size_t)b * T * NPROJ_P + C_V + kvh * 128, mask + (size_t)b * T * 64, mix + (size_t)b * T * 2048,
                           kvh, qt, relb, (LAS char*)F.lds, F.tid);
        }
    }
}

__device__ __forceinline__ void phase_hgrn(Frame& F, KA a, int l) {
    LAS float* qs = (LAS float*)(F.lds); LAS float* fs = (LAS float*)(F.lds + 16384); LAS float* ks = (LAS float*)(F.lds + 32768); LAS float* vs = (LAS float*)(F.lds + 49152); LAS float* ob = (LAS float*)(F.lds + 65536);
    const bf16* proj = (const bf16*)(a->ws + WS_PROJ); bf16* mix = (bf16*)(a->ws + WS_MIX);
    const float* lbl = a->in[11]; const float* gn = a->in[12] + l * 128;
    const int tid = F.tid, j = tid >> 2, dsl = tid & 3, tt_s = tid >> 4, d8 = (tid & 15) * 8;
    for (int unit = F.bid; unit < BATCH * 8; unit += F.G) {
        const int b = unit >> 3, h = unit & 7;
        float lbv[8];
#pragma unroll
        for (int i = 0; i < 8; ++i) lbv[i] = (l == 0) ? 0.f : sigmf(lbl[1024 + h * 128 + d8 + i] - lbl[h * 128 + d8 + i]);
        float S[32];
#pragma unroll
        for (int i = 0; i < 32; ++i) S[i] = 0.f;
#pragma unroll 1
        for (int c = 0; c < T / 32; ++c) {
            {   const bf16* pr = proj + (size_t)(b * T + c * 32 + tt_s) * NPROJ_P + h * 128 + d8;
                const v4u wq = *(const GAS v4u*)(pr + C_HQ), wfv = *(const GAS v4u*)(pr + C_HF), wi = *(const GAS v4u*)(pr + C_HI);
                const float xq[8] = {blo(wq.x), bhi(wq.x), blo(wq.y), bhi(wq.y), blo(wq.z), bhi(wq.z), blo(wq.w), bhi(wq.w)};
                const float xf[8] = {blo(wfv.x), bhi(wfv.x), blo(wfv.y), bhi(wfv.y), blo(wfv.z), bhi(wfv.z), blo(wfv.w), bhi(wfv.w)};
                const float xi[8] = {blo(wi.x), bhi(wi.x), blo(wi.y), bhi(wi.y), blo(wi.z), bhi(wi.z), blo(wi.w), bhi(wi.w)};
                float q[8], f[8], k[8];
#pragma unroll
                for (int i = 0; i < 8; ++i) { q[i] = siluf(xq[i]) * ATT_SCALE; f[i] = lbv[i] + (1.0f - lbv[i]) * sigmf(xf[i]); k[i] = 1.0f - f[i]; }
                const int o = tt_s * 128 + d8;
                *(LAS f32x4*)(qs + o) = (f32x4){q[0], q[1], q[2], q[3]}; *(LAS f32x4*)(qs + o + 4) = (f32x4){q[4], q[5], q[6], q[7]};
                *(LAS f32x4*)(fs + o) = (f32x4){f[0], f[1], f[2], f[3]}; *(LAS f32x4*)(fs + o + 4) = (f32x4){f[4], f[5], f[6], f[7]};
                *(LAS f32x4*)(ks + o) = (f32x4){k[0], k[1], k[2], k[3]}; *(LAS f32x4*)(ks + o + 4) = (f32x4){k[4], k[5], k[6], k[7]};
                *(LAS f32x4*)(vs + o) = (f32x4){xi[0], xi[1], xi[2], xi[3]}; *(LAS f32x4*)(vs + o + 4) = (f32x4){xi[4], xi[5], xi[6], xi[7]};
            }
            __syncthreads();
#pragma unroll 1
            for (int tt = 0; tt < 32; ++tt) {
                const float v = vs[tt * 128 + j]; float o = 0.f;
                const LAS f32x4* f4 = (const LAS f32x4*)(fs + tt * 128 + dsl * 32); const LAS f32x4* k4 = (const LAS f32x4*)(ks + tt * 128 + dsl * 32); const LAS f32x4* q4 = (const LAS f32x4*)(qs + tt * 128 + dsl * 32);
#pragma unroll
                for (int i4 = 0; i4 < 8; ++i4) { const f32x4 ff = f4[i4], kk = k4[i4], qq = q4[i4];
                    S[4 * i4] = ff.x * S[4 * i4] + kk.x * v; o += qq.x * S[4 * i4];
                    S[4 * i4 + 1] = ff.y * S[4 * i4 + 1] + kk.y * v; o += qq.y * S[4 * i4 + 1];
                    S[4 * i4 + 2] = ff.z * S[4 * i4 + 2] + kk.z * v; o += qq.z * S[4 * i4 + 2];
                    S[4 * i4 + 3] = ff.w * S[4 * i4 + 3] + kk.w * v; o += qq.w * S[4 * i4 + 3]; }
                o += swz<1>(o); o += swz<2>(o);
                if (dsl == 0) ob[tt * 128 + j] = o;
            }
            __syncthreads();
            {   const size_t row = (size_t)(b * T + c * 32 + tt_s);
                const f32x4 o0 = *(const LAS f32x4*)(ob + tt_s * 128 + d8), o1 = *(const LAS f32x4*)(ob + tt_s * 128 + d8 + 4);
                float ss = (o0.x * o0.x + o0.y * o0.y) + (o0.z * o0.z + o0.w * o0.w) + (o1.x * o1.x + o1.y * o1.y) + (o1.z * o1.z + o1.w * o1.w);
                ss += swz<1>(ss); ss += swz<2>(ss); ss += swz<4>(ss); ss += swz<8>(ss);
                const float r = 1.0f / sqrtf(ss * (1.0f / 128.0f) + EPS);
                const v4u wg = *(const GAS v4u*)(proj + row * NPROJ_P + C_HG + h * 128 + d8);
                const float xg[8] = {blo(wg.x), bhi(wg.x), blo(wg.y), bhi(wg.y), blo(wg.z), bhi(wg.z), blo(wg.w), bhi(wg.w)};
                const float ov[8] = {o0.x, o0.y, o0.z, o0.w, o1.x, o1.y, o1.z, o1.w};
                unsigned pw[4];
#pragma unroll
                for (int i = 0; i < 4; ++i) pw[i] = pk2(ov[2 * i] * r * gn[d8 + 2 * i] * siluf(xg[2 * i]), ov[2 * i + 1] * r * gn[d8 + 2 * i + 1] * siluf(xg[2 * i + 1]));
                *(GAS v4u*)(mix + row * 2048 + 1024 + h * 128 + d8) = (v4u){pw[0], pw[1], pw[2], pw[3]};
            }
            __syncthreads();
        }
    }
}


namespace hg {
constexpr int LQ = 272, LT = 144;
constexpr int OFF_G = 0, OFF_TOT = 32768, OFF_BV = 34816, OFF_QH0 = 36864, OFF_QH1 = OFF_QH0 + 64 * LQ, OFF_KH = OFF_QH1 + 32 * LQ, OFF_KP = OFF_KH + 64 * LQ, OFF_K2T = OFF_KP + 64 * LQ, OFF_VT = OFF_K2T + 128 * LT, OFF_END = OFF_VT + 128 * LT;
static_assert(OFF_END <= LDSCTL_OFF, "hgrn LDS map");
__device__ __forceinline__ int crow(int r, int hi) { return (r & 3) + 8 * (r >> 2) + 4 * hi; }
__device__ __forceinline__ bf16x8 pack8(const f32x16& x, int s) { v4u w; w.x = pk2(x[8 * s], x[8 * s + 1]); w.y = pk2(x[8 * s + 2], x[8 * s + 3]); w.z = pk2(x[8 * s + 4], x[8 * s + 5]); w.w = pk2(x[8 * s + 6], x[8 * s + 7]); return __builtin_bit_cast(bf16x8, w); }
__device__ __forceinline__ f32x16 xblock(const LAS unsigned char* Kt, const LAS unsigned char* Qt, int r32, int hi) {
    f32x16 x;
#pragma unroll
    for (int i = 0; i < 16; ++i) x[i] = 0.f;
#pragma unroll
    for (int st = 0; st < 8; ++st) { const bf16x8 ka = *(const LAS bf16x8*)(Kt + r32 * LQ + (16 * st + 8 * hi) * 2), qb = *(const LAS bf16x8*)(Qt + r32 * LQ + (16 * st + 8 * hi) * 2);
        x = __builtin_amdgcn_mfma_f32_32x32x16_bf16(ka, qb, x, 0, 0, 0); }
    return x;
}
__device__ __forceinline__ void xtv(f32x16& od, const f32x16& x_, const LAS unsigned char* vt  , int hi) {
    f32x16 x = x_; asm volatile("s_nop 15\n\ts_nop 3" : "+v"(x));
#pragma unroll
    for (int st = 0; st < 2; ++st) { const v2u lo = *(const LAS v2u*)(vt + (16 * st + 4 * hi) * 2), hi2 = *(const LAS v2u*)(vt + (16 * st + 8 + 4 * hi) * 2);
        const v4u w = {lo.x, lo.y, hi2.x, hi2.y};
        od = __builtin_amdgcn_mfma_f32_32x32x16_bf16(pack8(x, st), __builtin_bit_cast(bf16x8, w), od, 0, 0, 0); }
}
}
__device__ __forceinline__ void phase_hgrn1(Frame& F, KA a, int l) {
    using namespace hg;
    LAS unsigned char* L = F.lds; LAS float* G = (LAS float*)(L + OFF_G); LAS float* TOT = (LAS float*)(L + OFF_TOT); LAS float* BV = (LAS float*)(L + OFF_BV);
    const bf16* proj = (const bf16*)(a->ws + WS_PROJ);
    float* OI = (float*)(a->ws + WS_HOI); bf16* UT = (bf16*)(a->ws + WS_HUT); bf16* QH = (bf16*)(a->ws + WS_HQH); float* DEC = (float*)(a->ws + WS_HDEC);
    const float* lbl = a->in[11];
    const int tid = F.tid, lane = F.lane, r32 = lane & 31, hi = lane >> 5, wave = F.wave;
    for (int u = F.bid; u < BATCH * 8 * 32; u += F.G) {
        const int c = u & 31, h = (u >> 5) & 7, b = u >> 8; const size_t row0 = (size_t)b * T + 64 * c;
        float qv[2][8], kv[2][8];
#pragma unroll
        for (int k = 0; k < 2; ++k) { const int slot = tid + 512 * k, t = slot >> 4, d8 = (slot & 15) * 8;
            const bf16* pr = proj + (row0 + t) * NPROJ_P + h * 128 + d8;
            const v4u wq = *(const GAS v4u*)(pr + C_HQ), wf = *(const GAS v4u*)(pr + C_HF), wi = *(const GAS v4u*)(pr + C_HI);
            const float xq[8] = {blo(wq.x), bhi(wq.x), blo(wq.y), bhi(wq.y), blo(wq.z), bhi(wq.z), blo(wq.w), bhi(wq.w)};
            const float xf[8] = {blo(wf.x), bhi(wf.x), blo(wf.y), bhi(wf.y), blo(wf.z), bhi(wf.z), blo(wf.w), bhi(wf.w)};
            float g[8];
#pragma unroll
            for (int i = 0; i < 8; ++i) { const float lb = (l == 0) ? 0.f : sigmf(lbl[1024 + h * 128 + d8 + i] - lbl[h * 128 + d8 + i]);
                const float f = lb + (1.0f - lb) * sigmf(xf[i]); qv[k][i] = siluf(xq[i]) * ATT_SCALE; kv[k][i] = 1.0f - f; g[i] = __logf(f); }
            *(LAS f32x4*)(G + t * 128 + d8) = (f32x4){g[0], g[1], g[2], g[3]}; *(LAS f32x4*)(G + t * 128 + d8 + 4) = (f32x4){g[4], g[5], g[6], g[7]};
            const unsigned vw[4] = {wi.x, wi.y, wi.z, wi.w};
#pragma unroll
            for (int i = 0; i < 8; ++i) *(LAS bf16*)(L + OFF_VT + (d8 + i) * LT + t * 2) = (bf16)((i & 1) ? (vw[i >> 1] >> 16) : (vw[i >> 1] & 0xffffu));
        }
        __syncthreads();
        { const int d = tid & 127, sb = tid >> 7; float run = 0.f;
#pragma unroll
            for (int i = 0; i < 16; ++i) { run += G[(16 * sb + i) * 128 + d]; G[(16 * sb + i) * 128 + d] = run; }
            TOT[sb * 128 + d] = run;
            __syncthreads();
            float off = 0.f;
#pragma unroll
            for (int q = 0; q < 3; ++q) off += (q < sb) ? TOT[q * 128 + d] : 0.f;
#pragma unroll
            for (int i = 0; i < 16; ++i) G[(16 * sb + i) * 128 + d] += off;
            if (sb == 0) { const float b1 = TOT[d] + TOT[128 + d], bl = b1 + TOT[256 + d] + TOT[384 + d]; BV[d] = b1; BV[128 + d] = bl;
                DEC[(size_t)u * 128 + d] = __expf(bl); }
        }
        __syncthreads();
#pragma unroll
        for (int k = 0; k < 2; ++k) { const int slot = tid + 512 * k, t = slot >> 4, d8 = (slot & 15) * 8; const int J = t >> 5;
            const f32x4 ba = *(const LAS f32x4*)(G + t * 128 + d8), bb = *(const LAS f32x4*)(G + t * 128 + d8 + 4);
            const f32x4 b1a = *(const LAS f32x4*)(BV + d8), b1b = *(const LAS f32x4*)(BV + d8 + 4), bla = *(const LAS f32x4*)(BV + 128 + d8), blb = *(const LAS f32x4*)(BV + 128 + d8 + 4);
            const float bt[8] = {ba.x, ba.y, ba.z, ba.w, bb.x, bb.y, bb.z, bb.w}, b1[8] = {b1a.x, b1a.y, b1a.z, b1a.w, b1b.x, b1b.y, b1b.z, b1b.w}, bl[8] = {bla.x, bla.y, bla.z, bla.w, blb.x, blb.y, blb.z, blb.w};
            float q0[8], q1[8], kh[8], kp[8], k2[8];
#pragma unroll
            for (int i = 0; i < 8; ++i) { const float bj = J ? b1[i] : 0.f, bj1 = J ? bl[i] : b1[i];
                q0[i] = qv[k][i] * __expf(bt[i]); q1[i] = qv[k][i] * __expf(bt[i] - b1[i]);
                kh[i] = kv[k][i] * __expf(bj1 - bt[i]); kp[i] = kv[k][i] * __expf(fminf(bj - bt[i], 80.f)); k2[i] = kv[k][i] * __expf(bl[i] - bt[i]); }
            const v4u w0 = {pk2(q0[0], q0[1]), pk2(q0[2], q0[3]), pk2(q0[4], q0[5]), pk2(q0[6], q0[7])};
            *(LAS v4u*)(L + OFF_QH0 + t * LQ + d8 * 2) = w0; *(GAS v4u*)(QH + (row0 + t) * 1024 + h * 128 + d8) = w0;
            if (J) *(LAS v4u*)(L + OFF_QH1 + (t - 32) * LQ + d8 * 2) = (v4u){pk2(q1[0], q1[1]), pk2(q1[2], q1[3]), pk2(q1[4], q1[5]), pk2(q1[6], q1[7])};
            *(LAS v4u*)(L + OFF_KH + t * LQ + d8 * 2) = (v4u){pk2(kh[0], kh[1]), pk2(kh[2], kh[3]), pk2(kh[4], kh[5]), pk2(kh[6], kh[7])};
            *(LAS v4u*)(L + OFF_KP + t * LQ + d8 * 2) = (v4u){pk2(kp[0], kp[1]), pk2(kp[2], kp[3]), pk2(kp[4], kp[5]), pk2(kp[6], kp[7])};
#pragma unroll
            for (int i = 0; i < 8; ++i) *(LAS bf16*)(L + OFF_K2T + (d8 + i) * LT + t * 2) = (bf16)f2bf(k2[i]);
        }
        __syncthreads();
        { const int I = wave >> 2, dvb = wave & 3;
            f32x16 od;
#pragma unroll
            for (int i = 0; i < 16; ++i) od[i] = 0.f;
            const LAS unsigned char* vrow = L + OFF_VT + (32 * dvb + r32) * LT;
            if (I == 0) {
                f32x16 x = xblock(L + OFF_KP, L + OFF_QH0, r32, hi);
#pragma unroll
                for (int i = 0; i < 16; ++i) x[i] = (crow(i, hi) <= r32) ? x[i] : 0.f;
                xtv(od, x, vrow, hi);
            } else {
                f32x16 x = xblock(L + OFF_KH, L + OFF_QH1, r32, hi);
                xtv(od, x, vrow, hi);
                x = xblock(L + OFF_KP + 32 * LQ, L + OFF_QH1, r32, hi);
#pragma unroll
                for (int i = 0; i < 16; ++i) x[i] = (crow(i, hi) <= r32) ? x[i] : 0.f;
                xtv(od, x, vrow + 64, hi);
            }
            float* op = OI + (row0 + 32 * I) * 1024 + h * 128 + 32 * dvb + r32;
#pragma unroll
            for (int i = 0; i < 16; ++i) op[(size_t)crow(i, hi) * 1024] = od[i];
#pragma unroll
            for (int e = 0; e < 2; ++e) { const int dvb2 = wave >> 1, dkb = 2 * (wave & 1) + e;
                f32x16 uacc;
#pragma unroll
                for (int i = 0; i < 16; ++i) uacc[i] = 0.f;
#pragma unroll
                for (int st = 0; st < 4; ++st) { const bf16x8 va = *(const LAS bf16x8*)(L + OFF_VT + (32 * dvb2 + r32) * LT + (16 * st + 8 * hi) * 2), kb = *(const LAS bf16x8*)(L + OFF_K2T + (32 * dkb + r32) * LT + (16 * st + 8 * hi) * 2);
                    uacc = __builtin_amdgcn_mfma_f32_32x32x16_bf16(va, kb, uacc, 0, 0, 0); }
                bf16* up = UT + (size_t)u * 16384 + (size_t)(32 * dvb2) * 128 + 32 * dkb + r32;
#pragma unroll
                for (int i = 0; i < 16; ++i) up[crow(i, hi) * 128] = (bf16)f2bf(uacc[i]);
            }
        }
        __syncthreads();
    }
}
__device__ __forceinline__ void phase_hgrn2(Frame& F, KA a, int l) {
    LAS unsigned char* L = F.lds; constexpr int LS = 272; LAS float* OB = (LAS float*)(L + 36864); LAS float* DECS = (LAS float*)(L + 69632); LAS unsigned char* QS = L + 70656;
    const bf16* proj = (const bf16*)(a->ws + WS_PROJ); bf16* mix = (bf16*)(a->ws + WS_MIX);
    const float* OI = (const float*)(a->ws + WS_HOI); const bf16* UT = (const bf16*)(a->ws + WS_HUT); const bf16* QH = (const bf16*)(a->ws + WS_HQH); const float* DEC = (const float*)(a->ws + WS_HDEC);
    const float* gn = a->in[12] + l * 128;
    const int tid = F.tid, lane = F.lane, r32 = lane & 31, hi = lane >> 5, wave = F.wave;
    const int dv = tid >> 2, dkq = tid & 3, I = wave >> 2, dvb = wave & 3, tn = tid >> 3, d16 = (tid & 7) * 16;
    for (int u = F.bid; u < BATCH * 8; u += F.G) {
        const int b = u >> 3, h = u & 7;
        float S[32];
#pragma unroll
        for (int i = 0; i < 32; ++i) S[i] = 0.f;
#pragma unroll
        for (int i = 0; i < 4; ++i) *(LAS v4u*)(L + dv * LS + (32 * dkq + 8 * i) * 2) = (v4u){0u, 0u, 0u, 0u};
        v4u qn0, qn1, g0, g1, uw[4]; f32x4 oi[4]; float dn = 0.f;
#define H2_ROWQ(c) (QH + ((size_t)b * T + 64 * (c) + tn) * 1024 + h * 128 + d16)
#define H2_LDQ(c) do { qn0 = *(const GAS v4u*)(H2_ROWQ(c)); qn1 = *(const GAS v4u*)(H2_ROWQ(c) + 8); if (tid < 128) dn = DEC[((size_t)u * 32 + (c)) * 128 + tid]; } while (0)
#define H2_STQ(c) do { *(LAS v4u*)(QS + ((c) & 1) * (64 * LS) + tn * LS + d16 * 2) = qn0; *(LAS v4u*)(QS + ((c) & 1) * (64 * LS) + tn * LS + d16 * 2 + 16) = qn1; if (tid < 128) DECS[((c) & 1) * 128 + tid] = dn; } while (0)
#define H2_LDN(c) do { const size_t row_ = (size_t)b * T + 64 * (c) + tn; \
            _Pragma("unroll") for (int i = 0; i < 4; ++i) oi[i] = *(const GAS f32x4*)(OI + row_ * 1024 + h * 128 + d16 + 4 * i); \
            g0 = *(const GAS v4u*)(proj + row_ * NPROJ_P + C_HG + h * 128 + d16); g1 = *(const GAS v4u*)(proj + row_ * NPROJ_P + C_HG + h * 128 + d16 + 8); } while (0)
#define H2_LDU(c) do { _Pragma("unroll") for (int i = 0; i < 4; ++i) uw[i] = *(const GAS v4u*)(UT + ((size_t)u * 32 + (c)) * 16384 + (size_t)dv * 128 + 32 * dkq + 8 * i); } while (0)
        H2_LDQ(0); H2_LDN(0); H2_LDU(0); H2_STQ(0);
#pragma unroll 1
        for (int c = 0; c < 32; ++c) {
            const size_t row0 = (size_t)b * T + 64 * c;
            if (c + 1 < 32) H2_LDQ(c + 1);
            __syncthreads();
            f32x16 acc;
#pragma unroll
            for (int i = 0; i < 16; ++i) acc[i] = 0.f;
            const LAS unsigned char* qs = QS + (c & 1) * (64 * LS) + (32 * I + r32) * LS + 16 * hi;
#pragma unroll
            for (int st = 0; st < 8; ++st) { const bf16x8 qa = *(const LAS bf16x8*)(qs + 32 * st), sb = *(const LAS bf16x8*)(L + (32 * dvb + r32) * LS + (16 * st + 8 * hi) * 2);
                acc = __builtin_amdgcn_mfma_f32_32x32x16_bf16(qa, sb, acc, 0, 0, 0); }
#pragma unroll
            for (int i = 0; i < 16; ++i) OB[(32 * I + hg::crow(i, hi)) * 128 + 32 * dvb + r32] = acc[i];
            __syncthreads();
            {
                const size_t row = row0 + tn; float ov[16]; float ss = 0.f;
#pragma unroll
                for (int i = 0; i < 4; ++i) { const f32x4 o4 = *(const LAS f32x4*)(OB + tn * 128 + d16 + 4 * i) + oi[i]; ov[4 * i] = o4.x; ov[4 * i + 1] = o4.y; ov[4 * i + 2] = o4.z; ov[4 * i + 3] = o4.w; ss += (o4.x * o4.x + o4.y * o4.y) + (o4.z * o4.z + o4.w * o4.w); }
                ss += swz<1>(ss); ss += swz<2>(ss); ss += swz<4>(ss);
                const float r = __builtin_amdgcn_rsqf(ss * (1.0f / 128.0f) + EPS);
                const float xg[16] = {blo(g0.x), bhi(g0.x), blo(g0.y), bhi(g0.y), blo(g0.z), bhi(g0.z), blo(g0.w), bhi(g0.w), blo(g1.x), bhi(g1.x), blo(g1.y), bhi(g1.y), blo(g1.z), bhi(g1.z), blo(g1.w), bhi(g1.w)};
                unsigned pw[8];
#pragma unroll
                for (int i = 0; i < 8; ++i) pw[i] = pk2(ov[2 * i] * r * gn[d16 + 2 * i] * siluf(xg[2 * i]), ov[2 * i + 1] * r * gn[d16 + 2 * i + 1] * siluf(xg[2 * i + 1]));
                *(GAS v4u*)(mix + row * 2048 + 1024 + h * 128 + d16) = (v4u){pw[0], pw[1], pw[2], pw[3]}; *(GAS v4u*)(mix + row * 2048 + 1024 + h * 128 + d16 + 8) = (v4u){pw[4], pw[5], pw[6], pw[7]};
            }
            if (c + 1 < 32) H2_LDN(c + 1);
            {
                const LAS float* dcs = DECS + (c & 1) * 128 + 32 * dkq;
#pragma unroll
                for (int i = 0; i < 4; ++i) { const unsigned ww[4] = {uw[i].x, uw[i].y, uw[i].z, uw[i].w};
                    const f32x4 d0 = *(const LAS f32x4*)(dcs + 8 * i), d1 = *(const LAS f32x4*)(dcs + 8 * i + 4); const float dcf[8] = {d0.x, d0.y, d0.z, d0.w, d1.x, d1.y, d1.z, d1.w};
#pragma unroll
                    for (int q = 0; q < 4; ++q) { S[8 * i + 2 * q] = dcf[2 * q] * S[8 * i + 2 * q] + blo(ww[q]); S[8 * i + 2 * q + 1] = dcf[2 * q + 1] * S[8 * i + 2 * q + 1] + bhi(ww[q]); }
                    *(LAS v4u*)(L + dv * LS + (32 * dkq + 8 * i) * 2) = (v4u){pk2(S[8 * i], S[8 * i + 1]), pk2(S[8 * i + 2], S[8 * i + 3]), pk2(S[8 * i + 4], S[8 * i + 5]), pk2(S[8 * i + 6], S[8 * i + 7])}; }
            }
            if (c + 1 < 32) { H2_LDU(c + 1); H2_STQ(c + 1); }
        }
#undef H2_ROWQ
#undef H2_LDQ
#undef H2_STQ
#undef H2_LDN
#undef H2_LDU
        __syncthreads();
    }
}

__device__ __forceinline__ void phase_norm_router(Frame& F, KA a, const float* src, bf16* dst) {
    LAS int* lcnt = (LAS int*)(F.lds); LAS int* lbase = (LAS int*)(F.lds + 64); LAS int* stash = (LAS int*)(F.lds + 128);
    float* rstd2 = (float*)(a->ws + WS_TAB + TAB_RSTD2); int* toke = (int*)(a->ws + WS_TAB + TAB_TOKE); int* tokpos = (int*)(a->ws + WS_TAB + TAB_TOKPOS); float* tokp = (float*)(a->ws + WS_TAB + TAB_TOKP);
    unsigned* gcnt = (unsigned*)(a->ws + WS_CTL) + CW_ECNT;
    const float* gain = a->in[3] + 2048; const float* wr = a->in[19];
    const int lane = F.lane;
    for (int chunk = F.bid; chunk < M / 64; chunk += F.G) {
        if (F.tid < 8) lcnt[F.tid] = 0;
        __syncthreads();
#pragma unroll 1
        for (int rr = 0; rr < 8; ++rr) {
            const int lrow = F.wave * 8 + rr; const size_t row = (size_t)chunk * 64 + lrow;
            const GAS f32x4* xr = (const GAS f32x4*)(src + row * D) + lane;
            f32x4 v[8]; float s = 0.f;
#pragma unroll
            for (int jj = 0; jj < 8; ++jj) { v[jj] = xr[64 * jj]; s += (v[jj].x * v[jj].x + v[jj].y * v[jj].y) + (v[jj].z * v[jj].z + v[jj].w * v[jj].w); }
            s = wave_sum(s); const float r = 1.0f / sqrtf(s * (1.0f / D) + EPS);
            GAS v2u* o8 = (GAS v2u*)(dst + row * D) + lane;
            float lg[8] = {0.f, 0.f, 0.f, 0.f, 0.f, 0.f, 0.f, 0.f};
#pragma unroll
            for (int jj = 0; jj < 8; ++jj) { v2u w; w.x = pk2(v[jj].x, v[jj].y); w.y = pk2(v[jj].z, v[jj].w); o8[64 * jj] = w;
                const int d0 = 4 * lane + 256 * jj; const f32x4 g4 = *(const GAS f32x4*)(gain + d0);
                const float xg[4] = {v[jj].x * g4.x, v[jj].y * g4.y, v[jj].z * g4.z, v[jj].w * g4.w};
#pragma unroll
                for (int q = 0; q < 4; ++q) { const f32x4 wa = *(const GAS f32x4*)(wr + (size_t)(d0 + q) * 8), wb = *(const GAS f32x4*)(wr + (size_t)(d0 + q) * 8 + 4);
                    lg[0] += xg[q] * wa.x; lg[1] += xg[q] * wa.y; lg[2] += xg[q] * wa.z; lg[3] += xg[q] * wa.w; lg[4] += xg[q] * wb.x; lg[5] += xg[q] * wb.y; lg[6] += xg[q] * wb.z; lg[7] += xg[q] * wb.w; } }
#pragma unroll
            for (int e = 0; e < 8; ++e) lg[e] = wave_sum(lg[e]) * r;
            int e0 = 0; float v0 = lg[0];
#pragma unroll
            for (int e = 1; e < 8; ++e) if (lg[e] > v0) { v0 = lg[e]; e0 = e; }
            int e1 = -1; float v1 = -INFINITY;
#pragma unroll
            for (int e = 0; e < 8; ++e) if (e != e0 && lg[e] > v1) { v1 = lg[e]; e1 = e; }
            const float p0 = 1.0f / (1.0f + __expf(v1 - v0)), p1 = 1.0f - p0;
            if (lane == 0) { rstd2[row] = r; const int lp0 = atomicAdd((int*)lcnt + e0, 1), lp1 = atomicAdd((int*)lcnt + e1, 1);
                stash[lrow * 4] = e0; stash[lrow * 4 + 1] = e1; stash[lrow * 4 + 2] = lp0; stash[lrow * 4 + 3] = lp1; tokp[row * 2] = p0; tokp[row * 2 + 1] = p1; }
        }
        __syncthreads();
        if (F.tid < 8) lbase[F.tid] = (int)__hip_atomic_fetch_add(gcnt + F.tid, (unsigned)lcnt[F.tid], __ATOMIC_RELAXED, __HIP_MEMORY_SCOPE_AGENT);
        __syncthreads();
        if (F.tid < 64) { const size_t row = (size_t)chunk * 64 + F.tid; const int e0 = stash[F.tid * 4], e1 = stash[F.tid * 4 + 1];
            toke[row * 2] = e0; toke[row * 2 + 1] = e1; tokpos[row * 2] = lbase[e0] + stash[F.tid * 4 + 2]; tokpos[row * 2 + 1] = lbase[e1] + stash[F.tid * 4 + 3]; }
        __syncthreads();
    }
}
struct ExpTab { int t[9]; };
__device__ __forceinline__ void load_exptab(KA a, int (&off)[9]) {
    const unsigned* gcnt = (const unsigned*)(a->ws + WS_CTL) + CW_ECNT;
    off[0] = 0;
#pragma unroll
    for (int e = 0; e < 8; ++e) { const unsigned c = __hip_atomic_load(gcnt + e, __ATOMIC_RELAXED, __HIP_MEMORY_SCOPE_AGENT); off[e + 1] = off[e] + (int)((c + 255u) >> 8); }
}
__device__ __forceinline__ void phase_gather(Frame& F, KA a) {
    int off[9]; load_exptab(a, off);
    const bf16* hb = (const bf16*)(a->ws + WS_HB); bf16* hs = (bf16*)(a->ws + WS_HSX);
    const float* rstd2 = (const float*)(a->ws + WS_TAB + TAB_RSTD2); float* rstds = (float*)(a->ws + WS_TAB + TAB_RSTDS);
    const int* toke = (const int*)(a->ws + WS_TAB + TAB_TOKE); const int* tokpos = (const int*)(a->ws + WS_TAB + TAB_TOKPOS); int* tokdest = (int*)(a->ws + WS_TAB + TAB_TOKDEST);
    const int gw = F.bid * NWAVES + F.wave, NGW = F.G * NWAVES;
    for (int pair = gw; pair < 2 * M; pair += NGW) {
        const int tok = pair >> 1; const int e = toke[pair], pos = tokpos[pair];
        int o = off[0];
#pragma unroll
        for (int q = 1; q < 8; ++q) o = (e == q) ? off[q] : o;
        const int dest = o * 256 + pos;
        const GAS v4u* s = (const GAS v4u*)(hb + (size_t)tok * D) + F.lane; GAS v2u* dd = (GAS v2u*)((unsigned char*)hs + (size_t)dest * D) + F.lane;
#pragma unroll
        for (int jj = 0; jj < 4; ++jj) { const v4u w = s[64 * jj]; unsigned w0 = 0u, w1 = 0u;
            w0 = __builtin_amdgcn_cvt_pk_fp8_f32(blo(w.x), bhi(w.x), w0, false); w0 = __builtin_amdgcn_cvt_pk_fp8_f32(blo(w.y), bhi(w.y), w0, true);
            w1 = __builtin_amdgcn_cvt_pk_fp8_f32(blo(w.z), bhi(w.z), w1, false); w1 = __builtin_amdgcn_cvt_pk_fp8_f32(blo(w.w), bhi(w.w), w1, true);
            dd[64 * jj] = (v2u){w0, w1}; }
        if (F.lane == 0) { rstds[dest] = rstd2[tok]; tokdest[pair] = dest; }
    }
}
__device__ __forceinline__ void phase_combine(Frame& F, KA a) {
    const float* y = (const float*)(a->ws + WS_Y); const int* tokdest = (const int*)(a->ws + WS_TAB + TAB_TOKDEST); const float* tokp = (const float*)(a->ws + WS_TAB + TAB_TOKP);
    const int* toke = (const int*)(a->ws + WS_TAB + TAB_TOKE); const float* slab = (const float*)(a->ws + WS_SLAB);
    int off[9]; load_exptab(a, off);
    const int Ltot = off[8] * (D / 256); int Lreg, KS; md_split(Ltot, F.G, Lreg, KS);
    const int gw = F.bid * NWAVES + F.wave, NGW = F.G * NWAVES;
    for (int row = gw; row < M; row += NGW) {
        const int d0 = tokdest[2 * row], d1 = tokdest[2 * row + 1]; const float p0 = tokp[2 * row], p1 = tokp[2 * row + 1];
        const int e0 = toke[2 * row], e1 = toke[2 * row + 1];
        int ts0 = 0, te0 = 0, ts1 = 0, te1 = 0;
#pragma unroll
        for (int e = 0; e < 8; ++e) { if (e == e0) { ts0 = off[e]; te0 = off[e + 1]; } if (e == e1) { ts1 = off[e]; te1 = off[e + 1]; } }
        GAS f32x4* o = (GAS f32x4*)(a->out + (size_t)row * D) + F.lane; const GAS f32x4* y0 = (const GAS f32x4*)(y + (size_t)d0 * D) + F.lane; const GAS f32x4* y1 = (const GAS f32x4*)(y + (size_t)d1 * D) + F.lane;
#pragma unroll
        for (int jj = 0; jj < 8; ++jj) {
            const int L0 = ts0 * 8 + jj * (te0 - ts0) + ((d0 >> 8) - ts0), L1 = ts1 * 8 + jj * (te1 - ts1) + ((d1 >> 8) - ts1);
            f32x4 v0, v1;
            if (L0 >= Lreg) { const GAS f32x4* sp = (const GAS f32x4*)(slab + ((size_t)(L0 - Lreg) * KS * 256 + (d0 & 255)) * 256) + F.lane; v0 = sp[0];
                for (int q = 1; q < KS; ++q) v0 += sp[(size_t)q * (65536 / 4)]; } else v0 = y0[64 * jj];
            if (L1 >= Lreg) { const GAS f32x4* sp = (const GAS f32x4*)(slab + ((size_t)(L1 - Lreg) * KS * 256 + (d1 & 255)) * 256) + F.lane; v1 = sp[0];
                for (int q = 1; q < KS; ++q) v1 += sp[(size_t)q * (65536 / 4)]; } else v1 = y1[64 * jj];
            o[64 * jj] = o[64 * jj] + v0 * p0 + v1 * p1; }
    }
}

#ifndef MK_ONE_LAUNCH
#define MK_ONE_LAUNCH 1
#endif
constexpr int PH_PER_LAYER = 16, NPHASE = 2 * PH_PER_LAYER;
constexpr int CONV_GG = 128;
__global__ void __launch_bounds__(NWAVES * 64, 2) mk_fwd(Args args) {
    extern __shared__ __attribute__((aligned(16))) unsigned char lds[];
    LAS unsigned char* const ldsb = (LAS unsigned char*)lds;
    const int wave_s = __builtin_amdgcn_readfirstlane(threadIdx.x >> 6);
    for (int u = threadIdx.x; u < (LDS_BYTES - LDSCTL_OFF) / 4; u += NWAVES * 64) ((LAS unsigned*)(ldsb + LDSCTL_OFF))[u] = 0u;
    __syncthreads();
    XcdBarrier bar; bar.bar = nullptr; bar.x = 0; bar.st = nullptr;
    if (MK_ONE_LAUNCH) { KA a = ka_get(); bar = xcd_barrier_post((unsigned*)(a->ws + WS_CTL) + CW_BAR, (volatile LAS unsigned*)(ldsb + MISC_OFF) + 8); }
    const int lo = args.ph_lo, hi = args.ph_hi;
#define IN(k) in_range((k), lo, hi)
#define SEAM(k) do { if (MK_ONE_LAUNCH && IN(k) && IN((k) + 1)) { XcdBarrier b2_ = bar; asm volatile("" : "+s"(b2_.bar)); xcd_barrier(b2_); } } while (0)
#pragma unroll 1
    for (int l = 0; l < 2; ++l) {
        const int pb = l * PH_PER_LAYER;
        if (IN(pb + 0)) { KA a = ka_get(); Frame F = make_frame(ldsb, wave_s); unsigned char* ws = a->ws; if (l == 0) phase_conv(F, a, 0, F.G == 256 ? 1 : 16, F.bid, F.G);
            phase_norm_t<true>(F, (l == 0) ? a->in[0] : (const float*)(ws + WS_H), (bf16*)(ws + WS_XB), (float*)(ws + WS_RSTD1)); }
        SEAM(pb + 0);
        if (IN(pb + 1)) { KA a = ka_get(); Frame F = make_frame(ldsb, wave_s); unsigned char* ws = a->ws;
            const bool split = (l == 0 && F.G == 256);
            const int Gv = split ? CONV_GG : F.G;
            if (F.bid < Gv) {
                pg8::Gemm g{(const bf16*)(ws + WS_XB), (const bf16*)(ws + WS_WIN + l * WIN_SZ), M, NPROJ_P, D / 2, D / 2, F.tid, 0x7f7f7f7f, 0x79797979};     pg8::StaticOrder S; S.init(M, F.G == 256 ? NPROJ_P - 256 : NPROJ_P, Gv, F.bid);
                pg8::EpiScaleBf16 E{(bf16*)(ws + WS_PROJ), NPROJ_P, (const float*)(ws + WS_RSTD1)};
                pg8::gemm_phase<pg8::EpiScaleBf16, pg8::StaticOrder, true, true, true>(F.lds + RING_OFF, g, S, E);
            } else phase_conv(F, a, 1, 16, F.bid - CONV_GG, F.G - CONV_GG);
        }
        SEAM(pb + 1);
        if (IN(pb + 2)) { KA a = ka_get(); Frame F = make_frame(ldsb, wave_s); phase_post(F, a, l); }
        SEAM(pb + 2);
        if (IN(pb + 3)) { KA a = ka_get(); Frame F = make_frame(ldsb, wave_s); unsigned char* ws = a->ws;
            pg8::Gemm g{(const bf16*)(ws + WS_PROJ) + C_CQ, (const bf16*)(ws + WS_WIDX + l * WIDX_SZ), M, 1024, 512, NPROJ_P, F.tid, 0, 0}; pg8::StaticOrder S; S.init(M, 1024, F.G, F.bid);
            pg8::EpiScaleBf16 E{(bf16*)(ws + WS_QIDX), 1024, (const float*)(ws + WS_RSTDCQ)};
            pg8::gemm_phase<pg8::EpiScaleBf16, pg8::StaticOrder, true, true>(F.lds + RING_OFF, g, S, E);
        }
        SEAM(pb + 3);
        if (IN(pb + 4)) { KA a = ka_get(); Frame F = make_frame(ldsb, wave_s); phase_index2(F, a); }
        SEAM(pb + 4);
        if (IN(pb + 5)) { KA a = ka_get(); Frame F = make_frame(ldsb, wave_s); phase_attn2(F, a); }
        SEAM(pb + 5);
        if (IN(pb + 6)) { KA a = ka_get(); Frame F = make_frame(ldsb, wave_s); phase_hgrn1(F, a, l); }
        SEAM(pb + 6);
        if (IN(pb + 7)) { KA a = ka_get(); Frame F = make_frame(ldsb, wave_s); unsigned char* ws = a->ws;
            const bool split = F.G >= 128;
            if (!split || F.bid < 64) phase_hgrn2(F, a, l);
            if (!split || F.bid >= 64) {
                pg8::Gemm g{(const bf16*)(ws + WS_MIX), (const bf16*)(ws + WS_WUA + l * WU_SZ), M, D, 1024, D, F.tid, 0, 0}; pg8::StaticOrder S; S.init(M, D, split ? F.G - 64 : F.G, split ? F.bid - 64 : F.bid);
                pg8::EpiGate<0> E{(float*)(ws + WS_TMP), nullptr, D, (const bf16*)(ws + WS_PROJ) + C_GA, NPROJ_P};
                pg8::gemm_phase<pg8::EpiGate<0>, pg8::StaticOrder, true, true>(F.lds + RING_OFF, g, S, E);
            }
            if (F.G == 256 && F.bid >= 192) {
                pg8::Gemm g{(const bf16*)(ws + WS_XB), (const bf16*)(ws + WS_WIN + l * WIN_SZ), M, NPROJ_P, D / 2, D / 2, F.tid, 0x7f7f7f7f, 0x79797979};     pg8::OneUnit S{F.bid - 192, NPROJ_P / 256 - 1, true};
                pg8::EpiScaleBf16 E{(bf16*)(ws + WS_PROJ), NPROJ_P, (const float*)(ws + WS_RSTD1)};
                pg8::gemm_phase<pg8::EpiScaleBf16, pg8::OneUnit, true, true, true>(F.lds + RING_OFF, g, S, E);
            }
        }
        SEAM(pb + 7);
        if (IN(pb + 9)) { KA a = ka_get(); Frame F = make_frame(ldsb, wave_s); unsigned char* ws = a->ws;
            pg8::Gemm g{(const bf16*)(ws + WS_MIX) + 1024, (const bf16*)(ws + WS_WUH + l * WU_SZ), M, D, 1024, D, F.tid, 0, 0}; pg8::StaticOrder S; S.init(M, D, F.G, F.bid);
            pg8::EpiGate<1> E{(float*)(ws + WS_TMP), (bf16*)(ws + WS_MRG), D, (const bf16*)(ws + WS_PROJ) + C_GH, NPROJ_P};
            pg8::gemm_phase<pg8::EpiGate<1>, pg8::StaticOrder, true, true>(F.lds + RING_OFF, g, S, E);
        }
        SEAM(pb + 9);
        if (IN(pb + 10)) { KA a = ka_get(); Frame F = make_frame(ldsb, wave_s); unsigned char* ws = a->ws;
            pg8::Gemm g{(const bf16*)(ws + WS_MRG), (const bf16*)(ws + WS_WO + l * WO_SZ), M, D, D, D, F.tid, 0, 0}; pg8::StaticOrder S; S.init(M, D, F.G, F.bid);
            pg8::EpiResF32 E{(l == 0) ? a->in[0] : (const float*)(ws + WS_H), (l == 0) ? (float*)(ws + WS_H) : a->out, D, 1 << 20};
            pg8::gemm_phase<pg8::EpiResF32, pg8::StaticOrder, true, true>(F.lds + RING_OFF, g, S, E);
        }
        SEAM(pb + 10);
        if (IN(pb + 11)) { KA a = ka_get(); Frame F = make_frame(ldsb, wave_s); unsigned char* ws = a->ws;
            if (l == 0) phase_norm_t<false>(F, (const float*)(ws + WS_H), (bf16*)(ws + WS_HB), (float*)(ws + WS_TAB + TAB_RSTD2)); else phase_norm_router(F, a, a->out, (bf16*)(ws + WS_HB)); }
        SEAM(pb + 11);
        if (l == 0) {
            if (IN(pb + 12)) { KA a = ka_get(); Frame F = make_frame(ldsb, wave_s); unsigned char* ws = a->ws;
                pg8::Gemm g{(const bf16*)(ws + WS_HB), (const bf16*)(ws + WS_W13D), M, 2 * FFD, D, D, F.tid, 0, 0}; pg8::StaticOrder S; S.init(M, 2 * FFD, F.G, F.bid);
                pg8::EpiSwiGLU E{(bf16*)(ws + WS_PROJ), FFD, 1 << 20, (const float*)(ws + WS_TAB + TAB_RSTD2)};
                pg8::gemm_phase<pg8::EpiSwiGLU, pg8::StaticOrder, true, true>(F.lds + RING_OFF, g, S, E);
            }
            SEAM(pb + 12);
            if (IN(pb + 13)) { KA a = ka_get(); Frame F = make_frame(ldsb, wave_s); unsigned char* ws = a->ws;
                pg8::Gemm g{(const bf16*)(ws + WS_PROJ), (const bf16*)(ws + WS_W2D), M, D, FFD, FFD, F.tid, 0, 0}; pg8::StaticOrder S; S.init(M, D, F.G, F.bid);
                pg8::EpiResF32 E{(const float*)(ws + WS_H), (float*)(ws + WS_H), D, 1 << 20};
                pg8::gemm_phase<pg8::EpiResF32, pg8::StaticOrder, true, true>(F.lds + RING_OFF, g, S, E);
            }
            SEAM(pb + 13);
        } else {
            if (IN(pb + 12)) { KA a = ka_get(); Frame F = make_frame(ldsb, wave_s); phase_gather(F, a); }
            SEAM(pb + 12);
            if (IN(pb + 13)) { KA a = ka_get(); Frame F = make_frame(ldsb, wave_s); unsigned char* ws = a->ws;
                int off[9]; load_exptab(a, off);
                pg8::Gemm g{(const bf16*)(ws + WS_HSX), (const bf16*)(ws + WS_W13M), MS, 2 * FFE, D / 2, D / 2, F.tid, 0x7f7f7f7f, 0x79797979};
                pg8::MoeOrder S{F.G, F.bid, 2 * FFE / 256, off[0], off[1], off[2], off[3], off[4], off[5], off[6], off[7], off[8], off[8] * (2 * FFE / 256)};
                pg8::EpiSwiGLUT<true> E{(bf16*)(ws + WS_ACTM), FFE, 2 * FFE / 256, (const float*)(ws + WS_TAB + TAB_RSTDS)};
                pg8::gemm_phase<pg8::EpiSwiGLUT<true>, pg8::MoeOrder, true, true, true>(F.lds + RING_OFF, g, S, E);
            }
            SEAM(pb + 13);
            if (IN(pb + 14)) { KA a = ka_get(); Frame F = make_frame(ldsb, wave_s); unsigned char* ws = a->ws;
                int off[9]; load_exptab(a, off);
                pg8::Gemm g{(const bf16*)(ws + WS_ACTM), (const bf16*)(ws + WS_W2M), MS, D, FFE / 2, FFE / 2, F.tid, 0x7c7c7c7c, 0x79797979};
                const int Ltot = off[8] * (D / 256); int Lreg, KS; md_split(Ltot, F.G, Lreg, KS);
                pg8::MoeOrder S{F.G, F.bid, D / 256, off[0], off[1], off[2], off[3], off[4], off[5], off[6], off[7], off[8], Lreg};
                pg8::EpiResF32 E{nullptr, (float*)(ws + WS_Y), D, D / 256};
                pg8::gemm_phase<pg8::EpiResF32, pg8::MoeOrder, true, true, true>(F.lds + RING_OFF, g, S, E);
            }
            if (IN(pb + 14)) { KA a = ka_get(); Frame F = make_frame(ldsb, wave_s); unsigned char* ws = a->ws;
                int off[9]; load_exptab(a, off);
                const int Ltot = off[8] * (D / 256); int Lreg, KS; md_split(Ltot, F.G, Lreg, KS);
                const int j = F.bid;
                if (j < (Ltot - Lreg) * KS) {
                    const int q = j % KS; pg8::Unit u; pg8::MoeOrder S{F.G, F.bid, D / 256, off[0], off[1], off[2], off[3], off[4], off[5], off[6], off[7], off[8], Lreg}; S.at((long)Lreg + j / KS, u);
                    const int Ks = (FFE / 2) / KS;
                    pg8::Gemm g2{(const bf16*)(ws + WS_ACTM) + (size_t)q * Ks, (const bf16*)(ws + WS_W2M) + (size_t)q * Ks, MS, D, Ks, FFE / 2, F.tid, 0x7c7c7c7c, 0x79797979, FFE / 2};
                    pg8::OneUnit S2{u.pm, u.pn, true};
                    float* slab = (float*)(ws + WS_SLAB) + (size_t)j * 65536;
                    pg8::EpiResF32 E2{nullptr, slab - (size_t)u.pm * 256 * 256 - (size_t)(u.pn % (D / 256)) * 256, 256, D / 256};
                    pg8::gemm_phase<pg8::EpiResF32, pg8::OneUnit, true, true, true>(F.lds + RING_OFF, g2, S2, E2);
                }
            }
            SEAM(pb + 14);
            if (IN(pb + 15)) { KA a = ka_get(); Frame F = make_frame(ldsb, wave_s); phase_combine(F, a); }
        }
    }
#undef IN
#undef SEAM
}

extern "C" void kernel_launch(void* const* d_in, const int* in_sizes, int n_in, void* d_out, int out_size, void* d_ws, size_t ws_size, hipStream_t stream) {
    static int grid = 0;
    if (grid == 0) {
        if (n_in != 23 || out_size != M * D || ws_size < WS_END) { fprintf(stderr, "kernel_launch: unexpected shapes (n_in %d out %d ws %zu need %zu)\n", n_in, out_size, ws_size, (size_t)WS_END); grid = -1; return; }
        int dev = 0, cus = 0, per_cu = 0;
        if (hipGetDevice(&dev) != hipSuccess || hipDeviceGetAttribute(&cus, hipDeviceAttributeMultiprocessorCount, dev) != hipSuccess) { grid = -1; return; }
        if (hipFuncSetAttribute((const void*)mk_fwd, hipFuncAttributeMaxDynamicSharedMemorySize, LDS_BYTES) != hipSuccess) { fprintf(stderr, "kernel_launch: hipFuncSetAttribute failed\n"); grid = -1; return; }
        if (hipOccupancyMaxActiveBlocksPerMultiprocessor(&per_cu, (const void*)mk_fwd, NWAVES * 64, LDS_BYTES) != hipSuccess || per_cu < 1) fprintf(stderr, "kernel_launch: occupancy query says %d\n", per_cu);
        (void)hipGetLastError();
        grid = cus;
    }
    if (grid < 0) return;
    (void)hipMemsetAsync((char*)d_ws + WS_CTL, 0, CTL_ZERO_BYTES, stream);
    Args a{};
    for (int i = 0; i < 23; ++i) a.in[i] = (const float*)d_in[i];
    a.out = (float*)d_out; a.ws = (unsigned char*)d_ws;
#if MK_ONE_LAUNCH
    a.ph_lo = 0; a.ph_hi = NPHASE;
    hipLaunchKernelGGL(mk_fwd, dim3(grid), dim3(NWAVES * 64), LDS_BYTES, stream, a);
#else
    for (int p = 0; p < NPHASE; ++p) {
        if (p == 14 || p == 15) continue;
        a.ph_lo = p; a.ph_hi = p + 1;
        hipLaunchKernelGGL(mk_fwd, dim3(grid), dim3(NWAVES * 64), LDS_BYTES, stream, a);
    }
#endif
}
```
